# Optimizing an MI355X kernel written in HIP

```python
import math
import jax, jax.numpy as jnp
from jax import lax
import numpy as np

D_MODEL = 1024
BATCH = 8
SEQ = 2048
DEPTH = 2

GRID_W = 64
NORM_EPS = 1e-6

NA_HEADS = 8
NA_HEAD_DIM = 64
NA_WIDTH = NA_HEADS * NA_HEAD_DIM
NA_KH_MAX = 8
NA_KW = 16

SSD_D_INNER = D_MODEL
SSD_HEAD_DIM = 64
SSD_HEADS = SSD_D_INNER // SSD_HEAD_DIM
SSD_GROUPS = 4
SSD_STATE = 128
SSD_CONV = 4
SSD_CHUNK = 128
SSD_CONV_DIM = SSD_D_INNER + 2 * SSD_GROUPS * SSD_STATE
DT_MIN = 0.001
DT_MAX = 0.1

EVEN_SPLITS = [NA_WIDTH, 2 * NA_WIDTH, 3 * NA_WIDTH,
               3 * NA_WIDTH + SSD_D_INNER,
               3 * NA_WIDTH + SSD_D_INNER + SSD_CONV_DIM]
EVEN_IN_WIDTH = 3 * NA_WIDTH + SSD_D_INNER + SSD_CONV_DIM + 2 * SSD_HEADS
EVEN_MIX_WIDTH = NA_WIDTH + SSD_D_INNER

GQA_HEADS = 16
GQA_KV_HEADS = 4
GQA_HEAD_DIM = 64
GQA_Q_WIDTH = GQA_HEADS * GQA_HEAD_DIM
GQA_KV_WIDTH = GQA_KV_HEADS * GQA_HEAD_DIM
ODD_IN_WIDTH = GQA_Q_WIDTH + 2 * GQA_KV_WIDTH
ROPE_THETA = 10000.0
Q_BLOCK = 128

FFN_HIDDEN = -(-8 * D_MODEL // (3 * 256)) * 256

N_EVEN = (DEPTH + 1) // 2
N_ODD = DEPTH // 2

kernel_name = "hybrid_natten_ssd_axial_gqa_encoder"


def rms_norm(x, g):
    xf = x.astype(jnp.float32)
    y = xf * lax.rsqrt(jnp.mean(xf * xf, axis=-1, keepdims=True) + NORM_EPS)
    return (y * g.astype(jnp.float32)).astype(x.dtype)


def neighbourhood_attention(q, k, v, rpb):
    B, S, H, Dh = q.shape
    rows = S // GRID_W
    kh = min(NA_KH_MAX, rows)
    qg = q.reshape(B, rows, GRID_W, H, Dh)
    kg = k.reshape(B, rows, GRID_W, H, Dh)
    vg = v.reshape(B, rows, GRID_W, H, Dh)
    r = jnp.arange(rows)
    row_start = jnp.clip(r - kh // 2, 0, rows - kh)
    key_rows = row_start[:, None] + jnp.arange(kh)[None, :]
    k_blk = kg[:, key_rows]
    v_blk = vg[:, key_rows]
    c = jnp.arange(GRID_W)
    col_start = jnp.clip(c - NA_KW // 2, 0, GRID_W - NA_KW)
    in_win = (c[None, :] >= col_start[:, None]) & (c[None, :] < col_start[:, None] + NA_KW)
    dy = key_rows - r[:, None] + (NA_KH_MAX - 1)
    dx = jnp.clip(c[None, :] - c[:, None], -(NA_KW - 1), NA_KW - 1) + (NA_KW - 1)
    bias = rpb.astype(jnp.float32)[:, dy[:, None, :, None], dx[None, :, None, :]]
    scale = Dh ** -0.5
    s = jnp.einsum('brchd,brjkhd->bhrcjk', qg, k_blk).astype(jnp.float32) * scale + bias[None]
    s = jnp.where(in_win[:, None, :], s, -jnp.inf)
    p = jax.nn.softmax(s.reshape(B, H, rows, GRID_W, kh * GRID_W), axis=-1)
    p = p.reshape(B, H, rows, GRID_W, kh, GRID_W).astype(v.dtype)
    o = jnp.einsum('bhrcjk,brjkhd->brchd', p, v_blk)
    return o.reshape(B, S, H * Dh)


def centred_depthwise_conv(x, w, b):
    K, C = w.shape
    left = K // 2
    xp = jnp.pad(x, ((0, 0), (left, K - 1 - left), (0, 0)))
    y = lax.conv_general_dilated(xp, w[:, None, :].astype(x.dtype), window_strides=(1,), padding='VALID',
                                 dimension_numbers=('NWC', 'WIO', 'NWC'), feature_group_count=C)
    return y + b.astype(x.dtype)


def ssd_scan(x, dt, A, Bm, Cm):
    out_dtype = x.dtype
    Bsz, S, H, P = x.shape
    G, N = Bm.shape[2], Bm.shape[3]
    R = H // G
    L = SSD_CHUNK
    nc = S // L
    f32 = jnp.float32
    x = x.astype(f32); dt = dt.astype(f32)
    xc = (x * dt[..., None]).reshape(Bsz, nc, L, G, R, P)
    Bc = Bm.astype(f32).reshape(Bsz, nc, L, G, N)
    Cc = Cm.astype(f32).reshape(Bsz, nc, L, G, N)
    a = (dt * A.astype(f32)).reshape(Bsz, nc, L, G, R)
    a_cum = jnp.moveaxis(jnp.cumsum(a, axis=2), 2, -1)
    seg = a_cum[..., :, None] - a_cum[..., None, :]
    lower = jnp.tril(jnp.ones((L, L), dtype=bool))
    decay = jnp.exp(jnp.where(lower, seg, -jnp.inf))
    cb = jnp.einsum('bclgn,bcsgn->bcgls', Cc, Bc)
    y_diag = jnp.einsum('bcgls,bcgrls,bcsgrp->bclgrp', cb, decay, xc)
    decay_to_end = jnp.exp(a_cum[..., -1:] - a_cum)
    states = jnp.einsum('bcsgn,bcgrs,bcsgrp->bcgrpn', Bc, decay_to_end, xc)
    chunk_decay = jnp.exp(a_cum[..., -1])

    def step(h, inp):
        s_c, d_c = inp
        return h * d_c[..., None, None] + s_c, h

    h0 = jnp.zeros((Bsz, G, R, P, N), f32)
    _, h_prev = lax.scan(step, h0, (jnp.moveaxis(states, 1, 0), jnp.moveaxis(chunk_decay, 1, 0)))
    h_prev = jnp.moveaxis(h_prev, 0, 1)
    y_off = jnp.einsum('bclgn,bcgrpn,bcgrl->bclgrp', Cc, h_prev, jnp.exp(a_cum))
    return (y_diag + y_off).reshape(Bsz, S, H, P).astype(out_dtype)


def gated_group_rms_norm(y, z, g):
    Bsz, S, Dn = y.shape
    h = (y * jax.nn.silu(z)).astype(jnp.float32).reshape(Bsz, S, SSD_GROUPS, Dn // SSD_GROUPS)
    h = h * lax.rsqrt(jnp.mean(h * h, axis=-1, keepdims=True) + NORM_EPS)
    return (h.reshape(Bsz, S, Dn) * g.astype(jnp.float32)).astype(y.dtype)


def even_mixer(x, mix_norm, w_in, na_q_norm, na_k_norm, na_rel_bias, conv_w, conv_b,
               dt_bias, A_log, D_skip, out_norm, w_out):
    Bsz, S, _ = x.shape
    proj = rms_norm(x, mix_norm) @ w_in
    q, k, v, z, xbc, dt_raw = jnp.split(proj, EVEN_SPLITS, axis=-1)
    q = rms_norm(q.reshape(Bsz, S, NA_HEADS, NA_HEAD_DIM), na_q_norm)
    k = rms_norm(k.reshape(Bsz, S, NA_HEADS, NA_HEAD_DIM), na_k_norm)
    v = v.reshape(Bsz, S, NA_HEADS, NA_HEAD_DIM)
    na_out = neighbourhood_attention(q, k, v, na_rel_bias)
    xbc = jax.nn.silu(centred_depthwise_conv(xbc, conv_w, conv_b))
    xs, bm, cm = jnp.split(xbc, [SSD_D_INNER, SSD_D_INNER + SSD_GROUPS * SSD_STATE], axis=-1)
    xs = xs.reshape(Bsz, S, SSD_HEADS, SSD_HEAD_DIM)
    bm = bm.reshape(Bsz, S, SSD_GROUPS, SSD_STATE)
    cm = cm.reshape(Bsz, S, SSD_GROUPS, SSD_STATE)
    dt = jax.nn.softplus(dt_raw.astype(jnp.float32).reshape(Bsz, S, 2, SSD_HEADS)
                         + dt_bias.astype(jnp.float32))
    A = -jnp.exp(A_log.astype(jnp.float32))
    y_fwd = ssd_scan(xs, dt[:, :, 0], A[0], bm, cm)
    y_bwd = jnp.flip(ssd_scan(jnp.flip(xs, 1), jnp.flip(dt[:, :, 1], 1), A[1],
                              jnp.flip(bm, 1), jnp.flip(cm, 1)), 1)
    y = y_fwd + y_bwd + D_skip.astype(xs.dtype)[:, None] * xs
    ssd_out = gated_group_rms_norm(y.reshape(Bsz, S, SSD_D_INNER), z, out_norm)
    return jnp.concatenate([na_out, ssd_out], axis=-1) @ w_out


def axial_rope_tables(S):
    t = jnp.arange(S)
    row = (t // GRID_W).astype(jnp.float32)
    col = (t % GRID_W).astype(jnp.float32)
    axis_dims = GQA_HEAD_DIM // 2
    freqs = ROPE_THETA ** (-jnp.arange(0, axis_dims, 2, dtype=jnp.float32) / axis_dims)
    ang = jnp.concatenate([row[:, None] * freqs, col[:, None] * freqs], axis=-1)
    return jnp.cos(ang), jnp.sin(ang)


def apply_rope(x, cos, sin):
    xf = x.astype(jnp.float32).reshape(*x.shape[:-1], x.shape[-1] // 2, 2)
    x0, x1 = xf[..., 0], xf[..., 1]
    c = cos[None, :, None, :]
    s = sin[None, :, None, :]
    out = jnp.stack([x0 * c - x1 * s, x0 * s + x1 * c], axis=-1)
    return out.reshape(x.shape).astype(x.dtype)


def gqa_block_attention(q, k, v):
    Bsz, S, H, Dh = q.shape
    KV = k.shape[2]
    rep = H // KV
    nb = S // Q_BLOCK
    qb = jnp.moveaxis(q.reshape(Bsz, nb, Q_BLOCK, KV, rep, Dh), 1, 0)
    scale = Dh ** -0.5

    def one_block(q_blk):
        s = jnp.einsum('bqgrd,bkgd->bgrqk', q_blk, k).astype(jnp.float32) * scale
        p = jax.nn.softmax(s, axis=-1).astype(v.dtype)
        return jnp.einsum('bgrqk,bkgd->bqgrd', p, v)

    o = lax.map(one_block, qb)
    return jnp.moveaxis(o, 0, 1).reshape(Bsz, S, H * Dh)


def odd_mixer(x, mix_norm, w_qkv, q_norm, k_norm, w_out):
    Bsz, S, _ = x.shape
    proj = rms_norm(x, mix_norm) @ w_qkv
    q, k, v = jnp.split(proj, [GQA_Q_WIDTH, GQA_Q_WIDTH + GQA_KV_WIDTH], axis=-1)
    q = rms_norm(q.reshape(Bsz, S, GQA_HEADS, GQA_HEAD_DIM), q_norm)
    k = rms_norm(k.reshape(Bsz, S, GQA_KV_HEADS, GQA_HEAD_DIM), k_norm)
    v = v.reshape(Bsz, S, GQA_KV_HEADS, GQA_HEAD_DIM)
    cos, sin = axial_rope_tables(S)
    q = apply_rope(q, cos, sin)
    k = apply_rope(k, cos, sin)
    return gqa_block_attention(q, k, v) @ w_out


def swiglu_ffn(x, norm_g, w13, w2):
    g, u = jnp.split(rms_norm(x, norm_g) @ w13, 2, axis=-1)
    return (jax.nn.silu(g) * u) @ w2


def setup_inputs(seed: int = 0) -> dict:
    key = jax.random.key(seed)
    ks = jax.random.split(key, 24)
    f32 = jnp.float32

    def normal(k, shape, scale):
        return jax.random.normal(k, shape, f32) * scale

    def gain(k, shape):
        return 1.0 + 0.02 * jax.random.normal(k, shape, f32)

    dt0 = jnp.exp(jax.random.uniform(ks[10], (N_EVEN, 2, SSD_HEADS), f32)
                  * (math.log(DT_MAX) - math.log(DT_MIN)) + math.log(DT_MIN))
    dt_bias = dt0 + jnp.log(-jnp.expm1(-dt0))
    A_log = jnp.log(jax.random.uniform(ks[11], (N_EVEN, 2, SSD_HEADS), f32, 1.0, 16.0))
    return {
        "x": jax.random.normal(ks[0], (BATCH, SEQ, D_MODEL), f32),
        "even_mix_norm": gain(ks[1], (N_EVEN, D_MODEL)),
        "even_w_in": normal(ks[2], (N_EVEN, D_MODEL, EVEN_IN_WIDTH), D_MODEL ** -0.5),
        "na_q_norm": gain(ks[3], (N_EVEN, NA_HEAD_DIM)),
        "na_k_norm": gain(ks[4], (N_EVEN, NA_HEAD_DIM)),
        "na_rel_bias": normal(ks[5], (N_EVEN, NA_HEADS, 2 * NA_KH_MAX - 1, 2 * NA_KW - 1), 0.05),
        "ssd_conv_w": normal(ks[6], (N_EVEN, SSD_CONV, SSD_CONV_DIM), SSD_CONV ** -0.5),
        "ssd_conv_b": normal(ks[7], (N_EVEN, SSD_CONV_DIM), 0.01),
        "ssd_dt_bias": dt_bias,
        "ssd_A_log": A_log,
        "ssd_D": gain(ks[8], (N_EVEN, SSD_HEADS)),
        "ssd_out_norm": gain(ks[9], (N_EVEN, SSD_D_INNER)),
        "even_w_out": normal(ks[12], (N_EVEN, EVEN_MIX_WIDTH, D_MODEL), EVEN_MIX_WIDTH ** -0.5),
        "odd_mix_norm": gain(ks[13], (N_ODD, D_MODEL)),
        "odd_w_qkv": normal(ks[14], (N_ODD, D_MODEL, ODD_IN_WIDTH), D_MODEL ** -0.5),
        "gqa_q_norm": gain(ks[15], (N_ODD, GQA_HEAD_DIM)),
        "gqa_k_norm": gain(ks[16], (N_ODD, GQA_HEAD_DIM)),
        "odd_w_out": normal(ks[17], (N_ODD, GQA_Q_WIDTH, D_MODEL), GQA_Q_WIDTH ** -0.5),
        "ffn_norm": gain(ks[18], (DEPTH, D_MODEL)),
        "ffn_w13": normal(ks[19], (DEPTH, D_MODEL, 2 * FFN_HIDDEN), D_MODEL ** -0.5),
        "ffn_w2": normal(ks[20], (DEPTH, FFN_HIDDEN, D_MODEL), FFN_HIDDEN ** -0.5),
    }


def reference(x, even_mix_norm, even_w_in, na_q_norm, na_k_norm, na_rel_bias, ssd_conv_w, ssd_conv_b,
              ssd_dt_bias, ssd_A_log, ssd_D, ssd_out_norm, even_w_out, odd_mix_norm, odd_w_qkv,
              gqa_q_norm, gqa_k_norm, odd_w_out, ffn_norm, ffn_w13, ffn_w2):
    for layer in range(DEPTH):
        i = layer // 2
        if layer % 2 == 0:
            x = x + even_mixer(x, even_mix_norm[i], even_w_in[i], na_q_norm[i], na_k_norm[i],
                               na_rel_bias[i], ssd_conv_w[i], ssd_conv_b[i], ssd_dt_bias[i],
                               ssd_A_log[i], ssd_D[i], ssd_out_norm[i], even_w_out[i])
        else:
            x = x + odd_mixer(x, odd_mix_norm[i], odd_w_qkv[i], gqa_q_norm[i], gqa_k_norm[i], odd_w_out[i])
        x = x + swiglu_ffn(x, ffn_norm[layer], ffn_w13[layer], ffn_w2[layer])
    return x
```

```cpp
#include <hip/hip_runtime.h>
#include <hip/hip_bf16.h>
#include <hip/hip_cooperative_groups.h>
#include <cstdio>
namespace cg = cooperative_groups;

#define PROBE_REP_MASK 0
#define PROBE_EXTRA_SYNCS 0
#define PROBE_SUB 0
#define PSUB(k) for (int _r = 0; _r < ((PROBE_SUB == (k)) ? 2 : 1); ++_r)
#ifndef MULTI_LAUNCH
#define MULTI_LAUNCH 0
#endif

typedef __attribute__((ext_vector_type(8))) short bf16x8;
typedef __attribute__((ext_vector_type(4))) float f32x4;
typedef __attribute__((ext_vector_type(2))) float f32x2;
typedef __attribute__((ext_vector_type(2))) __bf16 bf16v2;
typedef unsigned short u16;
typedef unsigned u32x4v __attribute__((ext_vector_type(4)));

#define DI __device__ __forceinline__
#define MFMA(a, b, c) __builtin_amdgcn_mfma_f32_16x16x32_bf16((a), (b), (c), 0, 0, 0)

constexpr int T = 16384;
constexpr float EPS = 1e-6f;
constexpr float LOG2E = 1.4426950408889634f;
constexpr int NPHASE = 13;
constexpr int SMEM_BYTES = 131072 + 8192;

constexpr size_t MIB = 1u << 20;
constexpr size_t O_WIN0 = 0;
constexpr size_t O_WV0 = O_WIN0 + 4352ull * 1024 * 2;
constexpr size_t O_WOUT0 = O_WV0 + 512ull * 1024 * 2;
constexpr size_t O_W13_0 = O_WOUT0 + 1024ull * 1536 * 2;
constexpr size_t O_W2_0 = O_W13_0 + 5632ull * 1024 * 2;
constexpr size_t O_ROPE = 31 * MIB;
constexpr size_t O_DTB = O_ROPE + 524288;
constexpr size_t O_SSQ = O_DTB + 2097152;
constexpr size_t O_BAR = O_SSQ + 262144;
constexpr size_t O_XB = 34 * MIB;
constexpr size_t O_BN = O_XB;
constexpr size_t O_BT = O_XB + 16 * MIB;
constexpr size_t O_Q0 = 66 * MIB;
constexpr size_t O_K0 = 82 * MIB;
constexpr size_t O_VT0 = 98 * MIB;
constexpr size_t O_WQKV1 = 66 * MIB;
constexpr size_t O_WV1 = O_WQKV1 + 1280ull * 1024 * 2;
constexpr size_t O_WOUT1 = O_WV1 + 256ull * 1024 * 2;
constexpr size_t O_W13_1 = O_WOUT1 + 1024ull * 1024 * 2;
constexpr size_t O_W2_1 = O_W13_1 + 5632ull * 1024 * 2;
constexpr size_t O_BIG = 114 * MIB;
constexpr size_t O_XBC = O_BIG;
constexpr size_t O_HPREV = O_BIG;
constexpr size_t O_CN = O_BIG + 64 * MIB;
constexpr size_t O_MIX = O_BIG + 80 * MIB;
constexpr size_t O_H = O_BIG;
constexpr size_t O_Q1 = O_BIG;
constexpr size_t O_K1 = O_BIG + 32 * MIB;
constexpr size_t O_VT1 = O_BIG + 40 * MIB;
constexpr size_t O_AO = O_BIG + 48 * MIB;

struct Params {
  const float *x, *even_mix_norm, *even_w_in, *na_q_norm, *na_k_norm, *na_rel_bias, *conv_w, *conv_b, *dt_bias, *A_log,
      *Dskip, *out_norm, *even_w_out, *odd_mix_norm, *odd_w_qkv, *gqa_q_norm, *gqa_k_norm, *odd_w_out, *ffn_norm,
      *ffn_w13, *ffn_w2;
  float* out;
  char* ws;
  int ph0, ph1;
};

__device__ __forceinline__ int threadIdx_x_raw() { return (int)__builtin_amdgcn_workitem_id_x(); }
DI unsigned pack2(float a, float b) {
  f32x2 v = {a, b};
  bf16v2 r = __builtin_convertvector(v, bf16v2);
  return __builtin_bit_cast(unsigned, r);
}
DI uint2 pack4(f32x4 v) { return make_uint2(pack2(v[0], v[1]), pack2(v[2], v[3])); }
DI u16 f2bf(float a) { return (u16)(pack2(a, 0.f) & 0xffffu); }
DI float bflo(unsigned u) { return __uint_as_float(u << 16); }
DI float bfhi(unsigned u) { return __uint_as_float(u & 0xffff0000u); }
DI float bf2f(u16 h) { return __uint_as_float(((unsigned)h) << 16); }
DI bf16x8 as_bf8(uint4 v) { return __builtin_bit_cast(bf16x8, v); }
DI bf16x8 cat_bf8(uint2 a, uint2 b) { return as_bf8(make_uint4(a.x, a.y, b.x, b.y)); }
DI int vtid() { int t = threadIdx_x_raw() & 255; asm volatile("" : "+v"(t)); return t; }
DI int otid() { int t = threadIdx_x_raw(); asm volatile("" : "+v"(t)); return t; }
DI float silu(float x) { return x / (1.f + __expf(-x)); }
DI float ex2(float x) { return __builtin_amdgcn_exp2f(x); }
DI float xor16_32_sum(float v) { v += __shfl_xor(v, 16); v += __shfl_xor(v, 32); return v; }
DI float xor16_32_max(float v) { v = fmaxf(v, __shfl_xor(v, 16)); v = fmaxf(v, __shfl_xor(v, 32)); return v; }
DI void wave_sync_lds() { __builtin_amdgcn_fence(__ATOMIC_ACQ_REL, "wavefront"); __builtin_amdgcn_wave_barrier(); }
DI void unpack8(uint4 u, float* f) {
  f[0] = bflo(u.x); f[1] = bfhi(u.x); f[2] = bflo(u.y); f[3] = bfhi(u.y);
  f[4] = bflo(u.z); f[5] = bfhi(u.z); f[6] = bflo(u.w); f[7] = bfhi(u.w);
}

struct WDesc { const float* W; int ldn, K, rows; u16* dst; const float* gain; int mode, coloff; };
DI int wt_srccol(int mode, int R, int coloff) {
  if (mode == 0) return coloff + R;
  const int pn = R >> 8, c = R & 255, bj = c >> 7, j = c & 127;
  if (mode == 1) return bj * 2816 + pn * 128 + j;
  const int wc = j >> 5, e = j & 31;
  if (mode == 2) {
    if (pn < 4) return (pn >> 1) * 512 + ((pn & 1) * 4 + wc) * 64 + bj * 32 + e;
    if (pn < 8) return 1536 + (R - 1024);
    if (pn < 16) return 2560 + (R - 2048);
    return (R - 4096 < 32) ? 4608 + (R - 4096) : -1;
  }
  if (pn < 4) return (pn * 4 + wc) * 64 + bj * 32 + e;
  return 1024 + wc * 64 + bj * 32 + e;
}
__device__ void wt_item(const WDesc& d, int item, int lane) {
  const int nr = d.rows >> 6, nn = item % nr, kk = item / nr;
  const int R = nn * 64 + lane;
  const int sc = wt_srccol(d.mode, R, d.coloff);
  const float* src = d.W + (sc >= 0 ? sc : 0);
  u16* dst = d.dst + (size_t)R * d.K + kk * 64;
#pragma unroll 2
  for (int k8 = 0; k8 < 8; ++k8) {
    float v[8];
#pragma unroll
    for (int e = 0; e < 8; ++e) {
      const int k = kk * 64 + k8 * 8 + e;
      float x = src[(size_t)k * d.ldn];
      if (d.gain) x *= d.gain[k];
      v[e] = (sc >= 0) ? x : 0.f;
    }
    *(uint4*)(dst + k8 * 8) = make_uint4(pack2(v[0], v[1]), pack2(v[2], v[3]), pack2(v[4], v[5]), pack2(v[6], v[7]));
  }
}
DI WDesc wt_desc(const Params& p, char* ws, int set, int i) {
  if (set == 0) {
    switch (i) {
      case 0: return WDesc{p.even_w_in, 4640, 1024, 4352, (u16*)(ws + O_WIN0), p.even_mix_norm, 2, 0};
      case 1: return WDesc{p.even_w_in, 4640, 1024, 512, (u16*)(ws + O_WV0), p.even_mix_norm, 0, 1024};
      case 2: return WDesc{p.even_w_out, 1024, 1536, 1024, (u16*)(ws + O_WOUT0), nullptr, 0, 0};
      case 3: return WDesc{p.ffn_w13, 5632, 1024, 5632, (u16*)(ws + O_W13_0), p.ffn_norm, 1, 0};
      default: return WDesc{p.ffn_w2, 1024, 2816, 1024, (u16*)(ws + O_W2_0), nullptr, 0, 0};
    }
  }
  switch (i) {
    case 0: return WDesc{p.odd_w_qkv, 1536, 1024, 1280, (u16*)(ws + O_WQKV1), p.odd_mix_norm, 3, 0};
    case 1: return WDesc{p.odd_w_qkv, 1536, 1024, 256, (u16*)(ws + O_WV1), p.odd_mix_norm, 0, 1280};
    case 2: return WDesc{p.odd_w_out, 1024, 1024, 1024, (u16*)(ws + O_WOUT1), nullptr, 0, 0};
    case 3: return WDesc{p.ffn_w13 + (size_t)1024 * 5632, 5632, 1024, 5632, (u16*)(ws + O_W13_1), p.ffn_norm + 1024, 1, 0};
    default: return WDesc{p.ffn_w2 + (size_t)2816 * 1024, 1024, 2816, 1024, (u16*)(ws + O_W2_1), nullptr, 0, 0};
  }
}
__device__ void wt_run(const Params& p, char* ws, int set, int gw, int nw, int lane) {
  const int c0 = set ? 320 : 1088, c1 = c0 + (set ? 64 : 128), c2 = c1 + (set ? 256 : 384), c3 = c2 + 1408, total = c3 + 704;
  for (int it = gw; it < total; it += nw) {
    const int i = it < c0 ? 0 : it < c1 ? 1 : it < c2 ? 2 : it < c3 ? 3 : 4;
    const int base = i == 0 ? 0 : i == 1 ? c0 : i == 2 ? c1 : i == 3 ? c2 : c3;
    const WDesc d = wt_desc(p, ws, set, i);
    wt_item(d, it - base, lane);
  }
}

__device__ void phase_prep(const Params& p) {
  char* ws = p.ws;
  asm volatile("" : "+s"(ws));
  const int tid = otid(), lane = tid & 63;
  const int gw = blockIdx.x * 8 + (tid >> 6), nw = gridDim.x * 8;
  PSUB(1) wt_run(p, ws, 0, gw, nw, lane);
  PSUB(2) for (int row0 = gw * 4; row0 < T; row0 += nw * 4) {
    float4 v[4][4];
#pragma unroll
    for (int rr = 0; rr < 4; ++rr)
#pragma unroll
      for (int i = 0; i < 4; ++i) v[rr][i] = *(const float4*)(p.x + (size_t)(row0 + rr) * 1024 + i * 256 + lane * 4);
#pragma unroll
    for (int rr = 0; rr < 4; ++rr) {
      u16* xb = (u16*)(ws + O_XB) + (size_t)(row0 + rr) * 1024;
      float ss = 0.f;
#pragma unroll
      for (int i = 0; i < 4; ++i) { const float4 a = v[rr][i]; ss += a.x * a.x + a.y * a.y + a.z * a.z + a.w * a.w; }
#pragma unroll
      for (int o = 32; o >= 1; o >>= 1) ss += __shfl_xor(ss, o);
      const float rs = rsqrtf(ss * (1.f / 1024.f) + EPS);
#pragma unroll
      for (int i = 0; i < 4; ++i) {
        const float4 a = v[rr][i];
        *(uint2*)(xb + i * 256 + lane * 4) = make_uint2(pack2(a.x * rs, a.y * rs), pack2(a.z * rs, a.w * rs));
      }
      if (lane == 0) {
        float* ssq = (float*)(ws + O_SSQ);
        const int row = row0 + rr;
        ssq[row] = ss; ssq[T + row] = 0.f; ssq[2 * T + row] = 0.f; ssq[3 * T + row] = 0.f;
      }
    }
  }
  PSUB(3) for (int idx = blockIdx.x * 512 + tid; idx < 65536; idx += gridDim.x * 512) {
    int s = idx >> 5, pp = idx & 31;
    float pos = (pp < 16) ? (float)(s >> 6) : (float)(s & 63);
    float freq = powf(10000.f, -(float)(pp & 15) / 16.f);
    float sn, cs;
    sincosf(pos * freq, &sn, &cs);
    ((float2*)(ws + O_ROPE))[idx] = make_float2(cs, sn);
  }
}
__device__ void phase_prep_l1(const Params& p, char* ws, int gw, int nw, int lane) { wt_run(p, ws, 1, gw, nw, lane); }
namespace pg8 {
#define PG8_LAS __attribute__((address_space(3)))
typedef unsigned short bf16_t;
constexpr int BM = 256, BK = 64, HALF = 128, HTB = HALF * BK * 2, STAGE_BYTES = 8 * HTB, NXCD = 8, WGM = 8;
DI int lds_byte(int r, int c) { const int st = (r >> 4) * 2 + (c >> 5), rr = r & 15, cc = c & 31, ob = rr * 64 + cc * 2; return st * 1024 + (ob ^ (((ob >> 9) & 1) << 5)); }
DI void stage_rc(int b, int& R, int& C) { const int st = b / 1024, sb = b % 1024, swz = sb ^ (((sb >> 9) & 1) << 5); R = (st >> 1) * 16 + swz / 64; C = (st & 1) * 32 + (swz % 64) / 2; }
DI int perm32(int rho) { const int n = rho >> 4, i = rho & 15; return 8 * (i >> 2) + 4 * n + (i & 3); }
struct Unit { int pm, pn; };
struct Gemm { const bf16_t* A; const bf16_t* Bt; int M, N, K; };
struct StaticOrder {
  int nM, nN, nwg, G, c;
  DI void init(int M, int N, int G_, int c_) { nM = M / BM; nN = N / BM; nwg = nM * nN; G = G_; c = c_; }
  DI bool next(int i, Unit& u) const {
    const long L = (long)i * G + c; if (L >= nwg) return false;
    int wgid = (int)L; { const int q = nwg / NXCD, r = nwg % NXCD, xcd = wgid % NXCD, off = wgid / NXCD; wgid = (xcd < r ? xcd * (q + 1) : r * (q + 1) + (xcd - r) * q) + off; }
    const int nig = WGM * nN, gid = wgid / nig, fm = gid * WGM, gsz = (nM - fm) < WGM ? (nM - fm) : WGM;
    u.pm = fm + ((wgid % nig) % gsz); u.pn = (wgid % nig) / gsz; return true;
  }
};
template <class Epi>
DI void gemm_phase(PG8_LAS unsigned char* lds, const Gemm g, const StaticOrder& S, const Epi& E) {
  const int tid = otid(), wid = __builtin_amdgcn_readfirstlane(tid >> 6), lane = tid & 63, wr = wid >> 2, wc = wid & 3, fr = lane & 15, fq = lane >> 4;
  const int K = g.K, nt = K / BK;
  unsigned voffA[2], voffB[2];
#pragma unroll
  for (int i = 0; i < 2; ++i) { int R, C; stage_rc(tid * 16 + i * 8192, R, C); const int Rb = E.perm ? ((R & ~31) + perm32(R & 31)) : R;
    voffA[i] = (unsigned)(R * K + C) * 2u; voffB[i] = (unsigned)(Rb * K + C) * 2u; }
  const size_t kstep = (size_t)(BK * 2);
  const size_t hstep = (size_t)HALF * K * 2;
  const size_t tstep = 2 * hstep;
  const unsigned ldsw = (unsigned)wid * 1024u;
  const int aoff = lds_byte(wr * 64 + fr, fq * 8), boff = lds_byte(wc * 32 + fr, fq * 8);
#define PG8_SA(b, h) (((b) * 2 + (h)) * HTB)
#define PG8_SB(b, h) ((4 + (b) * 2 + (h)) * HTB)
#define PG8_STAGE(bufoff, gbase, voff) do { _Pragma("unroll") for (int _i = 0; _i < 2; ++_i) \
    __builtin_amdgcn_global_load_lds((const unsigned*)((const char*)(gbase) + (voff)[_i]), (PG8_LAS unsigned*)(lds + (bufoff) + ldsw + _i * 8192), 16, 0, 0); } while (0)
#define PG8_LDA(dst, b, h) do { _Pragma("unroll") for (int m = 0; m < 4; ++m) _Pragma("unroll") for (int k = 0; k < 2; ++k) dst[m][k] = *(const PG8_LAS bf16x8*)(lds + PG8_SA(b, h) + aoff + m * 2048 + k * 1024); } while (0)
#define PG8_LDB(dst, b, h) do { _Pragma("unroll") for (int n = 0; n < 2; ++n) _Pragma("unroll") for (int k = 0; k < 2; ++k) dst[n][k] = *(const PG8_LAS bf16x8*)(lds + PG8_SB(b, h) + boff + n * 2048 + k * 1024); } while (0)
#define PG8_MMA(ai, bj, At, Bt) do { __builtin_amdgcn_s_setprio(1); _Pragma("unroll") for (int m = 0; m < 4; ++m) _Pragma("unroll") for (int n = 0; n < 2; ++n) _Pragma("unroll") for (int k = 0; k < 2; ++k) \
    acc[ai][bj][m][n] = __builtin_amdgcn_mfma_f32_16x16x32_bf16(Bt[n][k], At[m][k], acc[ai][bj][m][n], 0, 0, 0); __builtin_amdgcn_s_setprio(0); } while (0)
#define PG8_WAIT_V(n) asm volatile("s_waitcnt vmcnt(" #n ")" ::: "memory")
#define PG8_WAIT_L(n) asm volatile("s_waitcnt lgkmcnt(" #n ")" ::: "memory")
#define PG8_BAR __builtin_amdgcn_s_barrier()
#define PG8_SCHED __builtin_amdgcn_sched_barrier(0)
  Unit cur, nxt; int ui = 0;
  if (!S.next(0, cur)) return;
  if (E.ssq_in) {
    PG8_LAS float* rtab = (PG8_LAS float*)(lds + 131072);
    Unit uu;
    for (int q = 0; q < 8 && S.next(q, uu); ++q)
      if (tid < 256) rtab[q * 256 + tid] = rsqrtf(E.ssq_in[(E.kind == 4 ? uu.pn : uu.pm) * 256 + tid] * (1.f / 1024.f) + EPS);
    __syncthreads();
  }
  f32x4 acc[2][2][4][2];
#pragma unroll
  for (int a = 0; a < 2; ++a)
#pragma unroll
    for (int b = 0; b < 2; ++b)
#pragma unroll
      for (int m = 0; m < 4; ++m)
#pragma unroll
        for (int n = 0; n < 2; ++n) acc[a][b][m][n] = (f32x4){0.f, 0.f, 0.f, 0.f};
  bf16x8 At[4][2], B0[2][2], B1[2][2];
  const char* cA = (const char*)g.A + (size_t)cur.pm * tstep; const char* cB = (const char*)g.Bt + (size_t)cur.pn * tstep;
  PG8_STAGE(PG8_SB(0, 0), cB, voffB); PG8_STAGE(PG8_SA(0, 0), cA, voffA); PG8_STAGE(PG8_SB(0, 1), cB + hstep, voffB); PG8_STAGE(PG8_SA(0, 1), cA + hstep, voffA);
  if (wr == 1) PG8_BAR;
  PG8_WAIT_V(4); PG8_BAR;
  PG8_STAGE(PG8_SB(1, 0), cB + kstep, voffB); PG8_STAGE(PG8_SA(1, 0), cA + kstep, voffA); PG8_STAGE(PG8_SB(1, 1), cB + hstep + kstep, voffB);
  PG8_WAIT_V(6); PG8_BAR;
  for (;;) {
    const bool has_next = S.next(ui + 1, nxt);
    const char* nA = has_next ? (const char*)g.A + (size_t)nxt.pm * tstep : cA; const char* nB = has_next ? (const char*)g.Bt + (size_t)nxt.pn * tstep : cB;
    for (int t = 0; t < nt; t += 2) {
      const bool last = (t == nt - 2);
      const char* a1 = cA + (size_t)(t + 1) * kstep;
      const char* a2 = last ? nA : cA + (size_t)(t + 2) * kstep; const char* b2 = last ? nB : cB + (size_t)(t + 2) * kstep;
      const char* a3 = a2 + kstep; const char* b3 = b2 + kstep;
      PG8_LDB(B0, 0, 0); PG8_SCHED; PG8_LDA(At, 0, 0); PG8_STAGE(PG8_SA(1, 1), a1 + hstep, voffA);
      PG8_WAIT_L(8); PG8_BAR; PG8_WAIT_L(0); PG8_MMA(0, 0, At, B0); PG8_BAR; PG8_SCHED;
      PG8_LDB(B1, 0, 1); PG8_STAGE(PG8_SB(0, 0), b2, voffB);
      PG8_BAR; PG8_WAIT_L(0); PG8_MMA(0, 1, At, B1); PG8_BAR;
      PG8_LDA(At, 0, 1); PG8_STAGE(PG8_SA(0, 0), a2, voffA);
      PG8_BAR; PG8_WAIT_L(0); PG8_MMA(1, 0, At, B0); PG8_BAR; PG8_SCHED;
      PG8_STAGE(PG8_SB(0, 1), b2 + hstep, voffB);
      PG8_WAIT_V(6); PG8_BAR; PG8_MMA(1, 1, At, B1); PG8_BAR;
      PG8_LDB(B0, 1, 0); PG8_SCHED; PG8_LDA(At, 1, 0); PG8_STAGE(PG8_SA(0, 1), a2 + hstep, voffA);
      PG8_WAIT_L(8); PG8_BAR; PG8_WAIT_L(0); PG8_MMA(0, 0, At, B0); PG8_BAR; PG8_SCHED;
      PG8_LDB(B1, 1, 1); PG8_STAGE(PG8_SB(1, 0), b3, voffB);
      PG8_BAR; PG8_WAIT_L(0); PG8_MMA(0, 1, At, B1); PG8_BAR;
      PG8_LDA(At, 1, 1); PG8_STAGE(PG8_SA(1, 0), a3, voffA);
      PG8_BAR; PG8_WAIT_L(0); PG8_MMA(1, 0, At, B0); PG8_BAR; PG8_SCHED;
      PG8_STAGE(PG8_SB(1, 1), b3 + hstep, voffB);
      PG8_WAIT_V(6); PG8_BAR; PG8_MMA(1, 1, At, B1); PG8_BAR;
    }
    E(acc, cur, wr, wc, fr, fq, (const PG8_LAS float*)(lds + 131072) + ui * 256);
    if (!has_next) break;
#pragma unroll
    for (int a = 0; a < 2; ++a)
#pragma unroll
      for (int b = 0; b < 2; ++b)
#pragma unroll
        for (int m = 0; m < 4; ++m)
#pragma unroll
          for (int n = 0; n < 2; ++n) acc[a][b][m][n] = (f32x4){0.f, 0.f, 0.f, 0.f};
    cur = nxt; cA = nA; cB = nB; ++ui;
  }
  PG8_WAIT_V(0);
  if (wr == 0) PG8_BAR;
  PG8_BAR;
#undef PG8_SA
#undef PG8_SB
#undef PG8_STAGE
#undef PG8_LDA
#undef PG8_LDB
#undef PG8_MMA
#undef PG8_WAIT_V
#undef PG8_WAIT_L
#undef PG8_BAR
#undef PG8_SCHED
}
}

typedef f32x4 AccT[2][2][4][2];
DI uint4 pack8(f32x4 a, f32x4 b) { return make_uint4(pack2(a[0], a[1]), pack2(a[2], a[3]), pack2(b[0], b[1]), pack2(b[2], b[3])); }

struct EpiRes {
  static constexpr bool PERM = false;
  const float* res_f32; u16* xb; float* out_f32; float* ssq_out;
  DI void operator()(const AccT& acc, const pg8::Unit& u, int wr, int wc, int fr, int fq, const PG8_LAS float* rtab) const {
    const int row0 = u.pm * 256 + wr * 64 + fr, col0 = u.pn * 256 + wc * 32 + 4 * fq;
#pragma unroll
    for (int ai = 0; ai < 2; ++ai)
#pragma unroll
      for (int m = 0; m < 4; ++m) {
        const size_t r = row0 + ai * 128 + m * 16;
        float part = 0.f;
#pragma unroll
        for (int bj = 0; bj < 2; ++bj)
#pragma unroll
          for (int n = 0; n < 2; ++n) {
            const int c = col0 + bj * 128 + n * 16;
            float4 r4;
            if (res_f32) r4 = *(const float4*)(res_f32 + r * 1024 + c);
            else { uint2 rr = *(const uint2*)(xb + r * 1024 + c); r4 = make_float4(bflo(rr.x), bfhi(rr.x), bflo(rr.y), bfhi(rr.y)); }
            f32x4 a = acc[ai][bj][m][n];
            float4 v = make_float4(r4.x + a[0], r4.y + a[1], r4.z + a[2], r4.w + a[3]);
            if (out_f32) *(float4*)(out_f32 + r * 1024 + c) = v;
            else *(uint2*)(xb + r * 1024 + c) = make_uint2(pack2(v.x, v.y), pack2(v.z, v.w));
            part += v.x * v.x + v.y * v.y + v.z * v.z + v.w * v.w;
          }
        if (ssq_out) {
          part = xor16_32_sum(part);
          if (fq == 0) atomicAdd(ssq_out + r, part);
        }
      }
  }
};

struct EpiSwiglu {
  static constexpr bool PERM = true;
  const float* ssq_in; u16* h_out;
  DI void operator()(const AccT& acc, const pg8::Unit& u, int wr, int wc, int fr, int fq, const PG8_LAS float* rtab) const {
    const int row0 = u.pm * 256 + wr * 64 + fr;
#pragma unroll
    for (int ai = 0; ai < 2; ++ai)
#pragma unroll
      for (int m = 0; m < 4; ++m) {
        const size_t r = row0 + ai * 128 + m * 16;
        const float rs = rtab[ai * 128 + wr * 64 + m * 16 + fr];
        f32x4 h0, h1;
#pragma unroll
        for (int e = 0; e < 4; ++e) {
          h0[e] = silu(acc[ai][0][m][0][e] * rs) * (acc[ai][1][m][0][e] * rs);
          h1[e] = silu(acc[ai][0][m][1][e] * rs) * (acc[ai][1][m][1][e] * rs);
        }
        *(uint4*)(h_out + r * 2816 + u.pn * 128 + wc * 32 + 8 * fq) = pack8(h0, h1);
      }
  }
};

template <int L1>
struct EpiQK {
  static constexpr bool PERM = true;
  char* ws; u16* zout; const float* qn; const float* kn; const float* ssq_in;
  DI void operator()(const AccT& acc, const pg8::Unit& u, int wr, int wc, int fr, int fq, const PG8_LAS float* rtab) const {
    const int pn = u.pn;
    const int row0 = u.pm * 256 + wr * 64 + fr;
    const bool headnorm = L1 ? true : (pn < 4);
    const bool is_q = L1 ? (pn < 4) : (pn < 2);
#pragma unroll
    for (int ai = 0; ai < 2; ++ai)
#pragma unroll
      for (int m = 0; m < 4; ++m) {
        const size_t r = row0 + ai * 128 + m * 16;
        const float rs = L1 ? rtab[ai * 128 + wr * 64 + m * 16 + fr] : 1.f;
        f32x4 v[2][2];
#pragma unroll
        for (int bj = 0; bj < 2; ++bj)
#pragma unroll
          for (int n = 0; n < 2; ++n) v[bj][n] = acc[ai][bj][m][n] * rs;
        if (headnorm) {
          float ss = 0.f;
#pragma unroll
          for (int bj = 0; bj < 2; ++bj)
#pragma unroll
            for (int n = 0; n < 2; ++n)
              ss += v[bj][n][0] * v[bj][n][0] + v[bj][n][1] * v[bj][n][1] + v[bj][n][2] * v[bj][n][2] + v[bj][n][3] * v[bj][n][3];
          ss = xor16_32_sum(ss);
          const float hn = rsqrtf(ss * (1.f / 64.f) + EPS) * (is_q ? 0.125f * LOG2E : 1.f);
          const float* gn = is_q ? qn : kn;
#pragma unroll
          for (int bj = 0; bj < 2; ++bj)
#pragma unroll
            for (int n = 0; n < 2; ++n) {
              float4 g4 = *(const float4*)(gn + bj * 32 + 8 * fq + 4 * n);
              v[bj][n][0] *= hn * g4.x; v[bj][n][1] *= hn * g4.y; v[bj][n][2] *= hn * g4.z; v[bj][n][3] *= hn * g4.w;
            }
          u16* dst;
          if (L1) {
            const int s = (int)(r & 2047);
            const float4* rt = (const float4*)(ws + O_ROPE) + (size_t)s * 16;
#pragma unroll
            for (int bj = 0; bj < 2; ++bj)
#pragma unroll
              for (int n = 0; n < 2; ++n) {
                float4 cs = rt[bj * 8 + 2 * fq + n];
                float a0 = v[bj][n][0], a1 = v[bj][n][1], b0 = v[bj][n][2], b1 = v[bj][n][3];
                v[bj][n][0] = a0 * cs.x - a1 * cs.y; v[bj][n][1] = a0 * cs.y + a1 * cs.x;
                v[bj][n][2] = b0 * cs.z - b1 * cs.w; v[bj][n][3] = b0 * cs.w + b1 * cs.z;
              }
            dst = is_q ? (u16*)(ws + O_Q1) + r * 1024 + (pn * 4 + wc) * 64 : (u16*)(ws + O_K1) + r * 256 + wc * 64;
          } else {
            dst = (is_q ? (u16*)(ws + O_Q0) : (u16*)(ws + O_K0)) + r * 512 + ((pn & 1) * 4 + wc) * 64;
          }
#pragma unroll
          for (int bj = 0; bj < 2; ++bj) *(uint4*)(dst + bj * 32 + 8 * fq) = pack8(v[bj][0], v[bj][1]);
        } else if (pn < 8) {
          u16* dst = zout + r * 1024 + (pn - 4) * 256 + wc * 32 + 8 * fq;
#pragma unroll
          for (int bj = 0; bj < 2; ++bj) *(uint4*)(dst + bj * 128) = pack8(v[bj][0], v[bj][1]);
        } else if (pn < 16) {
          u16* dst = (u16*)(ws + O_XBC) + r * 2048 + (pn - 8) * 256 + wc * 32 + 8 * fq;
#pragma unroll
          for (int bj = 0; bj < 2; ++bj) *(uint4*)(dst + bj * 128) = pack8(v[bj][0], v[bj][1]);
        } else if (wc == 0) {
          float* dst = (float*)(ws + O_DTB) + r * 32 + 8 * fq;
          *(float4*)(dst) = make_float4(v[0][0][0], v[0][0][1], v[0][0][2], v[0][0][3]);
          *(float4*)(dst + 4) = make_float4(v[0][1][0], v[0][1][1], v[0][1][2], v[0][1][3]);
        }
      }
  }
};

struct EpiVT {
  static constexpr bool PERM = true;
  const float* ssq_in; u16* vt; int nh;
  DI void operator()(const AccT& acc, const pg8::Unit& u, int wr, int wc, int fr, int fq, const PG8_LAS float* rtab) const {
#pragma unroll
    for (int bj = 0; bj < 2; ++bj) {
      const int tok0 = u.pn * 256 + bj * 128 + wc * 32 + 8 * fq;
      f32x4 r0 = {1.f, 1.f, 1.f, 1.f}, r1 = r0;
      if (ssq_in) {
        const int lo = bj * 128 + wc * 32 + 8 * fq;
        r0 = *(const PG8_LAS f32x4*)(rtab + lo); r1 = *(const PG8_LAS f32x4*)(rtab + lo + 4);
      }
      const int b = tok0 >> 11, s = tok0 & 2047;
#pragma unroll
      for (int ai = 0; ai < 2; ++ai)
#pragma unroll
        for (int m = 0; m < 4; ++m) {
          const int f = u.pm * 256 + ai * 128 + wr * 64 + m * 16 + fr;
          const int hd = f >> 6, d = f & 63;
          u16* dstp = vt + ((size_t)((b * nh + hd) * 64 + d)) * 2048;
          const uint4 pk = pack8(acc[ai][bj][m][0] * r0, acc[ai][bj][m][1] * r1);
          if (nh == 4) {
            const int c = (s >> 3) & 3, pos0 = (s & ~31) + 16 * (c & 1) + 4 * (c >> 1);
            *(uint2*)(dstp + pos0) = make_uint2(pk.x, pk.y);
            *(uint2*)(dstp + pos0 + 8) = make_uint2(pk.z, pk.w);
          } else {
            *(uint4*)(dstp + s) = pk;
          }
        }
    }
  }
};
enum { EK_RES = 0, EK_SWIGLU = 1, EK_QK0 = 2, EK_QK1 = 3, EK_VT = 4 };
struct EpiAny {
  int kind; bool perm;
  char* ws; u16* zout; const float* qn; const float* kn; const float* ssq_in; float* ssq_out; const float* res_in; float* res_out; u16* xb_out; u16* o16; int nh;
  DI void operator()(const AccT& acc, const pg8::Unit& u, int wr, int wc, int fr, int fq, const PG8_LAS float* rtab) const {
    switch (kind) {
      case EK_RES: { EpiRes e{res_in, xb_out, res_out, ssq_out}; e(acc, u, wr, wc, fr, fq, rtab); } break;
      case EK_SWIGLU: { EpiSwiglu e{ssq_in, o16}; e(acc, u, wr, wc, fr, fq, rtab); } break;
      case EK_QK0: { EpiQK<0> e{ws, zout, qn, kn, ssq_in}; e(acc, u, wr, wc, fr, fq, rtab); } break;
      case EK_QK1: { EpiQK<1> e{ws, zout, qn, kn, ssq_in}; e(acc, u, wr, wc, fr, fq, rtab); } break;
      default: { EpiVT e{ssq_in, o16, nh}; e(acc, u, wr, wc, fr, fq, rtab); } break;
    }
  }
};

__device__ void na_tile(const Params& p, int tile) {
  const int tid = vtid(), lane = tid & 63, wave = tid >> 6, l15 = lane & 15, quad = lane >> 4;
  const int h = tile & 7, r = (tile >> 3) & 31, b = tile >> 8;
  const int c0 = min(max(16 * wave - 8, 0), 32);
  const int rs = min(max(r - 4, 0), 24);
  const u16* Q0 = (const u16*)(p.ws + O_Q0);
  const u16* K0 = (const u16*)(p.ws + O_K0) + (size_t)(b * 2048 + rs * 64 + c0 + 8 * (l15 >> 2) + (l15 & 3)) * 512 + h * 64 + 8 * quad;
  const u16* VT = (const u16*)(p.ws + O_VT0) + (size_t)((b * 8 + h) * 64 + l15) * 2048 + rs * 64 + c0 + 8 * quad;
  u16* mix = (u16*)(p.ws + O_MIX);
  const int tq = b * 2048 + r * 64 + 16 * wave + l15;
  bf16x8 qf[2];
#pragma unroll
  for (int ks = 0; ks < 2; ++ks) qf[ks] = as_bf8(*(const uint4*)(Q0 + (size_t)tq * 512 + h * 64 + 32 * ks + 8 * quad));
  const int cq = 16 * wave + l15;
  const int cs = min(max(cq - 8, 0), 48);
  const float* rpb = p.na_rel_bias + h * 465 + (rs - r + 7) * 31;
  const int d0 = c0 + 8 * quad - cq;
  const int w0 = d0 + cq - cs;
  f32x4 s[16];
  uint4 kb[2][4];
#pragma unroll
  for (int q4 = 0; q4 < 4; ++q4) kb[0][q4] = *(const uint4*)(K0 + (size_t)(4 * (q4 >> 1)) * 512 + 32 * (q4 & 1));
#pragma unroll
  for (int jr = 0; jr < 8; ++jr) {
    if (jr + 1 < 8) {
#pragma unroll
      for (int q4 = 0; q4 < 4; ++q4)
        kb[(jr + 1) & 1][q4] = *(const uint4*)(K0 + (size_t)((jr + 1) * 64 + 4 * (q4 >> 1)) * 512 + 32 * (q4 & 1));
    }
    float bias[8];
#pragma unroll
    for (int e = 0; e < 8; ++e) bias[e] = rpb[jr * 31 + min(max(d0 + 4 * (e >> 2) + (e & 3), -15), 15) + 15];
#pragma unroll
    for (int tt = 0; tt < 2; ++tt) {
      f32x4 a = {0.f, 0.f, 0.f, 0.f};
      a = MFMA(as_bf8(kb[jr & 1][2 * tt]), qf[0], a);
      a = MFMA(as_bf8(kb[jr & 1][2 * tt + 1]), qf[1], a);
#pragma unroll
      for (int rr = 0; rr < 4; ++rr) a[rr] = ((unsigned)(w0 + 4 * tt + rr) < 16u) ? (a[rr] + bias[tt * 4 + rr] * LOG2E) : -INFINITY;
      s[jr * 2 + tt] = a;
    }
  }
  float mx = -INFINITY;
#pragma unroll
  for (int u = 0; u < 16; ++u) mx = fmaxf(mx, fmaxf(fmaxf(s[u][0], s[u][1]), fmaxf(s[u][2], s[u][3])));
  mx = xor16_32_max(mx);
  uint4 vbuf[3][4];
#define NA_VLOAD(jr, dst) do { \
    _Pragma("unroll") for (int i2 = 0; i2 < 4; ++i2) dst[i2] = *(const uint4*)(VT + (size_t)(16 * i2) * 2048 + (jr) * 64); } while (0)
  NA_VLOAD(0, vbuf[0]);
  NA_VLOAD(1, vbuf[1]);
  float sum = 0.f;
#pragma unroll
  for (int u = 0; u < 16; ++u)
#pragma unroll
    for (int rr = 0; rr < 4; ++rr) { float pv = ex2(s[u][rr] - mx); s[u][rr] = pv; sum += pv; }
  sum = xor16_32_sum(sum);
  f32x4 o[4];
#pragma unroll
  for (int i2 = 0; i2 < 4; ++i2) o[i2] = (f32x4){0.f, 0.f, 0.f, 0.f};
#pragma unroll
  for (int jr = 0; jr < 8; ++jr) {
    if (jr + 2 < 8) NA_VLOAD(jr + 2, vbuf[(jr + 2) % 3]);
    bf16x8 pf = cat_bf8(pack4(s[2 * jr]), pack4(s[2 * jr + 1]));
#pragma unroll
    for (int i2 = 0; i2 < 4; ++i2) o[i2] = MFMA(as_bf8(vbuf[jr % 3][i2]), pf, o[i2]);
  }
#undef NA_VLOAD
  const float inv = 1.f / sum;
#pragma unroll
  for (int i2 = 0; i2 < 4; ++i2) *(uint2*)(mix + (size_t)tq * 1536 + h * 64 + 16 * i2 + 4 * quad) = pack4(o[i2] * inv);
}

__device__ void conv_tile(const Params& p, int tile) {
  const int tb = tile >> 2, cb = tile & 3;
  const int ch = cb * 512 + 2 * vtid();
  const int b = tb >> 5, s0 = (tb & 31) * 64;
  float w[4][2], bias[2];
#pragma unroll
  for (int k = 0; k < 4; ++k) { const float2 t = *(const float2*)(p.conv_w + k * 2048 + ch); w[k][0] = t.x; w[k][1] = t.y; }
  { const float2 t = *(const float2*)(p.conv_b + ch); bias[0] = t.x; bias[1] = t.y; }
  const u16* src = (const u16*)(p.ws + O_XBC) + (size_t)(b * 2048) * 2048 + ch;
  unsigned um2 = (s0 >= 2) ? *(const unsigned*)(src + (size_t)(s0 - 2) * 2048) : 0u;
  unsigned um1 = (s0 >= 1) ? *(const unsigned*)(src + (size_t)(s0 - 1) * 2048) : 0u;
  unsigned u0 = *(const unsigned*)(src + (size_t)s0 * 2048);
  u16* XT = (u16*)p.out + 16 * MIB;
  for (int sg = 0; sg < 8; ++sg) {
    unsigned nx[8];
#pragma unroll
    for (int e = 0; e < 8; ++e) { const int s = s0 + sg * 8 + e; nx[e] = (s + 1 < 2048) ? *(const unsigned*)(src + (size_t)(s + 1) * 2048) : 0u; }
    float y[2][8];
#pragma unroll
    for (int e = 0; e < 8; ++e) {
      const unsigned up1 = nx[e];
      y[0][e] = silu(w[0][0] * bflo(um2) + w[1][0] * bflo(um1) + w[2][0] * bflo(u0) + w[3][0] * bflo(up1) + bias[0]);
      y[1][e] = silu(w[0][1] * bfhi(um2) + w[1][1] * bfhi(um1) + w[2][1] * bfhi(u0) + w[3][1] * bfhi(up1) + bias[1]);
      um2 = um1; um1 = u0; u0 = up1;
    }
    const int sb = s0 + sg * 8;
    if (cb < 3) {
      u16* dstT = (cb < 2) ? XT + (size_t)(b * 1024 + ch) * 2048 + sb : (u16*)(p.ws + O_BT) + (size_t)(b * 512 + (ch - 1024)) * 2048 + sb;
#pragma unroll
      for (int c2 = 0; c2 < 2; ++c2)
        *(uint4*)(dstT + (size_t)c2 * 2048) = make_uint4(pack2(y[c2][0], y[c2][1]), pack2(y[c2][2], y[c2][3]), pack2(y[c2][4], y[c2][5]), pack2(y[c2][6], y[c2][7]));
    }
    if (cb >= 2) {
      u16* nat = (cb == 2) ? (u16*)(p.ws + O_BN) + (size_t)(b * 2048 + sb) * 512 + (ch - 1024)
                           : (u16*)(p.ws + O_CN) + (size_t)(b * 2048 + sb) * 512 + (ch - 1536);
#pragma unroll
      for (int e = 0; e < 8; ++e) *(unsigned*)(nat + e * 512) = pack2(y[0][e], y[1][e]);
    }
  }
}

__device__ void scan_item8(const Params& p, char* smem, int item) {
  const int tid = otid(), lane = tid & 63, wave = __builtin_amdgcn_readfirstlane(tid >> 6), l15 = lane & 15, quad = lane >> 4;
  const int dir = item & 1, h = (item >> 1) & 15, b = item >> 5, g = h >> 2;
  const float Ah = -__expf(p.A_log[dir * 16 + h]) * LOG2E;
  PG8_LAS float* wall = (PG8_LAS float*)((PG8_LAS unsigned char*)smem + 65536);
  PG8_LAS float* cdall = wall + 2048;
  const float* dtb = (const float*)(p.ws + O_DTB);
#pragma unroll
  for (int cc = 0; cc < 2; ++cc) {
    const int c = 2 * wave + cc;
    const int tokb = b * 2048 + c * 128;
    const float d0 = dtb[(size_t)(tokb + 2 * lane) * 32 + dir * 16 + h];
    const float d1 = dtb[(size_t)(tokb + 2 * lane + 1) * 32 + dir * 16 + h];
    const float a0 = d0 * Ah, a1 = d1 * Ah, ps = a0 + a1;
    float incl = ps;
#pragma unroll
    for (int o = 1; o < 64; o <<= 1) { float tv = __shfl_up(incl, o); if (lane >= o) incl += tv; }
    const float total = __shfl(incl, 63);
    const float excl = incl - ps;
    float w0, w1;
    if (dir == 0) { w0 = ex2(total - (excl + a0)) * d0; w1 = ex2(total - incl) * d1; }
    else { w0 = ex2(excl) * d0; w1 = ex2(excl + a0) * d1; }
    wall[c * 128 + 2 * lane] = w0; wall[c * 128 + 2 * lane + 1] = w1;
    if (lane == 0) cdall[c] = ex2(total);
  }
  __syncthreads();
  const int drow = 8 * wave + (lane >> 4);
  const u16* XTg = (const u16*)p.out + 16 * MIB + (size_t)(b * 1024 + h * 64) * 2048;
  const char* xsrc0 = (const char*)(XTg + (size_t)drow * 2048) + (((lane & 15) ^ (drow & 15)) << 4);
  const char* xsrc1 = (const char*)(XTg + (size_t)(drow + 4) * 2048) + (((lane & 15) ^ ((drow + 4) & 15)) << 4);
  PG8_LAS unsigned char* lds = (PG8_LAS unsigned char*)smem;
  const u16* BT = (const u16*)(p.ws + O_BT) + (size_t)(b * 512 + g * 128 + 16 * wave + l15) * 2048 + 8 * quad;
  u16* HP = (u16*)(p.ws + O_HPREV);
  f32x4 acc[4];
#pragma unroll
  for (int j = 0; j < 4; ++j) acc[j] = (f32x4){0.f, 0.f, 0.f, 0.f};
  u32x4v bA[4], bB[4], bC[4], bD[4];
#define SC_ISSUE(Bf, st, c) do { \
    __builtin_amdgcn_global_load_lds((const unsigned*)(xsrc0 + (c) * 256), (PG8_LAS unsigned*)(lds + (st) * 16384 + wave * 2048), 16, 0, 0); \
    __builtin_amdgcn_global_load_lds((const unsigned*)(xsrc1 + (c) * 256), (PG8_LAS unsigned*)(lds + (st) * 16384 + wave * 2048 + 1024), 16, 0, 0); \
    { const u16* _bp = BT + (c) * 128; \
      asm volatile("global_load_dwordx4 %0, %4, off\n\tglobal_load_dwordx4 %1, %4, off offset:64\n\tglobal_load_dwordx4 %2, %4, off offset:128\n\tglobal_load_dwordx4 %3, %4, off offset:192" \
                   : "=&v"(Bf[0]), "=&v"(Bf[1]), "=&v"(Bf[2]), "=&v"(Bf[3]) : "v"(_bp) : "memory"); } } while (0)
#define SC_STEP(Bf, st, c) do { \
    u16* hp = HP + ((size_t)(((b * 16 + (c)) * 16 + h) * 2 + dir) << 13); \
    _Pragma("unroll") for (int j = 0; j < 4; ++j) *(uint2*)(hp + (16 * j + l15) * 128 + 16 * wave + 4 * quad) = pack4(acc[j]); \
    const float cd = cdall[(c)]; \
    _Pragma("unroll") for (int j = 0; j < 4; ++j) acc[j] *= cd; \
    _Pragma("unroll") for (int ks = 0; ks < 4; ++ks) { \
      const f32x4 wav = *(const PG8_LAS f32x4*)(wall + (c) * 128 + 32 * ks + 8 * quad); \
      const f32x4 wbv = *(const PG8_LAS f32x4*)(wall + (c) * 128 + 32 * ks + 8 * quad + 4); \
      const float4 wa = make_float4(wav[0], wav[1], wav[2], wav[3]), wb = make_float4(wbv[0], wbv[1], wbv[2], wbv[3]); \
      _Pragma("unroll") for (int j = 0; j < 4; ++j) { \
        const u32x4v rawv = *(const PG8_LAS u32x4v*)(lds + (st) * 16384 + (16 * j + l15) * 256 + (((4 * ks + quad) ^ l15) << 4)); \
        const uint4 raw = make_uint4(rawv[0], rawv[1], rawv[2], rawv[3]); uint4 sc; \
        sc.x = pack2(bflo(raw.x) * wa.x, bfhi(raw.x) * wa.y); sc.y = pack2(bflo(raw.y) * wa.z, bfhi(raw.y) * wa.w); \
        sc.z = pack2(bflo(raw.z) * wb.x, bfhi(raw.z) * wb.y); sc.w = pack2(bflo(raw.w) * wb.z, bfhi(raw.w) * wb.w); \
        acc[j] = MFMA(__builtin_bit_cast(bf16x8, Bf[ks]), as_bf8(sc), acc[j]); } } } while (0)
#define SC_CH(s) (dir ? 15 - (s) : (s))
  SC_ISSUE(bA, 0, SC_CH(0)); SC_ISSUE(bB, 1, SC_CH(1)); SC_ISSUE(bC, 2, SC_CH(2));
#define SC_BAR() do { asm volatile("" ::: "memory"); __builtin_amdgcn_s_barrier(); asm volatile("" ::: "memory"); } while (0)
#define SC_WAIT(nlast, Bf) do { if (s4 == 12) asm volatile("s_waitcnt vmcnt(" #nlast ")" : "+v"(Bf[0]), "+v"(Bf[1]), "+v"(Bf[2]), "+v"(Bf[3]) :: "memory"); \
    else asm volatile("s_waitcnt vmcnt(18)" : "+v"(Bf[0]), "+v"(Bf[1]), "+v"(Bf[2]), "+v"(Bf[3]) :: "memory"); } while (0)
  for (int s4 = 0; s4 < 16; s4 += 4) {
    SC_ISSUE(bD, 3, SC_CH(s4 + 3));
    SC_WAIT(18, bA); SC_BAR();
    SC_STEP(bA, 0, SC_CH(s4));
    SC_BAR();
    if (s4 + 4 < 16) SC_ISSUE(bA, 0, SC_CH(s4 + 4));
    SC_WAIT(12, bB); SC_BAR();
    SC_STEP(bB, 1, SC_CH(s4 + 1));
    SC_BAR();
    if (s4 + 5 < 16) SC_ISSUE(bB, 1, SC_CH(s4 + 5));
    SC_WAIT(6, bC); SC_BAR();
    SC_STEP(bC, 2, SC_CH(s4 + 2));
    SC_BAR();
    if (s4 + 6 < 16) SC_ISSUE(bC, 2, SC_CH(s4 + 6));
    SC_WAIT(0, bD); SC_BAR();
    SC_STEP(bD, 3, SC_CH(s4 + 3));
    SC_BAR();
  }
#undef SC_BAR
#undef SC_WAIT
#undef SC_ISSUE
#undef SC_STEP
#undef SC_CH
  asm volatile("s_waitcnt vmcnt(0)" ::: "memory");
  __syncthreads();
}

__device__ void ssd_out_tile(const Params& p, char* smem, int tile) {
  const int tid = vtid(), lane = tid & 63, wave = tid >> 6, l15 = lane & 15, quad = lane >> 4;
  const int g = tile & 3, c = (tile >> 2) & 15, b = tile >> 6;
  const int hh = g * 4 + wave;
  u16* Gs = (u16*)smem;
  float* wv = (float*)(smem + 34816) + wave * 512;
  float* red = (float*)(smem + 34816 + 8192);
  const int tok0 = b * 2048 + c * 128;
  const u16* Cn = (const u16*)(p.ws + O_CN) + (size_t)tok0 * 512 + g * 128;
  const u16* Bn = (const u16*)(p.ws + O_BN) + (size_t)tok0 * 512 + g * 128;
  const float* dtb = (const float*)(p.ws + O_DTB);
  {
    f32x4 ga[8][2];
#pragma unroll
    for (int i = 0; i < 8; ++i) { ga[i][0] = (f32x4){0.f, 0.f, 0.f, 0.f}; ga[i][1] = ga[i][0]; }
#pragma unroll 2
    for (int ks = 0; ks < 4; ++ks) {
      bf16x8 cf[2];
#pragma unroll
      for (int jj = 0; jj < 2; ++jj)
        cf[jj] = as_bf8(*(const uint4*)(Cn + (size_t)(16 * (2 * wave + jj) + l15) * 512 + 32 * ks + 8 * quad));
#pragma unroll
      for (int i = 0; i < 8; ++i) {
        bf16x8 bf = as_bf8(*(const uint4*)(Bn + (size_t)(16 * i + l15) * 512 + 32 * ks + 8 * quad));
        ga[i][0] = MFMA(bf, cf[0], ga[i][0]);
        ga[i][1] = MFMA(bf, cf[1], ga[i][1]);
      }
    }
#pragma unroll
    for (int i = 0; i < 8; ++i)
#pragma unroll
      for (int jj = 0; jj < 2; ++jj)
        *(uint2*)(Gs + (16 * (2 * wave + jj) + l15) * 136 + 16 * i + 4 * quad) = pack4(ga[i][jj]);
  }
  {
    const float Af = -__expf(p.A_log[hh]) * LOG2E, Ab = -__expf(p.A_log[16 + hh]) * LOG2E;
    const float d0f = dtb[(size_t)(tok0 + 2 * lane) * 32 + hh], d1f = dtb[(size_t)(tok0 + 2 * lane + 1) * 32 + hh];
    const float d0b = dtb[(size_t)(tok0 + 2 * lane) * 32 + 16 + hh], d1b = dtb[(size_t)(tok0 + 2 * lane + 1) * 32 + 16 + hh];
    const float a0 = d0f * Af, a1 = d1f * Af, c0 = d0b * Ab, c1 = d1b * Ab;
    float inf_ = a0 + a1, inb = c0 + c1;
#pragma unroll
    for (int o = 1; o < 64; o <<= 1) {
      float t1 = __shfl_up(inf_, o), t2 = __shfl_up(inb, o);
      if (lane >= o) { inf_ += t1; inb += t2; }
    }
    const float totb = __shfl(inb, 63);
    const float exf = inf_ - (a0 + a1), exb = inb - (c0 + c1);
    *(float2*)(wv + 2 * lane) = make_float2(exf + a0, inf_);
    *(float2*)(wv + 128 + 2 * lane) = make_float2(totb - exb, totb - (exb + c0));
    *(float2*)(wv + 256 + 2 * lane) = make_float2(d0f, d1f);
    *(float2*)(wv + 384 + 2 * lane) = make_float2(d0b, d1b);
  }
  __syncthreads();
  const float Dh = p.Dskip[hh];
  const u16* XT = (const u16*)p.out + 16 * MIB + (size_t)(b * 1024 + hh * 64) * 2048 + c * 128;
  const u16* hf = (const u16*)(p.ws + O_HPREV) + ((size_t)(((b * 16 + c) * 16 + hh) * 2) << 13);
  const u16* hb = hf + 8192;
  const u16* Z = (const u16*)p.out;
  u16* mix = (u16*)(p.ws + O_MIX);
  #pragma unroll 1
  for (int jh = 0; jh < 2; ++jh) {
    f32x4 y[4][4];
    {
      float efv[4], ebv[4];
#pragma unroll
      for (int j = 0; j < 4; ++j) {
        const int l = 64 * jh + 16 * j + l15;
        efv[j] = ex2(wv[l]); ebv[j] = ex2(wv[128 + l]);
      }
#pragma unroll
      for (int i = 0; i < 4; ++i)
#pragma unroll
        for (int j = 0; j < 4; ++j) y[i][j] = (f32x4){0.f, 0.f, 0.f, 0.f};
#pragma unroll 2
      for (int ks = 0; ks < 4; ++ks) {
        bf16x8 cF[4], cB[4];
#pragma unroll
        for (int j = 0; j < 4; ++j) {
          const uint4 raw = *(const uint4*)(Cn + (size_t)(64 * jh + 16 * j + l15) * 512 + 32 * ks + 8 * quad);
          float f[8];
          unpack8(raw, f);
          cF[j] = as_bf8(make_uint4(pack2(f[0] * efv[j], f[1] * efv[j]), pack2(f[2] * efv[j], f[3] * efv[j]), pack2(f[4] * efv[j], f[5] * efv[j]), pack2(f[6] * efv[j], f[7] * efv[j])));
          cB[j] = as_bf8(make_uint4(pack2(f[0] * ebv[j], f[1] * ebv[j]), pack2(f[2] * ebv[j], f[3] * ebv[j]), pack2(f[4] * ebv[j], f[5] * ebv[j]), pack2(f[6] * ebv[j], f[7] * ebv[j])));
        }
#pragma unroll
        for (int i = 0; i < 4; ++i) {
          bf16x8 f1 = as_bf8(*(const uint4*)(hf + (16 * i + l15) * 128 + 32 * ks + 8 * quad));
          bf16x8 f2 = as_bf8(*(const uint4*)(hb + (16 * i + l15) * 128 + 32 * ks + 8 * quad));
#pragma unroll
          for (int j = 0; j < 4; ++j) { y[i][j] = MFMA(f1, cF[j], y[i][j]); y[i][j] = MFMA(f2, cB[j], y[i][j]); }
        }
      }
    }
#pragma unroll 2
    for (int ks = 0; ks < 4; ++ks) {
      const int sb = 32 * ks + 8 * quad;
      float afs[8], rbs[8], d0s[8], d1s[8];
      *(float4*)(afs) = *(const float4*)(wv + sb); *(float4*)(afs + 4) = *(const float4*)(wv + sb + 4);
      *(float4*)(rbs) = *(const float4*)(wv + 128 + sb); *(float4*)(rbs + 4) = *(const float4*)(wv + 128 + sb + 4);
      *(float4*)(d0s) = *(const float4*)(wv + 256 + sb); *(float4*)(d0s + 4) = *(const float4*)(wv + 256 + sb + 4);
      *(float4*)(d1s) = *(const float4*)(wv + 384 + sb); *(float4*)(d1s + 4) = *(const float4*)(wv + 384 + sb + 4);
      bf16x8 xf[4];
#pragma unroll
      for (int i = 0; i < 4; ++i) xf[i] = as_bf8(*(const uint4*)(XT + (size_t)(16 * i + l15) * 2048 + sb));
#pragma unroll
      for (int j = 0; j < 4; ++j) {
        const int l = 64 * jh + 16 * j + l15;
        const float afl = wv[l], rbl = wv[128 + l];
        float gv[8], m[8];
        unpack8(*(const uint4*)(Gs + l * 136 + sb), gv);
#pragma unroll
        for (int e = 0; e < 8; ++e) {
          const int s = sb + e;
          float ff = (s <= l) ? ex2(afl - afs[e]) * d0s[e] : 0.f;
          float fb = (s >= l) ? ex2(rbl - rbs[e]) * d1s[e] : 0.f;
          m[e] = gv[e] * (ff + fb) + ((s == l) ? Dh : 0.f);
        }
        bf16x8 mf = as_bf8(make_uint4(pack2(m[0], m[1]), pack2(m[2], m[3]), pack2(m[4], m[5]), pack2(m[6], m[7])));
#pragma unroll
        for (int i = 0; i < 4; ++i) y[i][j] = MFMA(xf[i], mf, y[i][j]);
      }
    }
#pragma unroll
    for (int j = 0; j < 4; ++j) {
      const int tok = tok0 + 64 * jh + 16 * j + l15;
      float part = 0.f;
#pragma unroll
      for (int i = 0; i < 4; ++i) {
        uint2 zr = *(const uint2*)(Z + (size_t)tok * 1024 + hh * 64 + 16 * i + 4 * quad);
        float z0 = bflo(zr.x), z1 = bfhi(zr.x), z2 = bflo(zr.y), z3 = bfhi(zr.y);
        y[i][j][0] *= silu(z0); y[i][j][1] *= silu(z1); y[i][j][2] *= silu(z2); y[i][j][3] *= silu(z3);
        part += y[i][j][0] * y[i][j][0] + y[i][j][1] * y[i][j][1] + y[i][j][2] * y[i][j][2] + y[i][j][3] * y[i][j][3];
      }
      part = xor16_32_sum(part);
      if (quad == 0) red[wave * 64 + 16 * j + l15] = part;
    }
    __syncthreads();
#pragma unroll
    for (int j = 0; j < 4; ++j) {
      const int tok = tok0 + 64 * jh + 16 * j + l15;
      const int q = 16 * j + l15;
      const float tot = red[q] + red[64 + q] + red[128 + q] + red[192 + q];
      const float rs = rsqrtf(tot * (1.f / 256.f) + EPS);
#pragma unroll
      for (int i = 0; i < 4; ++i) {
        float4 g4 = *(const float4*)(p.out_norm + hh * 64 + 16 * i + 4 * quad);
        f32x4 o;
        o[0] = y[i][j][0] * rs * g4.x; o[1] = y[i][j][1] * rs * g4.y; o[2] = y[i][j][2] * rs * g4.z; o[3] = y[i][j][3] * rs * g4.w;
        *(uint2*)(mix + (size_t)tok * 1536 + 512 + hh * 64 + 16 * i + 4 * quad) = pack4(o);
      }
    }
    __syncthreads();
  }
}

__device__ void gqa_tile8(const Params& p, char* smem, int tile) {
  const int tid = otid(), lane = tid & 63, wave = __builtin_amdgcn_readfirstlane(tid >> 6), l15 = lane & 15, quad = lane >> 4;
  const int rep = tile & 3, qb = (tile >> 2) & 7, kvh = (tile >> 5) & 3, b = tile >> 7;
  const int h = kvh * 4 + rep;
  const u16* Q1 = (const u16*)(p.ws + O_Q1);
  const u16* K1 = (const u16*)(p.ws + O_K1) + (size_t)(b * 2048) * 256 + kvh * 64;
  const u16* VT = (const u16*)(p.ws + O_VT1) + (size_t)((b * 4 + kvh) * 64) * 2048;
  u16* AO = (u16*)(p.ws + O_AO);
  const int tq0 = b * 2048 + qb * 256 + 32 * wave;
  bf16x8 qf[2][2];
#pragma unroll
  for (int j = 0; j < 2; ++j)
#pragma unroll
    for (int ks = 0; ks < 2; ++ks)
      qf[j][ks] = as_bf8(*(const uint4*)(Q1 + (size_t)(tq0 + 16 * j + l15) * 1024 + h * 64 + 32 * ks + 8 * quad));
  PG8_LAS unsigned char* lds = (PG8_LAS unsigned char*)smem;
  const int kr0 = 16 * wave + (lane >> 3), kr1 = kr0 + 8;
  const char* ksrc0 = (const char*)(K1 + (size_t)kr0 * 256) + ((((lane & 7) ^ ((kr0 >> 1) & 7))) << 4);
  const char* ksrc1 = (const char*)(K1 + (size_t)kr1 * 256) + ((((lane & 7) ^ ((kr1 >> 1) & 7))) << 4);
  const int vr0 = 8 * wave + (lane >> 4), vr1 = vr0 + 4;
  const char* vsrc0 = (const char*)(VT + (size_t)vr0 * 2048) + ((((lane & 15) ^ (vr0 & 15))) << 4);
  const char* vsrc1 = (const char*)(VT + (size_t)vr1 * 2048) + ((((lane & 15) ^ (vr1 & 15))) << 4);
  f32x4 o[4][2];
#pragma unroll
  for (int i = 0; i < 4; ++i) { o[i][0] = (f32x4){0.f, 0.f, 0.f, 0.f}; o[i][1] = o[i][0]; }
  float m[2] = {-1e30f, -1e30f}, lsum[2] = {0.f, 0.f};
#define GQ_ISSUE(t) do { const int _st = (t) & 3; \
    __builtin_amdgcn_global_load_lds((const unsigned*)(ksrc0 + (size_t)(t) * (128 * 512)), (PG8_LAS unsigned*)(lds + _st * 32768 + wave * 2048), 16, 0, 0); \
    __builtin_amdgcn_global_load_lds((const unsigned*)(ksrc1 + (size_t)(t) * (128 * 512)), (PG8_LAS unsigned*)(lds + _st * 32768 + wave * 2048 + 1024), 16, 0, 0); \
    __builtin_amdgcn_global_load_lds((const unsigned*)(vsrc0 + (t) * 256), (PG8_LAS unsigned*)(lds + _st * 32768 + 16384 + wave * 2048), 16, 0, 0); \
    __builtin_amdgcn_global_load_lds((const unsigned*)(vsrc1 + (t) * 256), (PG8_LAS unsigned*)(lds + _st * 32768 + 16384 + wave * 2048 + 1024), 16, 0, 0); } while (0)
#define GQ_BODY(st, hk) do { \
    PG8_LAS const unsigned char* sK = lds + (st) * 32768; PG8_LAS const unsigned char* sV = sK + 16384; \
    f32x4 s[4][2]; \
    _Pragma("unroll") for (int i = 0; i < 4; ++i) { s[i][0] = (f32x4){0.f, 0.f, 0.f, 0.f}; s[i][1] = s[i][0]; } \
    _Pragma("unroll") for (int ks = 0; ks < 2; ++ks) \
      _Pragma("unroll") for (int i = 0; i < 4; ++i) { \
        const int kr = 64 * (hk) + 16 * i + l15; \
        bf16x8 kf = *(PG8_LAS const bf16x8*)(sK + kr * 128 + (((4 * ks + quad) ^ ((kr >> 1) & 7)) << 4)); \
        s[i][0] = MFMA(kf, qf[0][ks], s[i][0]); s[i][1] = MFMA(kf, qf[1][ks], s[i][1]); } \
    bf16x8 pf[2][2]; \
    _Pragma("unroll") for (int j = 0; j < 2; ++j) { \
      float mx = -1e30f; \
      _Pragma("unroll") for (int i = 0; i < 4; ++i) mx = fmaxf(mx, fmaxf(fmaxf(s[i][j][0], s[i][j][1]), fmaxf(s[i][j][2], s[i][j][3]))); \
      mx = xor16_32_max(mx); \
      const float mn = fmaxf(m[j], mx); \
      if (__builtin_amdgcn_ballot_w64(mn > m[j]) != 0ull) { \
        const float alpha = ex2(m[j] - mn); m[j] = mn; lsum[j] *= alpha; \
        _Pragma("unroll") for (int i2 = 0; i2 < 4; ++i2) o[i2][j] *= alpha; } \
      float ps = 0.f; \
      _Pragma("unroll") for (int i = 0; i < 4; ++i) \
        _Pragma("unroll") for (int r = 0; r < 4; ++r) { float pv = ex2(s[i][j][r] - mn); s[i][j][r] = pv; ps += pv; } \
      lsum[j] += ps; \
      pf[j][0] = cat_bf8(pack4(s[0][j]), pack4(s[1][j])); pf[j][1] = cat_bf8(pack4(s[2][j]), pack4(s[3][j])); } \
    _Pragma("unroll") for (int ks2 = 0; ks2 < 2; ++ks2) \
      _Pragma("unroll") for (int i2 = 0; i2 < 4; ++i2) { \
        const int vd = 16 * i2 + l15; \
        bf16x8 vf = *(PG8_LAS const bf16x8*)(sV + vd * 256 + (((8 * (hk) + 4 * ks2 + quad) ^ (vd & 15)) << 4)); \
        o[i2][0] = MFMA(vf, pf[0][ks2], o[i2][0]); o[i2][1] = MFMA(vf, pf[1][ks2], o[i2][1]); } \
  } while (0)
  __syncthreads();
  GQ_ISSUE(0); GQ_ISSUE(1);
  for (int kt = 0; kt < 16; ++kt) {
    if (kt + 2 < 16) GQ_ISSUE(kt + 2);
    if (kt < 14) asm volatile("s_waitcnt vmcnt(8)" ::: "memory");
    else if (kt == 14) asm volatile("s_waitcnt vmcnt(4)" ::: "memory");
    else asm volatile("s_waitcnt vmcnt(0)" ::: "memory");
    asm volatile("" ::: "memory"); __builtin_amdgcn_s_barrier(); asm volatile("" ::: "memory");
    const int st = kt & 3;
    GQ_BODY(st, 0); GQ_BODY(st, 1);
  }
#undef GQ_ISSUE
#undef GQ_BODY
#pragma unroll
  for (int j = 0; j < 2; ++j) {
    const float inv = 1.f / xor16_32_sum(lsum[j]);
    const int tq = tq0 + 16 * j + l15;
#pragma unroll
    for (int i2 = 0; i2 < 4; ++i2) *(uint2*)(AO + (size_t)tq * 1024 + h * 64 + 16 * i2 + 4 * quad) = pack4(o[i2][j] * inv);
  }
}

#ifndef ONLY_PHASE
#define ONLY_PHASE -1
#endif
__device__ void run_phase(const Params& p, char* smem, int ph) {
  if (ONLY_PHASE >= 0 && ph != ONLY_PHASE) return;
  char* ws = p.ws;
  asm volatile("" : "+s"(ws));
  float* ssq = (float*)(ws + O_SSQ);
  u16* xb = (u16*)(ws + O_XB);
  const int half = __builtin_amdgcn_readfirstlane(threadIdx_x_raw() >> 8);
  char* sh = smem + half * 65536;
  const int G = gridDim.x, bid = blockIdx.x;
  const int vb = bid * 2 + half, nvb = G * 2;
  const bool is_gemm = (ph == 1) || (ph >= 5 && ph != 9);
  if (is_gemm) {
    const int nsub = (ph == 1 || ph == 8) ? 2 : 1;
    for (int sub = 0; sub < nsub; ++sub) {
      pg8::Gemm g{}; EpiAny E{}; E.ws = ws; E.zout = (u16*)p.out; E.perm = true; int c = bid;
      E.qn = (ph >= 8) ? p.gqa_q_norm : p.na_q_norm; E.kn = (ph >= 8) ? p.gqa_k_norm : p.na_k_norm;
      const bool l1 = ph >= 8;
      const u16* W13 = (const u16*)(ws + (l1 ? O_W13_1 : O_W13_0));
      const u16* W2 = (const u16*)(ws + (l1 ? O_W2_1 : O_W2_0));
      if (ph == 1 || ph == 8) {
        const float* sq = l1 ? ssq + 2 * T : nullptr;
        if (sub == 0) { g = pg8::Gemm{xb, (const u16*)(ws + (l1 ? O_WQKV1 : O_WIN0)), T, l1 ? 1280 : 4352, 1024}; E.kind = l1 ? EK_QK1 : EK_QK0; E.ssq_in = sq; }
        else { g = pg8::Gemm{(const u16*)(ws + (l1 ? O_WV1 : O_WV0)), xb, l1 ? 256 : 512, T, 1024}; E.kind = EK_VT; E.ssq_in = sq;
               E.o16 = (u16*)(ws + (l1 ? O_VT1 : O_VT0)); E.nh = l1 ? 4 : 8; c = (bid + G - 64) % G; }
      } else if (ph == 5 || ph == 10) {
        g = pg8::Gemm{(const u16*)(ws + (l1 ? O_AO : O_MIX)), (const u16*)(ws + (l1 ? O_WOUT1 : O_WOUT0)), T, 1024, l1 ? 1024 : 1536};
        E.kind = EK_RES; E.perm = false; E.res_in = l1 ? nullptr : p.x; E.res_out = nullptr; E.xb_out = xb; E.ssq_out = ssq + (l1 ? 3 * T : T);
      } else if (ph == 6 || ph == 11) {
        g = pg8::Gemm{xb, W13, T, 5632, 1024}; E.kind = EK_SWIGLU; E.ssq_in = ssq + (l1 ? 3 * T : T); E.o16 = (u16*)(ws + O_H);
      } else {
        g = pg8::Gemm{(const u16*)(ws + O_H), W2, T, 1024, 2816};
        E.kind = EK_RES; E.perm = false; E.res_in = nullptr; E.res_out = l1 ? p.out : nullptr; E.xb_out = xb; E.ssq_out = l1 ? nullptr : ssq + 2 * T;
      }
      pg8::StaticOrder S; S.init(g.M, g.N, G, c);
      pg8::gemm_phase(( PG8_LAS unsigned char*)smem, g, S, E);
      if (ph == 6 && G == 256 && bid >= 128) {
        const int tid = otid();
        phase_prep_l1(p, ws, (bid - 128) * 8 + (tid >> 6), 128 * 8, tid & 63);
      }
    }
    return;
  }
  switch (ph) {
    case 0: phase_prep(p); break;
    case 2: {
      PSUB(4) for (int t = vb; t < 2048; t += nvb) na_tile(p, t);
      PSUB(5) for (int t = vb; t < 1024; t += nvb) conv_tile(p, t);
      float* dtb = (float*)(ws + O_DTB);
      for (int idx = bid * 512 + otid(); idx < T * 32; idx += G * 512) {
        float v = dtb[idx] + p.dt_bias[idx & 31];
        dtb[idx] = (v > 20.f) ? v : log1pf(expf(v));
      }
    } break;
    case 3: {
      for (int t0 = 0; t0 < 256; t0 += G) {
        int item = min(t0 + bid, 255);
        if (G == 256) {
          const int xcd = bid & 7, j = bid >> 3, grp = xcd * 4 + (j >> 3), idx8 = j & 7;
          item = (idx8 & 1) + 2 * ((grp & 3) * 4 + (idx8 >> 1)) + 32 * (grp >> 2);
        }
        scan_item8(p, smem, item);
      }
      if (G != 256) { const int tid = otid(); phase_prep_l1(p, ws, bid * 8 + (tid >> 6), G * 8, tid & 63); }
    } break;
    case 4:
      for (int t0 = 0; t0 < 512; t0 += nvb) ssd_out_tile(p, sh, min(t0 + vb, 511));
      break;
    case 9:
      if (G == 256) {
        const int xcd = bid & 7;
        for (int r = 0; r < 4; ++r) gqa_tile8(p, smem, (r * 8 + xcd) * 32 + (bid >> 3));
      } else {
        for (int t0 = 0; t0 < 1024; t0 += G) gqa_tile8(p, smem, min(t0 + bid, 1023));
      }
      break;
    default: break;
  }
}

#define XB_TMO      128
#define XB_XCNT(j)  (256  + 64 * (j))
#define XB_XSUB(j)  (1280 + 64 * (j))
#define XB_XGEN(j)  (2304 + 64 * (j))
#define XB_TOP      3328
#define XB_TOPGEN   3392
#define XCD_BAR_WORDS 3456
#define XB_SPIN_CAP (1u << 18)
#define LAS __attribute__((address_space(3)))
DI unsigned xb_ld(unsigned* p) { return __hip_atomic_load(p, __ATOMIC_RELAXED, __HIP_MEMORY_SCOPE_AGENT); }
DI unsigned xb_add(unsigned* p, unsigned v) { return __hip_atomic_fetch_add(p, v, __ATOMIC_RELAXED, __HIP_MEMORY_SCOPE_AGENT); }
DI unsigned xb_xcc_id() { return (unsigned)__builtin_amdgcn_s_getreg((3 << 11) | 20) & 0xFu; }
#define XB_SPIN(cond, bar) do { unsigned _sp = 0; while (cond) { __builtin_amdgcn_s_sleep(1); \
    if ((++_sp & 255u) == 0u) { if (xb_ld(&(bar)[XB_TMO])) break; if (_sp > XB_SPIN_CAP) { atomicAdd(&(bar)[XB_TMO], 1u); break; } } } } while (0)
struct XcdBarrier { unsigned* bar; unsigned x; volatile LAS unsigned* st; };
DI XcdBarrier xcd_barrier_post(unsigned* bar, volatile LAS unsigned* st) {
  XcdBarrier b; b.bar = bar; b.x = xb_xcc_id(); b.st = st;
  if (threadIdx_x_raw() == 0) (void)xb_add(&bar[XB_XCNT(b.x)], 1u);
  return b;
}
DI void xcd_barrier_complete(unsigned* bar, unsigned x, unsigned& nloc, unsigned& nx) {
  const unsigned G = gridDim.x * gridDim.y * gridDim.z;
  unsigned sum, cnt, mine, sp = 0u;
  for (;;) {
    sum = 0u; cnt = 0u; mine = 0u;
#pragma unroll
    for (unsigned j = 0; j < 16; ++j) { const unsigned c = xb_ld(&bar[XB_XCNT(j)]); sum += c; cnt += (c > 0u) ? 1u : 0u; mine = (j == x) ? c : mine; }
    if (sum == G) break;
    __builtin_amdgcn_s_sleep(1);
    if ((++sp & 255u) == 0u) { if (xb_ld(&bar[XB_TMO])) break; if (sp > XB_SPIN_CAP) { atomicAdd(&bar[XB_TMO], 1u); break; } }
  }
  nloc = mine > 0u ? mine : 1u; nx = cnt > 0u ? cnt : 1u;
}
DI void xcd_barrier(const XcdBarrier& b) {
  asm volatile("s_waitcnt vmcnt(0)" ::: "memory");
  __syncthreads();
  if (threadIdx_x_raw() == 0) {
    unsigned* bar = b.bar;
    asm volatile("" : "+s"(bar));
    __builtin_amdgcn_s_waitcnt(0);
    unsigned nloc = b.st[0], nx = b.st[1];
    if (nloc == 0u) { xcd_barrier_complete(bar, b.x, nloc, nx); b.st[0] = nloc; b.st[1] = nx; }
    const unsigned old = xb_add(&bar[XB_XSUB(b.x)], 1u);
    const unsigned gen = old / nloc;
    if (old + 1u == (gen + 1u) * nloc) {
      __builtin_amdgcn_fence(__ATOMIC_RELEASE, "agent");
      asm volatile("s_waitcnt vmcnt(0)" ::: "memory");
      const unsigned og = xb_add(&bar[XB_TOP], 1u);
      const unsigned tg = og / nx;
      if (og + 1u == (tg + 1u) * nx) xb_add(&bar[XB_TOPGEN], 1u);
      else XB_SPIN(xb_ld(&bar[XB_TOPGEN]) == tg, bar);
      __builtin_amdgcn_fence(__ATOMIC_ACQUIRE, "agent");
      xb_add(&bar[XB_XGEN(b.x)], 1u);
      asm volatile("s_waitcnt vmcnt(0)" ::: "memory");
    } else {
      XB_SPIN(xb_ld(&bar[XB_XGEN(b.x)]) == gen, bar);
      __builtin_amdgcn_fence(__ATOMIC_ACQUIRE, "agent");
      asm volatile("s_waitcnt vmcnt(0)" ::: "memory");
    }
  }
  __syncthreads();
}

__global__ void __launch_bounds__(512, 2) mega(Params p) {
  extern __shared__ __attribute__((aligned(16))) char smem[];
  __shared__ uint4 xb_words;
  cg::grid_group grid = cg::this_grid();
  if (threadIdx_x_raw() == 0) xb_words = make_uint4(0u, 0u, 0u, 0u);
  __syncthreads();
  XcdBarrier xb = xcd_barrier_post((unsigned*)(p.ws + O_BAR), (volatile LAS unsigned*)&xb_words);
  if (p.ph0 < 0) grid.sync();
  for (int ph = p.ph0; ph < p.ph1; ++ph) {
    int nrep = 1;
#if PROBE_REP_MASK
    if ((PROBE_REP_MASK >> ph) & 1) nrep = 2;
#endif
    for (int r = 0; r < nrep; ++r) {
      run_phase(p, smem, ph);
      if (r + 1 < nrep || ph + 1 < p.ph1) xcd_barrier(xb);
    }
  }
#if PROBE_EXTRA_SYNCS
  for (int i = 0; i < PROBE_EXTRA_SYNCS; ++i) xcd_barrier(xb);
#endif
}

extern "C" void kernel_launch(void* const* d_in, const int* in_sizes, int n_in, void* d_out, int out_size, void* d_ws,
                              size_t ws_size, hipStream_t stream) {
  static int grid_blocks = 0;
  if (!grid_blocks) {
    (void)hipFuncSetAttribute((const void*)mega, hipFuncAttributeMaxDynamicSharedMemorySize, SMEM_BYTES);
    int dev = 0, cus = 0, per_cu = 0;
    (void)hipGetDevice(&dev);
    (void)hipDeviceGetAttribute(&cus, hipDeviceAttributeMultiprocessorCount, dev);
    (void)hipOccupancyMaxActiveBlocksPerMultiprocessor(&per_cu, mega, 512, SMEM_BYTES);
    if (per_cu < 1) per_cu = 1;
    grid_blocks = cus;
  }
  Params p{};
  const float** pp = (const float**)&p;
  for (int i = 0; i < 21; ++i) pp[i] = (const float*)d_in[i];
  p.out = (float*)d_out;
  p.ws = (char*)d_ws;
  (void)hipMemsetAsync((char*)d_ws + O_BAR, 0, XCD_BAR_WORDS * 4, stream);
#if MULTI_LAUNCH
  for (int ph = 0; ph < NPHASE; ++ph) {
    p.ph0 = ph; p.ph1 = ph + 1;
    hipLaunchKernelGGL(mega, dim3(grid_blocks), dim3(512), SMEM_BYTES, stream, p);
  }
#else
  p.ph0 = 0; p.ph1 = NPHASE;
  void* args[] = {&p};
  hipError_t e = hipLaunchCooperativeKernel((const void*)mega, dim3(grid_blocks), dim3(512), args, SMEM_BYTES, stream);
  if (e != hipSuccess) fprintf(stderr, "cooperative launch failed: %s (grid %d)\n", hipGetErrorString(e), grid_blocks);
#endif
}
```

```cpp
#include <hip/hip_runtime.h>
#include <hip/hip_bf16.h>
#include <hip/hip_cooperative_groups.h>
#include <cstdio>
namespace cg = cooperative_groups;

#define PROBE_REP_MASK 0
#define PROBE_EXTRA_SYNCS 0
#define PROBE_SUB 0
#define PSUB(k) for (int _r = 0; _r < ((PROBE_SUB == (k)) ? 2 : 1); ++_r)
#ifndef MULTI_LAUNCH
#define MULTI_LAUNCH 0
#endif

typedef __attribute__((ext_vector_type(8))) short bf16x8;
typedef __attribute__((ext_vector_type(4))) float f32x4;
typedef __attribute__((ext_vector_type(2))) float f32x2;
typedef __attribute__((ext_vector_type(2))) __bf16 bf16v2;
typedef unsigned short u16;
typedef unsigned u32x4v __attribute__((ext_vector_type(4)));

#define DI __device__ __forceinline__
#define MFMA(a, b, c) __builtin_amdgcn_mfma_f32_16x16x32_bf16((a), (b), (c), 0, 0, 0)

constexpr int T = 16384;
constexpr float EPS = 1e-6f;
constexpr float LOG2E = 1.4426950408889634f;
constexpr int NPHASE = 13;
constexpr int SMEM_BYTES = 131072 + 8192;

constexpr size_t MIB = 1u << 20;
constexpr size_t O_WIN0 = 0;
constexpr size_t O_WV0 = O_WIN0 + 4352ull * 1024 * 2;
constexpr size_t O_WOUT0 = O_WV0 + 512ull * 1024 * 2;
constexpr size_t O_W13_0 = O_WOUT0 + 1024ull * 1536 * 2;
constexpr size_t O_W2_0 = O_W13_0 + 5632ull * 1024 * 2;
constexpr size_t O_ROPE = 31 * MIB;
constexpr size_t O_DTB = O_ROPE + 524288;
constexpr size_t O_SSQ = O_DTB + 2097152;
constexpr size_t O_BAR = O_SSQ + 262144;
constexpr size_t O_XB = 34 * MIB;
constexpr size_t O_BN = O_XB;
constexpr size_t O_BT = O_XB + 16 * MIB;
constexpr size_t O_Q0 = 66 * MIB;
constexpr size_t O_K0 = 82 * MIB;
constexpr size_t O_VT0 = 98 * MIB;
constexpr size_t O_WQKV1 = 66 * MIB;
constexpr size_t O_WV1 = O_WQKV1 + 1280ull * 1024 * 2;
constexpr size_t O_WOUT1 = O_WV1 + 256ull * 1024 * 2;
constexpr size_t O_W13_1 = O_WOUT1 + 1024ull * 1024 * 2;
constexpr size_t O_W2_1 = O_W13_1 + 5632ull * 1024 * 2;
constexpr size_t O_BIG = 114 * MIB;
constexpr size_t O_XBC = O_BIG;
constexpr size_t O_HPREV = O_BIG;
constexpr size_t O_CN = O_BIG + 64 * MIB;
constexpr size_t O_MIX = O_BIG + 80 * MIB;
constexpr size_t O_H = O_BIG;
constexpr size_t O_Q1 = O_BIG;
constexpr size_t O_K1 = O_BIG + 32 * MIB;
constexpr size_t O_VT1 = O_BIG + 40 * MIB;
constexpr size_t O_AO = O_BIG + 48 * MIB;

struct Params {
  const float *x, *even_mix_norm, *even_w_in, *na_q_norm, *na_k_norm, *na_rel_bias, *conv_w, *conv_b, *dt_bias, *A_log,
      *Dskip, *out_norm, *even_w_out, *odd_mix_norm, *odd_w_qkv, *gqa_q_norm, *gqa_k_norm, *odd_w_out, *ffn_norm,
      *ffn_w13, *ffn_w2;
  float* out;
  char* ws;
  int ph0, ph1;
};

__device__ __forceinline__ int threadIdx_x_raw() { return (int)__builtin_amdgcn_workitem_id_x(); }
DI unsigned pack2(float a, float b) {
  f32x2 v = {a, b};
  bf16v2 r = __builtin_convertvector(v, bf16v2);
  return __builtin_bit_cast(unsigned, r);
}
DI uint2 pack4(f32x4 v) { return make_uint2(pack2(v[0], v[1]), pack2(v[2], v[3])); }
DI u16 f2bf(float a) { return (u16)(pack2(a, 0.f) & 0xffffu); }
DI float bflo(unsigned u) { return __uint_as_float(u << 16); }
DI float bfhi(unsigned u) { return __uint_as_float(u & 0xffff0000u); }
DI float bf2f(u16 h) { return __uint_as_float(((unsigned)h) << 16); }
DI bf16x8 as_bf8(uint4 v) { return __builtin_bit_cast(bf16x8, v); }
DI bf16x8 cat_bf8(uint2 a, uint2 b) { return as_bf8(make_uint4(a.x, a.y, b.x, b.y)); }
DI int vtid() { int t = threadIdx_x_raw() & 255; asm volatile("" : "+v"(t)); return t; }
DI int otid() { int t = threadIdx_x_raw(); asm volatile("" : "+v"(t)); return t; }
DI float silu(float x) { return x / (1.f + __expf(-x)); }
DI float ex2(float x) { return __builtin_amdgcn_exp2f(x); }
DI float xor16_32_sum(float v) { v += __shfl_xor(v, 16); v += __shfl_xor(v, 32); return v; }
DI float xor16_32_max(float v) { v = fmaxf(v, __shfl_xor(v, 16)); v = fmaxf(v, __shfl_xor(v, 32)); return v; }
DI void wave_sync_lds() { __builtin_amdgcn_fence(__ATOMIC_ACQ_REL, "wavefront"); __builtin_amdgcn_wave_barrier(); }
DI void unpack8(uint4 u, float* f) {
  f[0] = bflo(u.x); f[1] = bfhi(u.x); f[2] = bflo(u.y); f[3] = bfhi(u.y);
  f[4] = bflo(u.z); f[5] = bfhi(u.z); f[6] = bflo(u.w); f[7] = bfhi(u.w);
}

struct WDesc { const float* W; int ldn, K, rows; u16* dst; const float* gain; int mode, coloff; };
DI int wt_srccol(int mode, int R, int coloff) {
  if (mode == 0) return coloff + R;
  const int pn = R >> 8, c = R & 255, bj = c >> 7, j = c & 127;
  if (mode == 1) return bj * 2816 + pn * 128 + j;
  const int wc = j >> 5, e = j & 31;
  if (mode == 2) {
    if (pn < 4) return (pn >> 1) * 512 + ((pn & 1) * 4 + wc) * 64 + bj * 32 + e;
    if (pn < 8) return 1536 + (R - 1024);
    if (pn < 16) return 2560 + (R - 2048);
    return (R - 4096 < 32) ? 4608 + (R - 4096) : -1;
  }
  if (pn < 4) return (pn * 4 + wc) * 64 + bj * 32 + e;
  return 1024 + wc * 64 + bj * 32 + e;
}
__device__ void wt_item(const WDesc& d, int item, int lane) {
  const int nr = d.rows >> 6, nn = item % nr, kk = item / nr;
  const int R = nn * 64 + lane;
  const int sc = wt_srccol(d.mode, R, d.coloff);
  const float* src = d.W + (sc >= 0 ? sc : 0);
  u16* dst = d.dst + (size_t)R * d.K + kk * 64;
#pragma unroll 2
  for (int k8 = 0; k8 < 8; ++k8) {
    float v[8];
#pragma unroll
    for (int e = 0; e < 8; ++e) {
      const int k = kk * 64 + k8 * 8 + e;
      float x = src[(size_t)k * d.ldn];
      if (d.gain) x *= d.gain[k];
      v[e] = (sc >= 0) ? x : 0.f;
    }
    *(uint4*)(dst + k8 * 8) = make_uint4(pack2(v[0], v[1]), pack2(v[2], v[3]), pack2(v[4], v[5]), pack2(v[6], v[7]));
  }
}
DI WDesc wt_desc(const Params& p, char* ws, int set, int i) {
  if (set == 0) {
    switch (i) {
      case 0: return WDesc{p.even_w_in, 4640, 1024, 4352, (u16*)(ws + O_WIN0), p.even_mix_norm, 2, 0};
      case 1: return WDesc{p.even_w_in, 4640, 1024, 512, (u16*)(ws + O_WV0), p.even_mix_norm, 0, 1024};
      case 2: return WDesc{p.even_w_out, 1024, 1536, 1024, (u16*)(ws + O_WOUT0), nullptr, 0, 0};
      case 3: return WDesc{p.ffn_w13, 5632, 1024, 5632, (u16*)(ws + O_W13_0), p.ffn_norm, 1, 0};
      default: return WDesc{p.ffn_w2, 1024, 2816, 1024, (u16*)(ws + O_W2_0), nullptr, 0, 0};
    }
  }
  switch (i) {
    case 0: return WDesc{p.odd_w_qkv, 1536, 1024, 1280, (u16*)(ws + O_WQKV1), p.odd_mix_norm, 3, 0};
    case 1: return WDesc{p.odd_w_qkv, 1536, 1024, 256, (u16*)(ws + O_WV1), p.odd_mix_norm, 0, 1280};
    case 2: return WDesc{p.odd_w_out, 1024, 1024, 1024, (u16*)(ws + O_WOUT1), nullptr, 0, 0};
    case 3: return WDesc{p.ffn_w13 + (size_t)1024 * 5632, 5632, 1024, 5632, (u16*)(ws + O_W13_1), p.ffn_norm + 1024, 1, 0};
    default: return WDesc{p.ffn_w2 + (size_t)2816 * 1024, 1024, 2816, 1024, (u16*)(ws + O_W2_1), nullptr, 0, 0};
  }
}
__device__ void wt_run(const Params& p, char* ws, int set, int gw, int nw, int lane) {
  const int c0 = set ? 320 : 1088, c1 = c0 + (set ? 64 : 128), c2 = c1 + (set ? 256 : 384), c3 = c2 + 1408, total = c3 + 704;
  for (int it = gw; it < total; it += nw) {
    const int i = it < c0 ? 0 : it < c1 ? 1 : it < c2 ? 2 : it < c3 ? 3 : 4;
    const int base = i == 0 ? 0 : i == 1 ? c0 : i == 2 ? c1 : i == 3 ? c2 : c3;
    const WDesc d = wt_desc(p, ws, set, i);
    wt_item(d, it - base, lane);
  }
}

__device__ void phase_prep(const Params& p) {
  char* ws = p.ws;
  asm volatile("" : "+s"(ws));
  const int tid = otid(), lane = tid & 63;
  const int gw = blockIdx.x * 8 + (tid >> 6), nw = gridDim.x * 8;
  PSUB(1) wt_run(p, ws, 0, gw, nw, lane);
  PSUB(2) for (int row0 = gw * 4; row0 < T; row0 += nw * 4) {
    float4 v[4][4];
#pragma unroll
    for (int rr = 0; rr < 4; ++rr)
#pragma unroll
      for (int i = 0; i < 4; ++i) v[rr][i] = *(const float4*)(p.x + (size_t)(row0 + rr) * 1024 + i * 256 + lane * 4);
#pragma unroll
    for (int rr = 0; rr < 4; ++rr) {
      u16* xb = (u16*)(ws + O_XB) + (size_t)(row0 + rr) * 1024;
      float ss = 0.f;
#pragma unroll
      for (int i = 0; i < 4; ++i) { const float4 a = v[rr][i]; ss += a.x * a.x + a.y * a.y + a.z * a.z + a.w * a.w; }
#pragma unroll
      for (int o = 32; o >= 1; o >>= 1) ss += __shfl_xor(ss, o);
      const float rs = rsqrtf(ss * (1.f / 1024.f) + EPS);
#pragma unroll
      for (int i = 0; i < 4; ++i) {
        const float4 a = v[rr][i];
        *(uint2*)(xb + i * 256 + lane * 4) = make_uint2(pack2(a.x * rs, a.y * rs), pack2(a.z * rs, a.w * rs));
      }
      if (lane == 0) {
        float* ssq = (float*)(ws + O_SSQ);
        const int row = row0 + rr;
        ssq[row] = ss; ssq[T + row] = 0.f; ssq[2 * T + row] = 0.f; ssq[3 * T + row] = 0.f;
      }
    }
  }
  PSUB(3) for (int idx = blockIdx.x * 512 + tid; idx < 65536; idx += gridDim.x * 512) {
    int s = idx >> 5, pp = idx & 31;
    float pos = (pp < 16) ? (float)(s >> 6) : (float)(s & 63);
    float freq = powf(10000.f, -(float)(pp & 15) / 16.f);
    float sn, cs;
    sincosf(pos * freq, &sn, &cs);
    ((float2*)(ws + O_ROPE))[idx] = make_float2(cs, sn);
  }
}
__device__ void phase_prep_l1(const Params& p, char* ws, int gw, int nw, int lane) { wt_run(p, ws, 1, gw, nw, lane); }
namespace pg8 {
#define PG8_LAS __attribute__((address_space(3)))
typedef unsigned short bf16_t;
constexpr int BM = 256, BK = 64, HALF = 128, HTB = HALF * BK * 2, STAGE_BYTES = 8 * HTB, NXCD = 8, WGM = 8;
DI int lds_byte(int r, int c) { const int st = (r >> 4) * 2 + (c >> 5), rr = r & 15, cc = c & 31, ob = rr * 64 + cc * 2; return st * 1024 + (ob ^ (((ob >> 9) & 1) << 5)); }
DI void stage_rc(int b, int& R, int& C) { const int st = b / 1024, sb = b % 1024, swz = sb ^ (((sb >> 9) & 1) << 5); R = (st >> 1) * 16 + swz / 64; C = (st & 1) * 32 + (swz % 64) / 2; }
DI int perm32(int rho) { const int n = rho >> 4, i = rho & 15; return 8 * (i >> 2) + 4 * n + (i & 3); }
struct Unit { int pm, pn; };
struct Gemm { const bf16_t* A; const bf16_t* Bt; int M, N, K; };
struct StaticOrder {
  int nM, nN, nwg, G, c;
  DI void init(int M, int N, int G_, int c_) { nM = M / BM; nN = N / BM; nwg = nM * nN; G = G_; c = c_; }
  DI bool next(int i, Unit& u) const {
    const long L = (long)i * G + c; if (L >= nwg) return false;
    int wgid = (int)L; { const int q = nwg / NXCD, r = nwg % NXCD, xcd = wgid % NXCD, off = wgid / NXCD; wgid = (xcd < r ? xcd * (q + 1) : r * (q + 1) + (xcd - r) * q) + off; }
    const int nig = WGM * nN, gid = wgid / nig, fm = gid * WGM, gsz = (nM - fm) < WGM ? (nM - fm) : WGM;
    u.pm = fm + ((wgid % nig) % gsz); u.pn = (wgid % nig) / gsz; return true;
  }
};
template <class Epi>
DI void gemm_phase(PG8_LAS unsigned char* lds, const Gemm g, const StaticOrder& S, const Epi& E) {
  const int tid = otid(), wid = __builtin_amdgcn_readfirstlane(tid >> 6), lane = tid & 63, wr = wid >> 2, wc = wid & 3, fr = lane & 15, fq = lane >> 4;
  const int K = g.K, nt = K / BK;
  unsigned voffA[2], voffB[2];
#pragma unroll
  for (int i = 0; i < 2; ++i) { int R, C; stage_rc(tid * 16 + i * 8192, R, C); const int Rb = E.perm ? ((R & ~31) + perm32(R & 31)) : R;
    voffA[i] = (unsigned)(R * K + C) * 2u; voffB[i] = (unsigned)(Rb * K + C) * 2u; }
  const size_t kstep = (size_t)(BK * 2);
  const size_t hstep = (size_t)HALF * K * 2;
  const size_t tstep = 2 * hstep;
  const unsigned ldsw = (unsigned)wid * 1024u;
  const int aoff = lds_byte(wr * 64 + fr, fq * 8), boff = lds_byte(wc * 32 + fr, fq * 8);
#define PG8_SA(b, h) (((b) * 2 + (h)) * HTB)
#define PG8_SB(b, h) ((4 + (b) * 2 + (h)) * HTB)
#define PG8_STAGE(bufoff, gbase, voff) do { _Pragma("unroll") for (int _i = 0; _i < 2; ++_i) \
    __builtin_amdgcn_global_load_lds((const unsigned*)((const char*)(gbase) + (voff)[_i]), (PG8_LAS unsigned*)(lds + (bufoff) + ldsw + _i * 8192), 16, 0, 0); } while (0)
#define PG8_LDA(dst, b, h) do { _Pragma("unroll") for (int m = 0; m < 4; ++m) _Pragma("unroll") for (int k = 0; k < 2; ++k) dst[m][k] = *(const PG8_LAS bf16x8*)(lds + PG8_SA(b, h) + aoff + m * 2048 + k * 1024); } while (0)
#define PG8_LDB(dst, b, h) do { _Pragma("unroll") for (int n = 0; n < 2; ++n) _Pragma("unroll") for (int k = 0; k < 2; ++k) dst[n][k] = *(const PG8_LAS bf16x8*)(lds + PG8_SB(b, h) + boff + n * 2048 + k * 1024); } while (0)
#define PG8_MMA(ai, bj, At, Bt) do { __builtin_amdgcn_s_setprio(1); _Pragma("unroll") for (int m = 0; m < 4; ++m) _Pragma("unroll") for (int n = 0; n < 2; ++n) _Pragma("unroll") for (int k = 0; k < 2; ++k) \
    acc[ai][bj][m][n] = __builtin_amdgcn_mfma_f32_16x16x32_bf16(Bt[n][k], At[m][k], acc[ai][bj][m][n], 0, 0, 0); __builtin_amdgcn_s_setprio(0); } while (0)
#define PG8_WAIT_V(n) asm volatile("s_waitcnt vmcnt(" #n ")" ::: "memory")
#define PG8_WAIT_L(n) asm volatile("s_waitcnt lgkmcnt(" #n ")" ::: "memory")
#define PG8_BAR __builtin_amdgcn_s_barrier()
#define PG8_SCHED __builtin_amdgcn_sched_barrier(0)
  Unit cur, nxt; int ui = 0;
  if (!S.next(0, cur)) return;
  if (E.ssq_in) {
    PG8_LAS float* rtab = (PG8_LAS float*)(lds + 131072);
    Unit uu;
    for (int q = 0; q < 8 && S.next(q, uu); ++q)
      if (tid < 256) rtab[q * 256 + tid] = rsqrtf(E.ssq_in[(E.kind == 4 ? uu.pn : uu.pm) * 256 + tid] * (1.f / 1024.f) + EPS);
    __syncthreads();
  }
  f32x4 acc[2][2][4][2];
#pragma unroll
  for (int a = 0; a < 2; ++a)
#pragma unroll
    for (int b = 0; b < 2; ++b)
#pragma unroll
      for (int m = 0; m < 4; ++m)
#pragma unroll
        for (int n = 0; n < 2; ++n) acc[a][b][m][n] = (f32x4){0.f, 0.f, 0.f, 0.f};
  bf16x8 At[4][2], B0[2][2], B1[2][2];
  const char* cA = (const char*)g.A + (size_t)cur.pm * tstep; const char* cB = (const char*)g.Bt + (size_t)cur.pn * tstep;
  PG8_STAGE(PG8_SB(0, 0), cB, voffB); PG8_STAGE(PG8_SA(0, 0), cA, voffA); PG8_STAGE(PG8_SB(0, 1), cB + hstep, voffB); PG8_STAGE(PG8_SA(0, 1), cA + hstep, voffA);
  if (wr == 1) PG8_BAR;
  PG8_WAIT_V(4); PG8_BAR;
  PG8_STAGE(PG8_SB(1, 0), cB + kstep, voffB); PG8_STAGE(PG8_SA(1, 0), cA + kstep, voffA); PG8_STAGE(PG8_SB(1, 1), cB + hstep + kstep, voffB);
  PG8_WAIT_V(6); PG8_BAR;
  for (;;) {
    const bool has_next = S.next(ui + 1, nxt);
    const char* nA = has_next ? (const char*)g.A + (size_t)nxt.pm * tstep : cA; const char* nB = has_next ? (const char*)g.Bt + (size_t)nxt.pn * tstep : cB;
    for (int t = 0; t < nt; t += 2) {
      const bool last = (t == nt - 2);
      const char* a1 = cA + (size_t)(t + 1) * kstep;
      const char* a2 = last ? nA : cA + (size_t)(t + 2) * kstep; const char* b2 = last ? nB : cB + (size_t)(t + 2) * kstep;
      const char* a3 = a2 + kstep; const char* b3 = b2 + kstep;
      PG8_LDB(B0, 0, 0); PG8_SCHED; PG8_LDA(At, 0, 0); PG8_STAGE(PG8_SA(1, 1), a1 + hstep, voffA);
      PG8_WAIT_L(8); PG8_BAR; PG8_WAIT_L(0); PG8_MMA(0, 0, At, B0); PG8_BAR; PG8_SCHED;
      PG8_LDB(B1, 0, 1); PG8_STAGE(PG8_SB(0, 0), b2, voffB);
      PG8_BAR; PG8_WAIT_L(0); PG8_MMA(0, 1, At, B1); PG8_BAR;
      PG8_LDA(At, 0, 1); PG8_STAGE(PG8_SA(0, 0), a2, voffA);
      PG8_BAR; PG8_WAIT_L(0); PG8_MMA(1, 0, At, B0); PG8_BAR; PG8_SCHED;
      PG8_STAGE(PG8_SB(0, 1), b2 + hstep, voffB);
      PG8_WAIT_V(6); PG8_BAR; PG8_MMA(1, 1, At, B1); PG8_BAR;
      PG8_LDB(B0, 1, 0); PG8_SCHED; PG8_LDA(At, 1, 0); PG8_STAGE(PG8_SA(0, 1), a2 + hstep, voffA);
      PG8_WAIT_L(8); PG8_BAR; PG8_WAIT_L(0); PG8_MMA(0, 0, At, B0); PG8_BAR; PG8_SCHED;
      PG8_LDB(B1, 1, 1); PG8_STAGE(PG8_SB(1, 0), b3, voffB);
      PG8_BAR; PG8_WAIT_L(0); PG8_MMA(0, 1, At, B1); PG8_BAR;
      PG8_LDA(At, 1, 1); PG8_STAGE(PG8_SA(1, 0), a3, voffA);
      PG8_BAR; PG8_WAIT_L(0); PG8_MMA(1, 0, At, B0); PG8_BAR; PG8_SCHED;
      PG8_STAGE(PG8_SB(1, 1), b3 + hstep, voffB);
      PG8_WAIT_V(6); PG8_BAR; PG8_MMA(1, 1, At, B1); PG8_BAR;
    }
    E(acc, cur, wr, wc, fr, fq, (const PG8_LAS float*)(lds + 131072) + ui * 256);
    if (!has_next) break;
#pragma unroll
    for (int a = 0; a < 2; ++a)
#pragma unroll
      for (int b = 0; b < 2; ++b)
#pragma unroll
        for (int m = 0; m < 4; ++m)
#pragma unroll
          for (int n = 0; n < 2; ++n) acc[a][b][m][n] = (f32x4){0.f, 0.f, 0.f, 0.f};
    cur = nxt; cA = nA; cB = nB; ++ui;
  }
  PG8_WAIT_V(0);
  if (wr == 0) PG8_BAR;
  PG8_BAR;
#undef PG8_SA
#undef PG8_SB
#undef PG8_STAGE
#undef PG8_LDA
#undef PG8_LDB
#undef PG8_MMA
#undef PG8_WAIT_V
#undef PG8_WAIT_L
#undef PG8_BAR
#undef PG8_SCHED
}
}

typedef f32x4 AccT[2][2][4][2];
DI uint4 pack8(f32x4 a, f32x4 b) { return make_uint4(pack2(a[0], a[1]), pack2(a[2], a[3]), pack2(b[0], b[1]), pack2(b[2], b[3])); }

struct EpiRes {
  static constexpr bool PERM = false;
  const float* res_f32; u16* xb; float* out_f32; float* ssq_out;
  DI void operator()(const AccT& acc, const pg8::Unit& u, int wr, int wc, int fr, int fq, const PG8_LAS float* rtab) const {
    const int row0 = u.pm * 256 + wr * 64 + fr, col0 = u.pn * 256 + wc * 32 + 4 * fq;
#pragma unroll
    for (int ai = 0; ai < 2; ++ai)
#pragma unroll
      for (int m = 0; m < 4; ++m) {
        const size_t r = row0 + ai * 128 + m * 16;
        float part = 0.f;
#pragma unroll
        for (int bj = 0; bj < 2; ++bj)
#pragma unroll
          for (int n = 0; n < 2; ++n) {
            const int c = col0 + bj * 128 + n * 16;
            float4 r4;
            if (res_f32) r4 = *(const float4*)(res_f32 + r * 1024 + c);
            else { uint2 rr = *(const uint2*)(xb + r * 1024 + c); r4 = make_float4(bflo(rr.x), bfhi(rr.x), bflo(rr.y), bfhi(rr.y)); }
            f32x4 a = acc[ai][bj][m][n];
            float4 v = make_float4(r4.x + a[0], r4.y + a[1], r4.z + a[2], r4.w + a[3]);
            if (out_f32) *(float4*)(out_f32 + r * 1024 + c) = v;
            else *(uint2*)(xb + r * 1024 + c) = make_uint2(pack2(v.x, v.y), pack2(v.z, v.w));
            part += v.x * v.x + v.y * v.y + v.z * v.z + v.w * v.w;
          }
        if (ssq_out) {
          part = xor16_32_sum(part);
          if (fq == 0) atomicAdd(ssq_out + r, part);
        }
      }
  }
};

struct EpiSwiglu {
  static constexpr bool PERM = true;
  const float* ssq_in; u16* h_out;
  DI void operator()(const AccT& acc, const pg8::Unit& u, int wr, int wc, int fr, int fq, const PG8_LAS float* rtab) const {
    const int row0 = u.pm * 256 + wr * 64 + fr;
#pragma unroll
    for (int ai = 0; ai < 2; ++ai)
#pragma unroll
      for (int m = 0; m < 4; ++m) {
        const size_t r = row0 + ai * 128 + m * 16;
        const float rs = rtab[ai * 128 + wr * 64 + m * 16 + fr];
        f32x4 h0, h1;
#pragma unroll
        for (int e = 0; e < 4; ++e) {
          h0[e] = silu(acc[ai][0][m][0][e] * rs) * (acc[ai][1][m][0][e] * rs);
          h1[e] = silu(acc[ai][0][m][1][e] * rs) * (acc[ai][1][m][1][e] * rs);
        }
        *(uint4*)(h_out + r * 2816 + u.pn * 128 + wc * 32 + 8 * fq) = pack8(h0, h1);
      }
  }
};

template <int L1>
struct EpiQK {
  static constexpr bool PERM = true;
  char* ws; u16* zout; const float* qn; const float* kn; const float* ssq_in;
  DI void operator()(const AccT& acc, const pg8::Unit& u, int wr, int wc, int fr, int fq, const PG8_LAS float* rtab) const {
    const int pn = u.pn;
    const int row0 = u.pm * 256 + wr * 64 + fr;
    const bool headnorm = L1 ? true : (pn < 4);
    const bool is_q = L1 ? (pn < 4) : (pn < 2);
#pragma unroll
    for (int ai = 0; ai < 2; ++ai)
#pragma unroll
      for (int m = 0; m < 4; ++m) {
        const size_t r = row0 + ai * 128 + m * 16;
        const float rs = L1 ? rtab[ai * 128 + wr * 64 + m * 16 + fr] : 1.f;
        f32x4 v[2][2];
#pragma unroll
        for (int bj = 0; bj < 2; ++bj)
#pragma unroll
          for (int n = 0; n < 2; ++n) v[bj][n] = acc[ai][bj][m][n] * rs;
        if (headnorm) {
          float ss = 0.f;
#pragma unroll
          for (int bj = 0; bj < 2; ++bj)
#pragma unroll
            for (int n = 0; n < 2; ++n)
              ss += v[bj][n][0] * v[bj][n][0] + v[bj][n][1] * v[bj][n][1] + v[bj][n][2] * v[bj][n][2] + v[bj][n][3] * v[bj][n][3];
          ss = xor16_32_sum(ss);
          const float hn = rsqrtf(ss * (1.f / 64.f) + EPS) * (is_q ? 0.125f * LOG2E : 1.f);
          const float* gn = is_q ? qn : kn;
#pragma unroll
          for (int bj = 0; bj < 2; ++bj)
#pragma unroll
            for (int n = 0; n < 2; ++n) {
              float4 g4 = *(const float4*)(gn + bj * 32 + 8 * fq + 4 * n);
              v[bj][n][0] *= hn * g4.x; v[bj][n][1] *= hn * g4.y; v[bj][n][2] *= hn * g4.z; v[bj][n][3] *= hn * g4.w;
            }
          u16* dst;
          if (L1) {
            const int s = (int)(r & 2047);
            const float4* rt = (const float4*)(ws + O_ROPE) + (size_t)s * 16;
#pragma unroll
            for (int bj = 0; bj < 2; ++bj)
#pragma unroll
              for (int n = 0; n < 2; ++n) {
                float4 cs = rt[bj * 8 + 2 * fq + n];
                float a0 = v[bj][n][0], a1 = v[bj][n][1], b0 = v[bj][n][2], b1 = v[bj][n][3];
                v[bj][n][0] = a0 * cs.x - a1 * cs.y; v[bj][n][1] = a0 * cs.y + a1 * cs.x;
                v[bj][n][2] = b0 * cs.z - b1 * cs.w; v[bj][n][3] = b0 * cs.w + b1 * cs.z;
              }
            dst = is_q ? (u16*)(ws + O_Q1) + r * 1024 + (pn * 4 + wc) * 64 : (u16*)(ws + O_K1) + r * 256 + wc * 64;
          } else {
            dst = (is_q ? (u16*)(ws + O_Q0) : (u16*)(ws + O_K0)) + r * 512 + ((pn & 1) * 4 + wc) * 64;
          }
#pragma unroll
          for (int bj = 0; bj < 2; ++bj) *(uint4*)(dst + bj * 32 + 8 * fq) = pack8(v[bj][0], v[bj][1]);
        } else if (pn < 8) {
          u16* dst = zout + r * 1024 + (pn - 4) * 256 + wc * 32 + 8 * fq;
#pragma unroll
          for (int bj = 0; bj < 2; ++bj) *(uint4*)(dst + bj * 128) = pack8(v[bj][0], v[bj][1]);
        } else if (pn < 16) {
          u16* dst = (u16*)(ws + O_XBC) + r * 2048 + (pn - 8) * 256 + wc * 32 + 8 * fq;
#pragma unroll
          for (int bj = 0; bj < 2; ++bj) *(uint4*)(dst + bj * 128) = pack8(v[bj][0], v[bj][1]);
        } else if (wc == 0) {
          float* dst = (float*)(ws + O_DTB) + r * 32 + 8 * fq;
          *(float4*)(dst) = make_float4(v[0][0][0], v[0][0][1], v[0][0][2], v[0][0][3]);
          *(float4*)(dst + 4) = make_float4(v[0][1][0], v[0][1][1], v[0][1][2], v[0][1][3]);
        }
      }
  }
};

struct EpiVT {
  static constexpr bool PERM = true;
  const float* ssq_in; u16* vt; int nh;
  DI void operator()(const AccT& acc, const pg8::Unit& u, int wr, int wc, int fr, int fq, const PG8_LAS float* rtab) const {
#pragma unroll
    for (int bj = 0; bj < 2; ++bj) {
      const int tok0 = u.pn * 256 + bj * 128 + wc * 32 + 8 * fq;
      f32x4 r0 = {1.f, 1.f, 1.f, 1.f}, r1 = r0;
      if (ssq_in) {
        const int lo = bj * 128 + wc * 32 + 8 * fq;
        r0 = *(const PG8_LAS f32x4*)(rtab + lo); r1 = *(const PG8_LAS f32x4*)(rtab + lo + 4);
      }
      const int b = tok0 >> 11, s = tok0 & 2047;
#pragma unroll
      for (int ai = 0; ai < 2; ++ai)
#pragma unroll
        for (int m = 0; m < 4; ++m) {
          const int f = u.pm * 256 + ai * 128 + wr * 64 + m * 16 + fr;
          const int hd = f >> 6, d = f & 63;
          u16* dstp = vt + ((size_t)((b * nh + hd) * 64 + d)) * 2048;
          const uint4 pk = pack8(acc[ai][bj][m][0] * r0, acc[ai][bj][m][1] * r1);
          if (nh == 4) {
            const int c = (s >> 3) & 3, pos0 = (s & ~31) + 16 * (c & 1) + 4 * (c >> 1);
            *(uint2*)(dstp + pos0) = make_uint2(pk.x, pk.y);
            *(uint2*)(dstp + pos0 + 8) = make_uint2(pk.z, pk.w);
          } else {
            *(uint4*)(dstp + s) = pk;
          }
        }
    }
  }
};
enum { EK_RES = 0, EK_SWIGLU = 1, EK_QK0 = 2, EK_QK1 = 3, EK_VT = 4 };
struct EpiAny {
  int kind; bool perm;
  char* ws; u16* zout; const float* qn; const float* kn; const float* ssq_in; float* ssq_out; const float* res_in; float* res_out; u16* xb_out; u16* o16; int nh;
  DI void operator()(const AccT& acc, const pg8::Unit& u, int wr, int wc, int fr, int fq, const PG8_LAS float* rtab) const {
    switch (kind) {
      case EK_RES: { EpiRes e{res_in, xb_out, res_out, ssq_out}; e(acc, u, wr, wc, fr, fq, rtab); } break;
      case EK_SWIGLU: { EpiSwiglu e{ssq_in, o16}; e(acc, u, wr, wc, fr, fq, rtab); } break;
      case EK_QK0: { EpiQK<0> e{ws, zout, qn, kn, ssq_in}; e(acc, u, wr, wc, fr, fq, rtab); } break;
      case EK_QK1: { EpiQK<1> e{ws, zout, qn, kn, ssq_in}; e(acc, u, wr, wc, fr, fq, rtab); } break;
      default: { EpiVT e{ssq_in, o16, nh}; e(acc, u, wr, wc, fr, fq, rtab); } break;
    }
  }
};

__device__ void na_tile(const Params& p, int tile) {
  const int tid = vtid(), lane = tid & 63, wave = tid >> 6, l15 = lane & 15, quad = lane >> 4;
  const int h = tile & 7, r = (tile >> 3) & 31, b = tile >> 8;
  const int c0 = min(max(16 * wave - 8, 0), 32);
  const int rs = min(max(r - 4, 0), 24);
  const u16* Q0 = (const u16*)(p.ws + O_Q0);
  const u16* K0 = (const u16*)(p.ws + O_K0) + (size_t)(b * 2048 + rs * 64 + c0 + 8 * (l15 >> 2) + (l15 & 3)) * 512 + h * 64 + 8 * quad;
  const u16* VT = (const u16*)(p.ws + O_VT0) + (size_t)((b * 8 + h) * 64 + l15) * 2048 + rs * 64 + c0 + 8 * quad;
  u16* mix = (u16*)(p.ws + O_MIX);
  const int tq = b * 2048 + r * 64 + 16 * wave + l15;
  bf16x8 qf[2];
#pragma unroll
  for (int ks = 0; ks < 2; ++ks) qf[ks] = as_bf8(*(const uint4*)(Q0 + (size_t)tq * 512 + h * 64 + 32 * ks + 8 * quad));
  const int cq = 16 * wave + l15;
  const int cs = min(max(cq - 8, 0), 48);
  const float* rpb = p.na_rel_bias + h * 465 + (rs - r + 7) * 31;
  const int d0 = c0 + 8 * quad - cq;
  const int w0 = d0 + cq - cs;
  f32x4 s[16];
  uint4 kb[2][4];
#pragma unroll
  for (int q4 = 0; q4 < 4; ++q4) kb[0][q4] = *(const uint4*)(K0 + (size_t)(4 * (q4 >> 1)) * 512 + 32 * (q4 & 1));
#pragma unroll
  for (int jr = 0; jr < 8; ++jr) {
    if (jr + 1 < 8) {
#pragma unroll
      for (int q4 = 0; q4 < 4; ++q4)
        kb[(jr + 1) & 1][q4] = *(const uint4*)(K0 + (size_t)((jr + 1) * 64 + 4 * (q4 >> 1)) * 512 + 32 * (q4 & 1));
    }
    float bias[8];
#pragma unroll
    for (int e = 0; e < 8; ++e) bias[e] = rpb[jr * 31 + min(max(d0 + 4 * (e >> 2) + (e & 3), -15), 15) + 15];
#pragma unroll
    for (int tt = 0; tt < 2; ++tt) {
      f32x4 a = {0.f, 0.f, 0.f, 0.f};
      a = MFMA(as_bf8(kb[jr & 1][2 * tt]), qf[0], a);
      a = MFMA(as_bf8(kb[jr & 1][2 * tt + 1]), qf[1], a);
#pragma unroll
      for (int rr = 0; rr < 4; ++rr) a[rr] = ((unsigned)(w0 + 4 * tt + rr) < 16u) ? (a[rr] + bias[tt * 4 + rr] * LOG2E) : -INFINITY;
      s[jr * 2 + tt] = a;
    }
  }
  float mx = -INFINITY;
#pragma unroll
  for (int u = 0; u < 16; ++u) mx = fmaxf(mx, fmaxf(fmaxf(s[u][0], s[u][1]), fmaxf(s[u][2], s[u][3])));
  mx = xor16_32_max(mx);
  uint4 vbuf[3][4];
#define NA_VLOAD(jr, dst) do { \
    _Pragma("unroll") for (int i2 = 0; i2 < 4; ++i2) dst[i2] = *(const uint4*)(VT + (size_t)(16 * i2) * 2048 + (jr) * 64); } while (0)
  NA_VLOAD(0, vbuf[0]);
  NA_VLOAD(1, vbuf[1]);
  float sum = 0.f;
#pragma unroll
  for (int u = 0; u < 16; ++u)
#pragma unroll
    for (int rr = 0; rr < 4; ++rr) { float pv = ex2(s[u][rr] - mx); s[u][rr] = pv; sum += pv; }
  sum = xor16_32_sum(sum);
  f32x4 o[4];
#pragma unroll
  for (int i2 = 0; i2 < 4; ++i2) o[i2] = (f32x4){0.f, 0.f, 0.f, 0.f};
#pragma unroll
  for (int jr = 0; jr < 8; ++jr) {
    if (jr + 2 < 8) NA_VLOAD(jr + 2, vbuf[(jr + 2) % 3]);
    bf16x8 pf = cat_bf8(pack4(s[2 * jr]), pack4(s[2 * jr + 1]));
#pragma unroll
    for (int i2 = 0; i2 < 4; ++i2) o[i2] = MFMA(as_bf8(vbuf[jr % 3][i2]), pf, o[i2]);
  }
#undef NA_VLOAD
  const float inv = 1.f / sum;
#pragma unroll
  for (int i2 = 0; i2 < 4; ++i2) *(uint2*)(mix + (size_t)tq * 1536 + h * 64 + 16 * i2 + 4 * quad) = pack4(o[i2] * inv);
}

__device__ void conv_tile(const Params& p, int tile) {
  const int tb = tile >> 2, cb = tile & 3;
  const int ch = cb * 512 + 2 * vtid();
  const int b = tb >> 5, s0 = (tb & 31) * 64;
  float w[4][2], bias[2];
#pragma unroll
  for (int k = 0; k < 4; ++k) { const float2 t = *(const float2*)(p.conv_w + k * 2048 + ch); w[k][0] = t.x; w[k][1] = t.y; }
  { const float2 t = *(const float2*)(p.conv_b + ch); bias[0] = t.x; bias[1] = t.y; }
  const u16* src = (const u16*)(p.ws + O_XBC) + (size_t)(b * 2048) * 2048 + ch;
  unsigned um2 = (s0 >= 2) ? *(const unsigned*)(src + (size_t)(s0 - 2) * 2048) : 0u;
  unsigned um1 = (s0 >= 1) ? *(const unsigned*)(src + (size_t)(s0 - 1) * 2048) : 0u;
  unsigned u0 = *(const unsigned*)(src + (size_t)s0 * 2048);
  u16* XT = (u16*)p.out + 16 * MIB;
  for (int sg = 0; sg < 8; ++sg) {
    unsigned nx[8];
#pragma unroll
    for (int e = 0; e < 8; ++e) { const int s = s0 + sg * 8 + e; nx[e] = (s + 1 < 2048) ? *(const unsigned*)(src + (size_t)(s + 1) * 2048) : 0u; }
    float y[2][8];
#pragma unroll
    for (int e = 0; e < 8; ++e) {
      const unsigned up1 = nx[e];
      y[0][e] = silu(w[0][0] * bflo(um2) + w[1][0] * bflo(um1) + w[2][0] * bflo(u0) + w[3][0] * bflo(up1) + bias[0]);
      y[1][e] = silu(w[0][1] * bfhi(um2) + w[1][1] * bfhi(um1) + w[2][1] * bfhi(u0) + w[3][1] * bfhi(up1) + bias[1]);
      um2 = um1; um1 = u0; u0 = up1;
    }
    const int sb = s0 + sg * 8;
    if (cb < 3) {
      u16* dstT = (cb < 2) ? XT + (size_t)(b * 1024 + ch) * 2048 + sb : (u16*)(p.ws + O_BT) + (size_t)(b * 512 + (ch - 1024)) * 2048 + sb;
#pragma unroll
      for (int c2 = 0; c2 < 2; ++c2)
        *(uint4*)(dstT + (size_t)c2 * 2048) = make_uint4(pack2(y[c2][0], y[c2][1]), pack2(y[c2][2], y[c2][3]), pack2(y[c2][4], y[c2][5]), pack2(y[c2][6], y[c2][7]));
    }
    if (cb >= 2) {
      u16* nat = (cb == 2) ? (u16*)(p.ws + O_BN) + (size_t)(b * 2048 + sb) * 512 + (ch - 1024)
                           : (u16*)(p.ws + O_CN) + (size_t)(b * 2048 + sb) * 512 + (ch - 1536);
#pragma unroll
      for (int e = 0; e < 8; ++e) *(unsigned*)(nat + e * 512) = pack2(y[0][e], y[1][e]);
    }
  }
}

__device__ void scan_item8(const Params& p, char* smem, int item) {
  const int tid = otid(), lane = tid & 63, wave = __builtin_amdgcn_readfirstlane(tid >> 6), l15 = lane & 15, quad = lane >> 4;
  const int dir = item & 1, h = (item >> 1) & 15, b = item >> 5, g = h >> 2;
  const float Ah = -__expf(p.A_log[dir * 16 + h]) * LOG2E;
  PG8_LAS float* wall = (PG8_LAS float*)((PG8_LAS unsigned char*)smem + 65536);
  PG8_LAS float* cdall = wall + 2048;
  const float* dtb = (const float*)(p.ws + O_DTB);
#pragma unroll
  for (int cc = 0; cc < 2; ++cc) {
    const int c = 2 * wave + cc;
    const int tokb = b * 2048 + c * 128;
    const float d0 = dtb[(size_t)(tokb + 2 * lane) * 32 + dir * 16 + h];
    const float d1 = dtb[(size_t)(tokb + 2 * lane + 1) * 32 + dir * 16 + h];
    const float a0 = d0 * Ah, a1 = d1 * Ah, ps = a0 + a1;
    float incl = ps;
#pragma unroll
    for (int o = 1; o < 64; o <<= 1) { float tv = __shfl_up(incl, o); if (lane >= o) incl += tv; }
    const float total = __shfl(incl, 63);
    const float excl = incl - ps;
    float w0, w1;
    if (dir == 0) { w0 = ex2(total - (excl + a0)) * d0; w1 = ex2(total - incl) * d1; }
    else { w0 = ex2(excl) * d0; w1 = ex2(excl + a0) * d1; }
    wall[c * 128 + 2 * lane] = w0; wall[c * 128 + 2 * lane + 1] = w1;
    if (lane == 0) cdall[c] = ex2(total);
  }
  __syncthreads();
  const int drow = 8 * wave + (lane >> 4);
  const u16* XTg = (const u16*)p.out + 16 * MIB + (size_t)(b * 1024 + h * 64) * 2048;
  const char* xsrc0 = (const char*)(XTg + (size_t)drow * 2048) + (((lane & 15) ^ (drow & 15)) << 4);
  const char* xsrc1 = (const char*)(XTg + (size_t)(drow + 4) * 2048) + (((lane & 15) ^ ((drow + 4) & 15)) << 4);
  PG8_LAS unsigned char* lds = (PG8_LAS unsigned char*)smem;
  const u16* BT = (const u16*)(p.ws + O_BT) + (size_t)(b * 512 + g * 128 + 16 * wave + l15) * 2048 + 8 * quad;
  u16* HP = (u16*)(p.ws + O_HPREV);
  f32x4 acc[4];
#pragma unroll
  for (int j = 0; j < 4; ++j) acc[j] = (f32x4){0.f, 0.f, 0.f, 0.f};
  u32x4v bA[4], bB[4], bC[4], bD[4];
#define SC_ISSUE(Bf, st, c) do { \
    __builtin_amdgcn_global_load_lds((const unsigned*)(xsrc0 + (c) * 256), (PG8_LAS unsigned*)(lds + (st) * 16384 + wave * 2048), 16, 0, 0); \
    __builtin_amdgcn_global_load_lds((const unsigned*)(xsrc1 + (c) * 256), (PG8_LAS unsigned*)(lds + (st) * 16384 + wave * 2048 + 1024), 16, 0, 0); \
    { const u16* _bp = BT + (c) * 128; \
      asm volatile("global_load_dwordx4 %0, %4, off\n\tglobal_load_dwordx4 %1, %4, off offset:64\n\tglobal_load_dwordx4 %2, %4, off offset:128\n\tglobal_load_dwordx4 %3, %4, off offset:192" \
                   : "=&v"(Bf[0]), "=&v"(Bf[1]), "=&v"(Bf[2]), "=&v"(Bf[3]) : "v"(_bp) : "memory"); } } while (0)
#define SC_STEP(Bf, st, c) do { \
    u16* hp = HP + ((size_t)(((b * 16 + (c)) * 16 + h) * 2 + dir) << 13); \
    _Pragma("unroll") for (int j = 0; j < 4; ++j) *(uint2*)(hp + (16 * j + l15) * 128 + 16 * wave + 4 * quad) = pack4(acc[j]); \
    const float cd = cdall[(c)]; \
    _Pragma("unroll") for (int j = 0; j < 4; ++j) acc[j] *= cd; \
    _Pragma("unroll") for (int ks = 0; ks < 4; ++ks) { \
      const f32x4 wav = *(const PG8_LAS f32x4*)(wall + (c) * 128 + 32 * ks + 8 * quad); \
      const f32x4 wbv = *(const PG8_LAS f32x4*)(wall + (c) * 128 + 32 * ks + 8 * quad + 4); \
      const float4 wa = make_float4(wav[0], wav[1], wav[2], wav[3]), wb = make_float4(wbv[0], wbv[1], wbv[2], wbv[3]); \
      _Pragma("unroll") for (int j = 0; j < 4; ++j) { \
        const u32x4v rawv = *(const PG8_LAS u32x4v*)(lds + (st) * 16384 + (16 * j + l15) * 256 + (((4 * ks + quad) ^ l15) << 4)); \
        const uint4 raw = make_uint4(rawv[0], rawv[1], rawv[2], rawv[3]); uint4 sc; \
        sc.x = pack2(bflo(raw.x) * wa.x, bfhi(raw.x) * wa.y); sc.y = pack2(bflo(raw.y) * wa.z, bfhi(raw.y) * wa.w); \
        sc.z = pack2(bflo(raw.z) * wb.x, bfhi(raw.z) * wb.y); sc.w = pack2(bflo(raw.w) * wb.z, bfhi(raw.w) * wb.w); \
        acc[j] = MFMA(__builtin_bit_cast(bf16x8, Bf[ks]), as_bf8(sc), acc[j]); } } } while (0)
#define SC_CH(s) (dir ? 15 - (s) : (s))
  SC_ISSUE(bA, 0, SC_CH(0)); SC_ISSUE(bB, 1, SC_CH(1)); SC_ISSUE(bC, 2, SC_CH(2));
#define SC_BAR() do { asm volatile("" ::: "memory"); __builtin_amdgcn_s_barrier(); asm volatile("" ::: "memory"); } while (0)
#define SC_WAIT(nlast, Bf) do { if (s4 == 12) asm volatile("s_waitcnt vmcnt(" #nlast ")" : "+v"(Bf[0]), "+v"(Bf[1]), "+v"(Bf[2]), "+v"(Bf[3]) :: "memory"); \
    else asm volatile("s_waitcnt vmcnt(18)" : "+v"(Bf[0]), "+v"(Bf[1]), "+v"(Bf[2]), "+v"(Bf[3]) :: "memory"); } while (0)
  for (int s4 = 0; s4 < 16; s4 += 4) {
    SC_ISSUE(bD, 3, SC_CH(s4 + 3));
    SC_WAIT(18, bA); SC_BAR();
    SC_STEP(bA, 0, SC_CH(s4));
    SC_BAR();
    if (s4 + 4 < 16) SC_ISSUE(bA, 0, SC_CH(s4 + 4));
    SC_WAIT(12, bB); SC_BAR();
    SC_STEP(bB, 1, SC_CH(s4 + 1));
    SC_BAR();
    if (s4 + 5 < 16) SC_ISSUE(bB, 1, SC_CH(s4 + 5));
    SC_WAIT(6, bC); SC_BAR();
    SC_STEP(bC, 2, SC_CH(s4 + 2));
    SC_BAR();
    if (s4 + 6 < 16) SC_ISSUE(bC, 2, SC_CH(s4 + 6));
    SC_WAIT(0, bD); SC_BAR();
    SC_STEP(bD, 3, SC_CH(s4 + 3));
    SC_BAR();
  }
#undef SC_BAR
#undef SC_WAIT
#undef SC_ISSUE
#undef SC_STEP
#undef SC_CH
  asm volatile("s_waitcnt vmcnt(0)" ::: "memory");
  __syncthreads();
}

__device__ void ssd_out_tile(const Params& p, char* smem, int tile) {
  const int tid = vtid(), lane = tid & 63, wave = tid >> 6, l15 = lane & 15, quad = lane >> 4;
  const int g = tile & 3, c = (tile >> 2) & 15, b = tile >> 6;
  const int hh = g * 4 + wave;
  u16* Gs = (u16*)smem;
  float* wv = (float*)(smem + 34816) + wave * 512;
  float* red = (float*)(smem + 34816 + 8192);
  const int tok0 = b * 2048 + c * 128;
  const u16* Cn = (const u16*)(p.ws + O_CN) + (size_t)tok0 * 512 + g * 128;
  const u16* Bn = (const u16*)(p.ws + O_BN) + (size_t)tok0 * 512 + g * 128;
  const float* dtb = (const float*)(p.ws + O_DTB);
  {
    f32x4 ga[8][2];
#pragma unroll
    for (int i = 0; i < 8; ++i) { ga[i][0] = (f32x4){0.f, 0.f, 0.f, 0.f}; ga[i][1] = ga[i][0]; }
#pragma unroll 2
    for (int ks = 0; ks < 4; ++ks) {
      bf16x8 cf[2];
#pragma unroll
      for (int jj = 0; jj < 2; ++jj)
        cf[jj] = as_bf8(*(const uint4*)(Cn + (size_t)(16 * (2 * wave + jj) + l15) * 512 + 32 * ks + 8 * quad));
#pragma unroll
      for (int i = 0; i < 8; ++i) {
        bf16x8 bf = as_bf8(*(const uint4*)(Bn + (size_t)(16 * i + l15) * 512 + 32 * ks + 8 * quad));
        ga[i][0] = MFMA(bf, cf[0], ga[i][0]);
        ga[i][1] = MFMA(bf, cf[1], ga[i][1]);
      }
    }
#pragma unroll
    for (int i = 0; i < 8; ++i)
#pragma unroll
      for (int jj = 0; jj < 2; ++jj)
        *(uint2*)(Gs + (16 * (2 * wave + jj) + l15) * 136 + 16 * i + 4 * quad) = pack4(ga[i][jj]);
  }
  {
    const float Af = -__expf(p.A_log[hh]) * LOG2E, Ab = -__expf(p.A_log[16 + hh]) * LOG2E;
    const float d0f = dtb[(size_t)(tok0 + 2 * lane) * 32 + hh], d1f = dtb[(size_t)(tok0 + 2 * lane + 1) * 32 + hh];
    const float d0b = dtb[(size_t)(tok0 + 2 * lane) * 32 + 16 + hh], d1b = dtb[(size_t)(tok0 + 2 * lane + 1) * 32 + 16 + hh];
    const float a0 = d0f * Af, a1 = d1f * Af, c0 = d0b * Ab, c1 = d1b * Ab;
    float inf_ = a0 + a1, inb = c0 + c1;
#pragma unroll
    for (int o = 1; o < 64; o <<= 1) {
      float t1 = __shfl_up(inf_, o), t2 = __shfl_up(inb, o);
      if (lane >= o) { inf_ += t1; inb += t2; }
    }
    const float totb = __shfl(inb, 63);
    const float exf = inf_ - (a0 + a1), exb = inb - (c0 + c1);
    *(float2*)(wv + 2 * lane) = make_float2(exf + a0, inf_);
    *(float2*)(wv + 128 + 2 * lane) = make_float2(totb - exb, totb - (exb + c0));
    *(float2*)(wv + 256 + 2 * lane) = make_float2(d0f, d1f);
    *(float2*)(wv + 384 + 2 * lane) = make_float2(d0b, d1b);
  }
  __syncthreads();
  const float Dh = p.Dskip[hh];
  const u16* XT = (const u16*)p.out + 16 * MIB + (size_t)(b * 1024 + hh * 64) * 2048 + c * 128;
  const u16* hf = (const u16*)(p.ws + O_HPREV) + ((size_t)(((b * 16 + c) * 16 + hh) * 2) << 13);
  const u16* hb = hf + 8192;
  const u16* Z = (const u16*)p.out;
  u16* mix = (u16*)(p.ws + O_MIX);
  #pragma unroll 1
  for (int jh = 0; jh < 2; ++jh) {
    f32x4 y[4][4];
    {
      float efv[4], ebv[4];
#pragma unroll
      for (int j = 0; j < 4; ++j) {
        const int l = 64 * jh + 16 * j + l15;
        efv[j] = ex2(wv[l]); ebv[j] = ex2(wv[128 + l]);
      }
#pragma unroll
      for (int i = 0; i < 4; ++i)
#pragma unroll
        for (int j = 0; j < 4; ++j) y[i][j] = (f32x4){0.f, 0.f, 0.f, 0.f};
#pragma unroll 2
      for (int ks = 0; ks < 4; ++ks) {
        bf16x8 cF[4], cB[4];
#pragma unroll
        for (int j = 0; j < 4; ++j) {
          const uint4 raw = *(const uint4*)(Cn + (size_t)(64 * jh + 16 * j + l15) * 512 + 32 * ks + 8 * quad);
          float f[8];
          unpack8(raw, f);
          cF[j] = as_bf8(make_uint4(pack2(f[0] * efv[j], f[1] * efv[j]), pack2(f[2] * efv[j], f[3] * efv[j]), pack2(f[4] * efv[j], f[5] * efv[j]), pack2(f[6] * efv[j], f[7] * efv[j])));
          cB[j] = as_bf8(make_uint4(pack2(f[0] * ebv[j], f[1] * ebv[j]), pack2(f[2] * ebv[j], f[3] * ebv[j]), pack2(f[4] * ebv[j], f[5] * ebv[j]), pack2(f[6] * ebv[j], f[7] * ebv[j])));
        }
#pragma unroll
        for (int i = 0; i < 4; ++i) {
          bf16x8 f1 = as_bf8(*(const uint4*)(hf + (16 * i + l15) * 128 + 32 * ks + 8 * quad));
          bf16x8 f2 = as_bf8(*(const uint4*)(hb + (16 * i + l15) * 128 + 32 * ks + 8 * quad));
#pragma unroll
          for (int j = 0; j < 4; ++j) { y[i][j] = MFMA(f1, cF[j], y[i][j]); y[i][j] = MFMA(f2, cB[j], y[i][j]); }
        }
      }
    }
#pragma unroll 2
    for (int ks = 0; ks < 4; ++ks) {
      const int sb = 32 * ks + 8 * quad;
      float afs[8], rbs[8], d0s[8], d1s[8];
      *(float4*)(afs) = *(const float4*)(wv + sb); *(float4*)(afs + 4) = *(const float4*)(wv + sb + 4);
      *(float4*)(rbs) = *(const float4*)(wv + 128 + sb); *(float4*)(rbs + 4) = *(const float4*)(wv + 128 + sb + 4);
      *(float4*)(d0s) = *(const float4*)(wv + 256 + sb); *(float4*)(d0s + 4) = *(const float4*)(wv + 256 + sb + 4);
      *(float4*)(d1s) = *(const float4*)(wv + 384 + sb); *(float4*)(d1s + 4) = *(const float4*)(wv + 384 + sb + 4);
      bf16x8 xf[4];
#pragma unroll
      for (int i = 0; i < 4; ++i) xf[i] = as_bf8(*(const uint4*)(XT + (size_t)(16 * i + l15) * 2048 + sb));
#pragma unroll
      for (int j = 0; j < 4; ++j) {
        const int l = 64 * jh + 16 * j + l15;
        const float afl = wv[l], rbl = wv[128 + l];
        float gv[8], m[8];
        unpack8(*(const uint4*)(Gs + l * 136 + sb), gv);
#pragma unroll
        for (int e = 0; e < 8; ++e) {
          const int s = sb + e;
          float ff = (s <= l) ? ex2(afl - afs[e]) * d0s[e] : 0.f;
          float fb = (s >= l) ? ex2(rbl - rbs[e]) * d1s[e] : 0.f;
          m[e] = gv[e] * (ff + fb) + ((s == l) ? Dh : 0.f);
        }
        bf16x8 mf = as_bf8(make_uint4(pack2(m[0], m[1]), pack2(m[2], m[3]), pack2(m[4], m[5]), pack2(m[6], m[7])));
#pragma unroll
        for (int i = 0; i < 4; ++i) y[i][j] = MFMA(xf[i], mf, y[i][j]);
      }
    }
#pragma unroll
    for (int j = 0; j < 4; ++j) {
      const int tok = tok0 + 64 * jh + 16 * j + l15;
      float part = 0.f;
#pragma unroll
      for (int i = 0; i < 4; ++i) {
        uint2 zr = *(const uint2*)(Z + (size_t)tok * 1024 + hh * 64 + 16 * i + 4 * quad);
        float z0 = bflo(zr.x), z1 = bfhi(zr.x), z2 = bflo(zr.y), z3 = bfhi(zr.y);
        y[i][j][0] *= silu(z0); y[i][j][1] *= silu(z1); y[i][j][2] *= silu(z2); y[i][j][3] *= silu(z3);
        part += y[i][j][0] * y[i][j][0] + y[i][j][1] * y[i][j][1] + y[i][j][2] * y[i][j][2] + y[i][j][3] * y[i][j][3];
      }
      part = xor16_32_sum(part);
      if (quad == 0) red[wave * 64 + 16 * j + l15] = part;
    }
    __syncthreads();
#pragma unroll
    for (int j = 0; j < 4; ++j) {
      const int tok = tok0 + 64 * jh + 16 * j + l15;
      const int q = 16 * j + l15;
      const float tot = red[q] + red[64 + q] + red[128 + q] + red[192 + q];
      const float rs = rsqrtf(tot * (1.f / 256.f) + EPS);
#pragma unroll
      for (int i = 0; i < 4; ++i) {
        float4 g4 = *(const float4*)(p.out_norm + hh * 64 + 16 * i + 4 * quad);
        f32x4 o;
        o[0] = y[i][j][0] * rs * g4.x; o[1] = y[i][j][1] * rs * g4.y; o[2] = y[i][j][2] * rs * g4.z; o[3] = y[i][j][3] * rs * g4.w;
        *(uint2*)(mix + (size_t)tok * 1536 + 512 + hh * 64 + 16 * i + 4 * quad) = pack4(o);
      }
    }
    __syncthreads();
  }
}

__device__ void gqa_tile8(const Params& p, char* smem, int tile) {
  const int tid = otid(), lane = tid & 63, wave = __builtin_amdgcn_readfirstlane(tid >> 6), l15 = lane & 15, quad = lane >> 4;
  const int rep = tile & 3, qb = (tile >> 2) & 3, kvh = (tile >> 4) & 3, b = tile >> 6;
  const int h = kvh * 4 + rep;
  const u16* Q1 = (const u16*)(p.ws + O_Q1);
  const u16* K1 = (const u16*)(p.ws + O_K1) + (size_t)(b * 2048) * 256 + kvh * 64;
  const u16* VT = (const u16*)(p.ws + O_VT1) + (size_t)((b * 4 + kvh) * 64) * 2048;
  u16* AO = (u16*)(p.ws + O_AO);
  const int tq0 = b * 2048 + qb * 512 + 64 * wave;
  bf16x8 qf[4][2];
#pragma unroll
  for (int j = 0; j < 4; ++j)
#pragma unroll
    for (int ks = 0; ks < 2; ++ks)
      qf[j][ks] = as_bf8(*(const uint4*)(Q1 + (size_t)(tq0 + 16 * j + l15) * 1024 + h * 64 + 32 * ks + 8 * quad));
  PG8_LAS unsigned char* lds = (PG8_LAS unsigned char*)smem;
  const int kr0 = 16 * wave + (lane >> 3), kr1 = kr0 + 8;
  const char* ksrc0 = (const char*)(K1 + (size_t)kr0 * 256) + ((((lane & 7) ^ ((kr0 >> 1) & 7))) << 4);
  const char* ksrc1 = (const char*)(K1 + (size_t)kr1 * 256) + ((((lane & 7) ^ ((kr1 >> 1) & 7))) << 4);
  const int vr0 = 8 * wave + (lane >> 4), vr1 = vr0 + 4;
  const char* vsrc0 = (const char*)(VT + (size_t)vr0 * 2048) + ((((lane & 15) ^ (vr0 & 15))) << 4);
  const char* vsrc1 = (const char*)(VT + (size_t)vr1 * 2048) + ((((lane & 15) ^ (vr1 & 15))) << 4);
  f32x4 o[4][4];
#pragma unroll
  for (int i = 0; i < 4; ++i)
#pragma unroll
    for (int j = 0; j < 4; ++j) o[i][j] = (f32x4){0.f, 0.f, 0.f, 0.f};
  float m[4] = {-1e30f, -1e30f, -1e30f, -1e30f}, lsum[4] = {0.f, 0.f, 0.f, 0.f};
#define GQ_ISSUE(t) do { const int _st = (t) & 3; \
    __builtin_amdgcn_global_load_lds((const unsigned*)(ksrc0 + (size_t)(t) * (128 * 512)), (PG8_LAS unsigned*)(lds + _st * 32768 + wave * 2048), 16, 0, 0); \
    __builtin_amdgcn_global_load_lds((const unsigned*)(ksrc1 + (size_t)(t) * (128 * 512)), (PG8_LAS unsigned*)(lds + _st * 32768 + wave * 2048 + 1024), 16, 0, 0); \
    __builtin_amdgcn_global_load_lds((const unsigned*)(vsrc0 + (t) * 256), (PG8_LAS unsigned*)(lds + _st * 32768 + 16384 + wave * 2048), 16, 0, 0); \
    __builtin_amdgcn_global_load_lds((const unsigned*)(vsrc1 + (t) * 256), (PG8_LAS unsigned*)(lds + _st * 32768 + 16384 + wave * 2048 + 1024), 16, 0, 0); } while (0)
#define GQ_BODY(st, hk, jb) do { \
    PG8_LAS const unsigned char* sK = lds + (st) * 32768; PG8_LAS const unsigned char* sV = sK + 16384; \
    f32x4 s[4][2]; \
    _Pragma("unroll") for (int i = 0; i < 4; ++i) { s[i][0] = (f32x4){0.f, 0.f, 0.f, 0.f}; s[i][1] = s[i][0]; } \
    _Pragma("unroll") for (int ks = 0; ks < 2; ++ks) \
      _Pragma("unroll") for (int i = 0; i < 4; ++i) { \
        const int kr = 64 * (hk) + 16 * i + l15; \
        bf16x8 kf = *(PG8_LAS const bf16x8*)(sK + kr * 128 + (((4 * ks + quad) ^ ((kr >> 1) & 7)) << 4)); \
        s[i][0] = MFMA(kf, qf[(jb)][ks], s[i][0]); s[i][1] = MFMA(kf, qf[(jb) + 1][ks], s[i][1]); } \
    bf16x8 pf[2][2]; \
    _Pragma("unroll") for (int j = 0; j < 2; ++j) { \
      float mx = -1e30f; \
      _Pragma("unroll") for (int i = 0; i < 4; ++i) mx = fmaxf(mx, fmaxf(fmaxf(s[i][j][0], s[i][j][1]), fmaxf(s[i][j][2], s[i][j][3]))); \
      mx = xor16_32_max(mx); \
      const float mn = fmaxf(m[(jb) + j], mx); \
      if (__builtin_amdgcn_ballot_w64(mn > m[(jb) + j]) != 0ull) { \
        const float alpha = ex2(m[(jb) + j] - mn); m[(jb) + j] = mn; lsum[(jb) + j] *= alpha; \
        _Pragma("unroll") for (int i2 = 0; i2 < 4; ++i2) o[i2][(jb) + j] *= alpha; } \
      float ps = 0.f; \
      _Pragma("unroll") for (int i = 0; i < 4; ++i) \
        _Pragma("unroll") for (int r = 0; r < 4; ++r) { float pv = ex2(s[i][j][r] - mn); s[i][j][r] = pv; ps += pv; } \
      lsum[(jb) + j] += ps; \
      pf[j][0] = cat_bf8(pack4(s[0][j]), pack4(s[1][j])); pf[j][1] = cat_bf8(pack4(s[2][j]), pack4(s[3][j])); } \
    _Pragma("unroll") for (int ks2 = 0; ks2 < 2; ++ks2) \
      _Pragma("unroll") for (int i2 = 0; i2 < 4; ++i2) { \
        const int vd = 16 * i2 + l15; \
        bf16x8 vf = *(PG8_LAS const bf16x8*)(sV + vd * 256 + (((8 * (hk) + 4 * ks2 + quad) ^ (vd & 15)) << 4)); \
        o[i2][(jb)] = MFMA(vf, pf[0][ks2], o[i2][(jb)]); o[i2][(jb) + 1] = MFMA(vf, pf[1][ks2], o[i2][(jb) + 1]); } \
    __builtin_amdgcn_sched_barrier(0); \
  } while (0)
  __syncthreads();
  GQ_ISSUE(0); GQ_ISSUE(1);
  for (int kt = 0; kt < 16; ++kt) {
    if (kt + 2 < 16) GQ_ISSUE(kt + 2);
    if (kt < 14) asm volatile("s_waitcnt vmcnt(8)" ::: "memory");
    else if (kt == 14) asm volatile("s_waitcnt vmcnt(4)" ::: "memory");
    else asm volatile("s_waitcnt vmcnt(0)" ::: "memory");
    asm volatile("" ::: "memory"); __builtin_amdgcn_s_barrier(); asm volatile("" ::: "memory");
    const int st = kt & 3;
    GQ_BODY(st, 0, 0); GQ_BODY(st, 0, 2); GQ_BODY(st, 1, 0); GQ_BODY(st, 1, 2);
  }
#undef GQ_ISSUE
#undef GQ_BODY
#pragma unroll
  for (int j = 0; j < 4; ++j) {
    const float inv = 1.f / xor16_32_sum(lsum[j]);
    const int tq = tq0 + 16 * j + l15;
#pragma unroll
    for (int i2 = 0; i2 < 4; ++i2) *(uint2*)(AO + (size_t)tq * 1024 + h * 64 + 16 * i2 + 4 * quad) = pack4(o[i2][j] * inv);
  }
}

#ifndef ONLY_PHASE
#define ONLY_PHASE -1
#endif
__device__ void run_phase(const Params& p, char* smem, int ph) {
  if (ONLY_PHASE >= 0 && ph != ONLY_PHASE) return;
  char* ws = p.ws;
  asm volatile("" : "+s"(ws));
  float* ssq = (float*)(ws + O_SSQ);
  u16* xb = (u16*)(ws + O_XB);
  const int half = __builtin_amdgcn_readfirstlane(threadIdx_x_raw() >> 8);
  char* sh = smem + half * 65536;
  const int G = gridDim.x, bid = blockIdx.x;
  const int vb = bid * 2 + half, nvb = G * 2;
  const bool is_gemm = (ph == 1) || (ph >= 5 && ph != 9);
  if (is_gemm) {
    const int nsub = (ph == 1 || ph == 8) ? 2 : 1;
    for (int sub = 0; sub < nsub; ++sub) {
      pg8::Gemm g{}; EpiAny E{}; E.ws = ws; E.zout = (u16*)p.out; E.perm = true; int c = bid;
      E.qn = (ph >= 8) ? p.gqa_q_norm : p.na_q_norm; E.kn = (ph >= 8) ? p.gqa_k_norm : p.na_k_norm;
      const bool l1 = ph >= 8;
      const u16* W13 = (const u16*)(ws + (l1 ? O_W13_1 : O_W13_0));
      const u16* W2 = (const u16*)(ws + (l1 ? O_W2_1 : O_W2_0));
      if (ph == 1 || ph == 8) {
        const float* sq = l1 ? ssq + 2 * T : nullptr;
        if (sub == 0) { g = pg8::Gemm{xb, (const u16*)(ws + (l1 ? O_WQKV1 : O_WIN0)), T, l1 ? 1280 : 4352, 1024}; E.kind = l1 ? EK_QK1 : EK_QK0; E.ssq_in = sq; }
        else { g = pg8::Gemm{(const u16*)(ws + (l1 ? O_WV1 : O_WV0)), xb, l1 ? 256 : 512, T, 1024}; E.kind = EK_VT; E.ssq_in = sq;
               E.o16 = (u16*)(ws + (l1 ? O_VT1 : O_VT0)); E.nh = l1 ? 4 : 8; c = (bid + G - 64) % G; }
      } else if (ph == 5 || ph == 10) {
        g = pg8::Gemm{(const u16*)(ws + (l1 ? O_AO : O_MIX)), (const u16*)(ws + (l1 ? O_WOUT1 : O_WOUT0)), T, 1024, l1 ? 1024 : 1536};
        E.kind = EK_RES; E.perm = false; E.res_in = l1 ? nullptr : p.x; E.res_out = nullptr; E.xb_out = xb; E.ssq_out = ssq + (l1 ? 3 * T : T);
      } else if (ph == 6 || ph == 11) {
        g = pg8::Gemm{xb, W13, T, 5632, 1024}; E.kind = EK_SWIGLU; E.ssq_in = ssq + (l1 ? 3 * T : T); E.o16 = (u16*)(ws + O_H);
      } else {
        g = pg8::Gemm{(const u16*)(ws + O_H), W2, T, 1024, 2816};
        E.kind = EK_RES; E.perm = false; E.res_in = nullptr; E.res_out = l1 ? p.out : nullptr; E.xb_out = xb; E.ssq_out = l1 ? nullptr : ssq + 2 * T;
      }
      pg8::StaticOrder S; S.init(g.M, g.N, G, c);
      pg8::gemm_phase(( PG8_LAS unsigned char*)smem, g, S, E);
      if (ph == 6 && G == 256 && bid >= 128) {
        const int tid = otid();
        phase_prep_l1(p, ws, (bid - 128) * 8 + (tid >> 6), 128 * 8, tid & 63);
      }
    }
    return;
  }
  switch (ph) {
    case 0: phase_prep(p); break;
    case 2: {
      PSUB(4) for (int t = vb; t < 2048; t += nvb) na_tile(p, t);
      PSUB(5) for (int t = vb; t < 1024; t += nvb) conv_tile(p, t);
      float* dtb = (float*)(ws + O_DTB);
      for (int idx = bid * 512 + otid(); idx < T * 32; idx += G * 512) {
        float v = dtb[idx] + p.dt_bias[idx & 31];
        dtb[idx] = (v > 20.f) ? v : log1pf(expf(v));
      }
    } break;
    case 3: {
      for (int t0 = 0; t0 < 256; t0 += G) {
        int item = min(t0 + bid, 255);
        if (G == 256) {
          const int xcd = bid & 7, j = bid >> 3, grp = xcd * 4 + (j >> 3), idx8 = j & 7;
          item = (idx8 & 1) + 2 * ((grp & 3) * 4 + (idx8 >> 1)) + 32 * (grp >> 2);
        }
        scan_item8(p, smem, item);
      }
      if (G != 256) { const int tid = otid(); phase_prep_l1(p, ws, bid * 8 + (tid >> 6), G * 8, tid & 63); }
    } break;
    case 4:
      for (int t0 = 0; t0 < 512; t0 += nvb) ssd_out_tile(p, sh, min(t0 + vb, 511));
      break;
    case 9:
      if (G == 256) {
        const int xcd = bid & 7, j = bid >> 3;
        for (int r = 0; r < 2; ++r) gqa_tile8(p, smem, (r * 16 + xcd * 2 + (j >> 4)) * 16 + (j & 15));
      } else {
        for (int t0 = 0; t0 < 512; t0 += G) gqa_tile8(p, smem, min(t0 + bid, 511));
      }
      break;
    default: break;
  }
}

#define XB_TMO      128
#define XB_XCNT(j)  (256  + 64 * (j))
#define XB_XSUB(j)  (1280 + 64 * (j))
#define XB_XGEN(j)  (2304 + 64 * (j))
#define XB_TOP      3328
#define XB_TOPGEN   3392
#define XCD_BAR_WORDS 3456
#define XB_SPIN_CAP (1u << 18)
#define LAS __attribute__((address_space(3)))
DI unsigned xb_ld(unsigned* p) { return __hip_atomic_load(p, __ATOMIC_RELAXED, __HIP_MEMORY_SCOPE_AGENT); }
DI unsigned xb_add(unsigned* p, unsigned v) { return __hip_atomic_fetch_add(p, v, __ATOMIC_RELAXED, __HIP_MEMORY_SCOPE_AGENT); }
DI unsigned xb_xcc_id() { return (unsigned)__builtin_amdgcn_s_getreg((3 << 11) | 20) & 0xFu; }
#define XB_SPIN(cond, bar) do { unsigned _sp = 0; while (cond) { __builtin_amdgcn_s_sleep(1); \
    if ((++_sp & 255u) == 0u) { if (xb_ld(&(bar)[XB_TMO])) break; if (_sp > XB_SPIN_CAP) { atomicAdd(&(bar)[XB_TMO], 1u); break; } } } } while (0)
struct XcdBarrier { unsigned* bar; unsigned x; volatile LAS unsigned* st; };
DI XcdBarrier xcd_barrier_post(unsigned* bar, volatile LAS unsigned* st) {
  XcdBarrier b; b.bar = bar; b.x = xb_xcc_id(); b.st = st;
  if (threadIdx_x_raw() == 0) (void)xb_add(&bar[XB_XCNT(b.x)], 1u);
  return b;
}
DI void xcd_barrier_complete(unsigned* bar, unsigned x, unsigned& nloc, unsigned& nx) {
  const unsigned G = gridDim.x * gridDim.y * gridDim.z;
  unsigned sum, cnt, mine, sp = 0u;
  for (;;) {
    sum = 0u; cnt = 0u; mine = 0u;
#pragma unroll
    for (unsigned j = 0; j < 16; ++j) { const unsigned c = xb_ld(&bar[XB_XCNT(j)]); sum += c; cnt += (c > 0u) ? 1u : 0u; mine = (j == x) ? c : mine; }
    if (sum == G) break;
    __builtin_amdgcn_s_sleep(1);
    if ((++sp & 255u) == 0u) { if (xb_ld(&bar[XB_TMO])) break; if (sp > XB_SPIN_CAP) { atomicAdd(&bar[XB_TMO], 1u); break; } }
  }
  nloc = mine > 0u ? mine : 1u; nx = cnt > 0u ? cnt : 1u;
}
DI void xcd_barrier(const XcdBarrier& b) {
  asm volatile("s_waitcnt vmcnt(0)" ::: "memory");
  __syncthreads();
  if (threadIdx_x_raw() == 0) {
    unsigned* bar = b.bar;
    asm volatile("" : "+s"(bar));
    __builtin_amdgcn_s_waitcnt(0);
    unsigned nloc = b.st[0], nx = b.st[1];
    if (nloc == 0u) { xcd_barrier_complete(bar, b.x, nloc, nx); b.st[0] = nloc; b.st[1] = nx; }
    const unsigned old = xb_add(&bar[XB_XSUB(b.x)], 1u);
    const unsigned gen = old / nloc;
    if (old + 1u == (gen + 1u) * nloc) {
      __builtin_amdgcn_fence(__ATOMIC_RELEASE, "agent");
      asm volatile("s_waitcnt vmcnt(0)" ::: "memory");
      const unsigned og = xb_add(&bar[XB_TOP], 1u);
      const unsigned tg = og / nx;
      if (og + 1u == (tg + 1u) * nx) xb_add(&bar[XB_TOPGEN], 1u);
      else XB_SPIN(xb_ld(&bar[XB_TOPGEN]) == tg, bar);
      __builtin_amdgcn_fence(__ATOMIC_ACQUIRE, "agent");
      xb_add(&bar[XB_XGEN(b.x)], 1u);
      asm volatile("s_waitcnt vmcnt(0)" ::: "memory");
    } else {
      XB_SPIN(xb_ld(&bar[XB_XGEN(b.x)]) == gen, bar);
      __builtin_amdgcn_fence(__ATOMIC_ACQUIRE, "agent");
      asm volatile("s_waitcnt vmcnt(0)" ::: "memory");
    }
  }
  __syncthreads();
}

__global__ void __launch_bounds__(512, 2) mega(Params p) {
  extern __shared__ __attribute__((aligned(16))) char smem[];
  __shared__ uint4 xb_words;
  cg::grid_group grid = cg::this_grid();
  if (threadIdx_x_raw() == 0) xb_words = make_uint4(0u, 0u, 0u, 0u);
  __syncthreads();
  XcdBarrier xb = xcd_barrier_post((unsigned*)(p.ws + O_BAR), (volatile LAS unsigned*)&xb_words);
  if (p.ph0 < 0) grid.sync();
  for (int ph = p.ph0; ph < p.ph1; ++ph) {
    int nrep = 1;
#if PROBE_REP_MASK
    if ((PROBE_REP_MASK >> ph) & 1) nrep = 2;
#endif
    for (int r = 0; r < nrep; ++r) {
      run_phase(p, smem, ph);
      if (r + 1 < nrep || ph + 1 < p.ph1) xcd_barrier(xb);
    }
  }
#if PROBE_EXTRA_SYNCS
  for (int i = 0; i < PROBE_EXTRA_SYNCS; ++i) xcd_barrier(xb);
#endif
}

extern "C" void kernel_launch(void* const* d_in, const int* in_sizes, int n_in, void* d_out, int out_size, void* d_ws,
                              size_t ws_size, hipStream_t stream) {
  static int grid_blocks = 0;
  if (!grid_blocks) {
    (void)hipFuncSetAttribute((const void*)mega, hipFuncAttributeMaxDynamicSharedMemorySize, SMEM_BYTES);
    int dev = 0, cus = 0, per_cu = 0;
    (void)hipGetDevice(&dev);
    (void)hipDeviceGetAttribute(&cus, hipDeviceAttributeMultiprocessorCount, dev);
    (void)hipOccupancyMaxActiveBlocksPerMultiprocessor(&per_cu, mega, 512, SMEM_BYTES);
    if (per_cu < 1) per_cu = 1;
    grid_blocks = cus;
  }
  Params p{};
  const float** pp = (const float**)&p;
  for (int i = 0; i < 21; ++i) pp[i] = (const float*)d_in[i];
  p.out = (float*)d_out;
  p.ws = (char*)d_ws;
  (void)hipMemsetAsync((char*)d_ws + O_BAR, 0, XCD_BAR_WORDS * 4, stream);
#if MULTI_LAUNCH
  for (int ph = 0; ph < NPHASE; ++ph) {
    p.ph0 = ph; p.ph1 = ph + 1;
    hipLaunchKernelGGL(mega, dim3(grid_blocks), dim3(512), SMEM_BYTES, stream, p);
  }
#else
  p.ph0 = 0; p.ph1 = NPHASE;
  void* args[] = {&p};
  hipError_t e = hipLaunchCooperativeKernel((const void*)mega, dim3(grid_blocks), dim3(512), args, SMEM_BYTES, stream);
  if (e != hipSuccess) fprintf(stderr, "cooperative launch failed: %s (grid %d)\n", hipGetErrorString(e), grid_blocks);
#endif
}
```

```cpp
#include <hip/hip_runtime.h>
#include <hip/hip_bf16.h>
#include <hip/hip_cooperative_groups.h>
#include <cstdio>
namespace cg = cooperative_groups;

#define PROBE_REP_MASK 0
#define PROBE_EXTRA_SYNCS 0
#define PROBE_SUB 0
#define PSUB(k) for (int _r = 0; _r < ((PROBE_SUB == (k)) ? 2 : 1); ++_r)
#ifndef MULTI_LAUNCH
#define MULTI_LAUNCH 0
#endif

typedef __attribute__((ext_vector_type(8))) short bf16x8;
typedef __attribute__((ext_vector_type(4))) float f32x4;
typedef __attribute__((ext_vector_type(2))) float f32x2;
typedef __attribute__((ext_vector_type(2))) __bf16 bf16v2;
typedef unsigned short u16;
typedef unsigned u32x4v __attribute__((ext_vector_type(4)));

#define DI __device__ __forceinline__
#define MFMA(a, b, c) __builtin_amdgcn_mfma_f32_16x16x32_bf16((a), (b), (c), 0, 0, 0)

constexpr int T = 16384;
constexpr float EPS = 1e-6f;
constexpr float LOG2E = 1.4426950408889634f;
constexpr int NPHASE = 13;
constexpr int SMEM_BYTES = 131072 + 8192;

constexpr size_t MIB = 1u << 20;
constexpr size_t O_WIN0 = 0;
constexpr size_t O_WV0 = O_WIN0 + 4352ull * 1024 * 2;
constexpr size_t O_WOUT0 = O_WV0 + 512ull * 1024 * 2;
constexpr size_t O_W13_0 = O_WOUT0 + 1024ull * 1536 * 2;
constexpr size_t O_W2_0 = O_W13_0 + 5632ull * 1024 * 2;
constexpr size_t O_ROPE = 31 * MIB;
constexpr size_t O_DTB = O_ROPE + 524288;
constexpr size_t O_SSQ = O_DTB + 2097152;
constexpr size_t O_BAR = O_SSQ + 262144;
constexpr size_t O_XB = 34 * MIB;
constexpr size_t O_BN = O_XB;
constexpr size_t O_BT = O_XB + 16 * MIB;
constexpr size_t O_Q0 = 66 * MIB;
constexpr size_t O_K0 = 82 * MIB;
constexpr size_t O_VT0 = 98 * MIB;
constexpr size_t O_WQKV1 = 66 * MIB;
constexpr size_t O_WV1 = O_WQKV1 + 1280ull * 1024 * 2;
constexpr size_t O_WOUT1 = O_WV1 + 256ull * 1024 * 2;
constexpr size_t O_W13_1 = O_WOUT1 + 1024ull * 1024 * 2;
constexpr size_t O_W2_1 = O_W13_1 + 5632ull * 1024 * 2;
constexpr size_t O_BIG = 114 * MIB;
constexpr size_t O_XBC = O_BIG;
constexpr size_t O_HPREV = O_BIG;
constexpr size_t O_CN = O_BIG + 64 * MIB;
constexpr size_t O_MIX = O_BIG + 80 * MIB;
constexpr size_t O_H = O_BIG;
constexpr size_t O_Q1 = O_BIG;
constexpr size_t O_K1 = O_BIG + 32 * MIB;
constexpr size_t O_VT1 = O_BIG + 40 * MIB;
constexpr size_t O_AO = O_BIG + 48 * MIB;

struct Params {
  const float *x, *even_mix_norm, *even_w_in, *na_q_norm, *na_k_norm, *na_rel_bias, *conv_w, *conv_b, *dt_bias, *A_log,
      *Dskip, *out_norm, *even_w_out, *odd_mix_norm, *odd_w_qkv, *gqa_q_norm, *gqa_k_norm, *odd_w_out, *ffn_norm,
      *ffn_w13, *ffn_w2;
  float* out;
  char* ws;
  int ph0, ph1;
};

__device__ __forceinline__ int threadIdx_x_raw() { return (int)__builtin_amdgcn_workitem_id_x(); }
DI unsigned pack2(float a, float b) {
  f32x2 v = {a, b};
  bf16v2 r = __builtin_convertvector(v, bf16v2);
  return __builtin_bit_cast(unsigned, r);
}
DI uint2 pack4(f32x4 v) { return make_uint2(pack2(v[0], v[1]), pack2(v[2], v[3])); }
DI u16 f2bf(float a) { return (u16)(pack2(a, 0.f) & 0xffffu); }
DI float bflo(unsigned u) { return __uint_as_float(u << 16); }
DI float bfhi(unsigned u) { return __uint_as_float(u & 0xffff0000u); }
DI float bf2f(u16 h) { return __uint_as_float(((unsigned)h) << 16); }
DI bf16x8 as_bf8(uint4 v) { return __builtin_bit_cast(bf16x8, v); }
DI bf16x8 cat_bf8(uint2 a, uint2 b) { return as_bf8(make_uint4(a.x, a.y, b.x, b.y)); }
DI int vtid() { int t = threadIdx_x_raw() & 255; asm volatile("" : "+v"(t)); return t; }
DI int otid() { int t = threadIdx_x_raw(); asm volatile("" : "+v"(t)); return t; }
DI float silu(float x) { return x * __builtin_amdgcn_rcpf(1.f + __builtin_amdgcn_exp2f(-1.4426950408889634f * x)); }
DI float ex2(float x) { return __builtin_amdgcn_exp2f(x); }
DI float xor16_32_sum(float v) { v += __shfl_xor(v, 16); v += __shfl_xor(v, 32); return v; }
DI float xor16_32_max(float v) { v = fmaxf(v, __shfl_xor(v, 16)); v = fmaxf(v, __shfl_xor(v, 32)); return v; }
DI void wave_sync_lds() { __builtin_amdgcn_fence(__ATOMIC_ACQ_REL, "wavefront"); __builtin_amdgcn_wave_barrier(); }
DI void unpack8(uint4 u, float* f) {
  f[0] = bflo(u.x); f[1] = bfhi(u.x); f[2] = bflo(u.y); f[3] = bfhi(u.y);
  f[4] = bflo(u.z); f[5] = bfhi(u.z); f[6] = bflo(u.w); f[7] = bfhi(u.w);
}

struct WDesc { const float* W; int ldn, K, rows; u16* dst; const float* gain; int mode, coloff; };
DI int wt_srccol(int mode, int R, int coloff) {
  if (mode == 0) return coloff + R;
  const int pn = R >> 8, c = R & 255, bj = c >> 7, j = c & 127;
  if (mode == 1) return bj * 2816 + pn * 128 + j;
  const int wc = j >> 5, e = j & 31;
  if (mode == 2) {
    if (pn < 4) return (pn >> 1) * 512 + ((pn & 1) * 4 + wc) * 64 + bj * 32 + e;
    if (pn < 8) return 1536 + (R - 1024);
    if (pn < 16) return 2560 + (R - 2048);
    return (R - 4096 < 32) ? 4608 + (R - 4096) : -1;
  }
  if (pn < 4) return (pn * 4 + wc) * 64 + bj * 32 + e;
  return 1024 + wc * 64 + bj * 32 + e;
}
__device__ void wt_item(const WDesc& d, int item, int lane) {
  const int nr = d.rows >> 6, nn = item % nr, kk = item / nr;
  const int R = nn * 64 + lane;
  const int sc = wt_srccol(d.mode, R, d.coloff);
  const float* src = d.W + (sc >= 0 ? sc : 0);
  u16* dst = d.dst + (size_t)R * d.K + kk * 64;
#pragma unroll 2
  for (int k8 = 0; k8 < 8; ++k8) {
    float v[8];
#pragma unroll
    for (int e = 0; e < 8; ++e) {
      const int k = kk * 64 + k8 * 8 + e;
      float x = src[(size_t)k * d.ldn];
      if (d.gain) x *= d.gain[k];
      v[e] = (sc >= 0) ? x : 0.f;
    }
    *(uint4*)(dst + k8 * 8) = make_uint4(pack2(v[0], v[1]), pack2(v[2], v[3]), pack2(v[4], v[5]), pack2(v[6], v[7]));
  }
}
DI WDesc wt_desc(const Params& p, char* ws, int set, int i) {
  if (set == 0) {
    switch (i) {
      case 0: return WDesc{p.even_w_in, 4640, 1024, 4352, (u16*)(ws + O_WIN0), p.even_mix_norm, 2, 0};
      case 1: return WDesc{p.even_w_in, 4640, 1024, 512, (u16*)(ws + O_WV0), p.even_mix_norm, 0, 1024};
      case 2: return WDesc{p.even_w_out, 1024, 1536, 1024, (u16*)(ws + O_WOUT0), nullptr, 0, 0};
      case 3: return WDesc{p.ffn_w13, 5632, 1024, 5632, (u16*)(ws + O_W13_0), p.ffn_norm, 1, 0};
      default: return WDesc{p.ffn_w2, 1024, 2816, 1024, (u16*)(ws + O_W2_0), nullptr, 0, 0};
    }
  }
  switch (i) {
    case 0: return WDesc{p.odd_w_qkv, 1536, 1024, 1280, (u16*)(ws + O_WQKV1), p.odd_mix_norm, 3, 0};
    case 1: return WDesc{p.odd_w_qkv, 1536, 1024, 256, (u16*)(ws + O_WV1), p.odd_mix_norm, 0, 1280};
    case 2: return WDesc{p.odd_w_out, 1024, 1024, 1024, (u16*)(ws + O_WOUT1), nullptr, 0, 0};
    case 3: return WDesc{p.ffn_w13 + (size_t)1024 * 5632, 5632, 1024, 5632, (u16*)(ws + O_W13_1), p.ffn_norm + 1024, 1, 0};
    default: return WDesc{p.ffn_w2 + (size_t)2816 * 1024, 1024, 2816, 1024, (u16*)(ws + O_W2_1), nullptr, 0, 0};
  }
}
__device__ void wt_run(const Params& p, char* ws, int set, int gw, int nw, int lane) {
  const int c0 = set ? 320 : 1088, c1 = c0 + (set ? 64 : 128), c2 = c1 + (set ? 256 : 384), c3 = c2 + 1408, total = c3 + 704;
  for (int it = gw; it < total; it += nw) {
    const int i = it < c0 ? 0 : it < c1 ? 1 : it < c2 ? 2 : it < c3 ? 3 : 4;
    const int base = i == 0 ? 0 : i == 1 ? c0 : i == 2 ? c1 : i == 3 ? c2 : c3;
    const WDesc d = wt_desc(p, ws, set, i);
    wt_item(d, it - base, lane);
  }
}

__device__ void phase_prep(const Params& p) {
  char* ws = p.ws;
  asm volatile("" : "+s"(ws));
  const int tid = otid(), lane = tid & 63;
  const int gw = blockIdx.x * 8 + (tid >> 6), nw = gridDim.x * 8;
  PSUB(1) wt_run(p, ws, 0, gw, nw, lane);
  PSUB(2) for (int row0 = gw * 4; row0 < T; row0 += nw * 4) {
    float4 v[4][4];
#pragma unroll
    for (int rr = 0; rr < 4; ++rr)
#pragma unroll
      for (int i = 0; i < 4; ++i) v[rr][i] = *(const float4*)(p.x + (size_t)(row0 + rr) * 1024 + i * 256 + lane * 4);
#pragma unroll
    for (int rr = 0; rr < 4; ++rr) {
      u16* xb = (u16*)(ws + O_XB) + (size_t)(row0 + rr) * 1024;
      float ss = 0.f;
#pragma unroll
      for (int i = 0; i < 4; ++i) { const float4 a = v[rr][i]; ss += a.x * a.x + a.y * a.y + a.z * a.z + a.w * a.w; }
#pragma unroll
      for (int o = 32; o >= 1; o >>= 1) ss += __shfl_xor(ss, o);
      const float rs = rsqrtf(ss * (1.f / 1024.f) + EPS);
#pragma unroll
      for (int i = 0; i < 4; ++i) {
        const float4 a = v[rr][i];
        *(uint2*)(xb + i * 256 + lane * 4) = make_uint2(pack2(a.x * rs, a.y * rs), pack2(a.z * rs, a.w * rs));
      }
      if (lane == 0) {
        float* ssq = (float*)(ws + O_SSQ);
        const int row = row0 + rr;
        ssq[row] = ss; ssq[T + row] = 0.f; ssq[2 * T + row] = 0.f; ssq[3 * T + row] = 0.f;
      }
    }
  }
  PSUB(3) for (int idx = blockIdx.x * 512 + tid; idx < 65536; idx += gridDim.x * 512) {
    int s = idx >> 5, pp = idx & 31;
    float pos = (pp < 16) ? (float)(s >> 6) : (float)(s & 63);
    float freq = powf(10000.f, -(float)(pp & 15) / 16.f);
    float sn, cs;
    sincosf(pos * freq, &sn, &cs);
    ((float2*)(ws + O_ROPE))[idx] = make_float2(cs, sn);
  }
}
__device__ void phase_prep_l1(const Params& p, char* ws, int gw, int nw, int lane) { wt_run(p, ws, 1, gw, nw, lane); }
namespace pg8 {
#define PG8_LAS __attribute__((address_space(3)))
typedef unsigned short bf16_t;
constexpr int BM = 256, BK = 64, HALF = 128, HTB = HALF * BK * 2, STAGE_BYTES = 8 * HTB, NXCD = 8, WGM = 8;
DI int lds_byte(int r, int c) { const int st = (r >> 4) * 2 + (c >> 5), rr = r & 15, cc = c & 31, ob = rr * 64 + cc * 2; return st * 1024 + (ob ^ (((ob >> 9) & 1) << 5)); }
DI void stage_rc(int b, int& R, int& C) { const int st = b / 1024, sb = b % 1024, swz = sb ^ (((sb >> 9) & 1) << 5); R = (st >> 1) * 16 + swz / 64; C = (st & 1) * 32 + (swz % 64) / 2; }
DI int perm32(int rho) { const int n = rho >> 4, i = rho & 15; return 8 * (i >> 2) + 4 * n + (i & 3); }
struct Unit { int pm, pn; };
struct Gemm { const bf16_t* A; const bf16_t* Bt; int M, N, K; };
struct StaticOrder {
  int nM, nN, nwg, G, c;
  DI void init(int M, int N, int G_, int c_) { nM = M / BM; nN = N / BM; nwg = nM * nN; G = G_; c = c_; }
  DI bool next(int i, Unit& u) const {
    const long L = (long)i * G + c; if (L >= nwg) return false;
    int wgid = (int)L; { const int q = nwg / NXCD, r = nwg % NXCD, xcd = wgid % NXCD, off = wgid / NXCD; wgid = (xcd < r ? xcd * (q + 1) : r * (q + 1) + (xcd - r) * q) + off; }
    const int nig = WGM * nN, gid = wgid / nig, fm = gid * WGM, gsz = (nM - fm) < WGM ? (nM - fm) : WGM;
    u.pm = fm + ((wgid % nig) % gsz); u.pn = (wgid % nig) / gsz; return true;
  }
};
template <class Epi>
DI void gemm_phase(PG8_LAS unsigned char* lds, const Gemm g, const StaticOrder& S, const Epi& E) {
  const int tid = otid(), wid = __builtin_amdgcn_readfirstlane(tid >> 6), lane = tid & 63, wr = wid >> 2, wc = wid & 3, fr = lane & 15, fq = lane >> 4;
  const int K = g.K, nt = K / BK;
  unsigned voffA[2], voffB[2];
#pragma unroll
  for (int i = 0; i < 2; ++i) { int R, C; stage_rc(tid * 16 + i * 8192, R, C); const int Rb = E.perm ? ((R & ~31) + perm32(R & 31)) : R;
    voffA[i] = (unsigned)(R * K + C) * 2u; voffB[i] = (unsigned)(Rb * K + C) * 2u; }
  const size_t kstep = (size_t)(BK * 2);
  const size_t hstep = (size_t)HALF * K * 2;
  const size_t tstep = 2 * hstep;
  const unsigned ldsw = (unsigned)wid * 1024u;
  const int aoff = lds_byte(wr * 64 + fr, fq * 8), boff = lds_byte(wc * 32 + fr, fq * 8);
#define PG8_SA(b, h) (((b) * 2 + (h)) * HTB)
#define PG8_SB(b, h) ((4 + (b) * 2 + (h)) * HTB)
#define PG8_STAGE(bufoff, gbase, voff) do { _Pragma("unroll") for (int _i = 0; _i < 2; ++_i) \
    __builtin_amdgcn_global_load_lds((const unsigned*)((const char*)(gbase) + (voff)[_i]), (PG8_LAS unsigned*)(lds + (bufoff) + ldsw + _i * 8192), 16, 0, 0); } while (0)
#define PG8_LDA(dst, b, h) do { _Pragma("unroll") for (int m = 0; m < 4; ++m) _Pragma("unroll") for (int k = 0; k < 2; ++k) dst[m][k] = *(const PG8_LAS bf16x8*)(lds + PG8_SA(b, h) + aoff + m * 2048 + k * 1024); } while (0)
#define PG8_LDB(dst, b, h) do { _Pragma("unroll") for (int n = 0; n < 2; ++n) _Pragma("unroll") for (int k = 0; k < 2; ++k) dst[n][k] = *(const PG8_LAS bf16x8*)(lds + PG8_SB(b, h) + boff + n * 2048 + k * 1024); } while (0)
#define PG8_MMA(ai, bj, At, Bt) do { __builtin_amdgcn_s_setprio(1); _Pragma("unroll") for (int m = 0; m < 4; ++m) _Pragma("unroll") for (int n = 0; n < 2; ++n) _Pragma("unroll") for (int k = 0; k < 2; ++k) \
    acc[ai][bj][m][n] = __builtin_amdgcn_mfma_f32_16x16x32_bf16(Bt[n][k], At[m][k], acc[ai][bj][m][n], 0, 0, 0); __builtin_amdgcn_s_setprio(0); } while (0)
#define PG8_WAIT_V(n) asm volatile("s_waitcnt vmcnt(" #n ")" ::: "memory")
#define PG8_WAIT_L(n) asm volatile("s_waitcnt lgkmcnt(" #n ")" ::: "memory")
#define PG8_BAR __builtin_amdgcn_s_barrier()
#define PG8_SCHED __builtin_amdgcn_sched_barrier(0)
  Unit cur, nxt; int ui = 0;
  if (!S.next(0, cur)) return;
  if (E.ssq_in) {
    PG8_LAS float* rtab = (PG8_LAS float*)(lds + 131072);
    Unit uu;
    for (int q = 0; q < 8 && S.next(q, uu); ++q)
      if (tid < 256) rtab[q * 256 + tid] = rsqrtf(E.ssq_in[(E.kind == 4 ? uu.pn : uu.pm) * 256 + tid] * (1.f / 1024.f) + EPS);
    __syncthreads();
  }
  f32x4 acc[2][2][4][2];
#pragma unroll
  for (int a = 0; a < 2; ++a)
#pragma unroll
    for (int b = 0; b < 2; ++b)
#pragma unroll
      for (int m = 0; m < 4; ++m)
#pragma unroll
        for (int n = 0; n < 2; ++n) acc[a][b][m][n] = (f32x4){0.f, 0.f, 0.f, 0.f};
  bf16x8 At[4][2], B0[2][2], B1[2][2];
  const char* cA = (const char*)g.A + (size_t)cur.pm * tstep; const char* cB = (const char*)g.Bt + (size_t)cur.pn * tstep;
  PG8_STAGE(PG8_SB(0, 0), cB, voffB); PG8_STAGE(PG8_SA(0, 0), cA, voffA); PG8_STAGE(PG8_SB(0, 1), cB + hstep, voffB); PG8_STAGE(PG8_SA(0, 1), cA + hstep, voffA);
  if (wr == 1) PG8_BAR;
  PG8_WAIT_V(4); PG8_BAR;
  PG8_STAGE(PG8_SB(1, 0), cB + kstep, voffB); PG8_STAGE(PG8_SA(1, 0), cA + kstep, voffA); PG8_STAGE(PG8_SB(1, 1), cB + hstep + kstep, voffB);
  PG8_WAIT_V(6); PG8_BAR;
  for (;;) {
    const bool has_next = S.next(ui + 1, nxt);
    const char* nA = has_next ? (const char*)g.A + (size_t)nxt.pm * tstep : cA; const char* nB = has_next ? (const char*)g.Bt + (size_t)nxt.pn * tstep : cB;
    for (int t = 0; t < nt; t += 2) {
      const bool last = (t == nt - 2);
      const char* a1 = cA + (size_t)(t + 1) * kstep;
      const char* a2 = last ? nA : cA + (size_t)(t + 2) * kstep; const char* b2 = last ? nB : cB + (size_t)(t + 2) * kstep;
      const char* a3 = a2 + kstep; const char* b3 = b2 + kstep;
      PG8_LDB(B0, 0, 0); PG8_SCHED; PG8_LDA(At, 0, 0); PG8_STAGE(PG8_SA(1, 1), a1 + hstep, voffA);
      PG8_WAIT_L(8); PG8_BAR; PG8_WAIT_L(0); PG8_MMA(0, 0, At, B0); PG8_BAR; PG8_SCHED;
      PG8_LDB(B1, 0, 1); PG8_STAGE(PG8_SB(0, 0), b2, voffB);
      PG8_BAR; PG8_WAIT_L(0); PG8_MMA(0, 1, At, B1); PG8_BAR;
      PG8_LDA(At, 0, 1); PG8_STAGE(PG8_SA(0, 0), a2, voffA);
      PG8_BAR; PG8_WAIT_L(0); PG8_MMA(1, 0, At, B0); PG8_BAR; PG8_SCHED;
      PG8_STAGE(PG8_SB(0, 1), b2 + hstep, voffB);
      PG8_WAIT_V(6); PG8_BAR; PG8_MMA(1, 1, At, B1); PG8_BAR;
      PG8_LDB(B0, 1, 0); PG8_SCHED; PG8_LDA(At, 1, 0); PG8_STAGE(PG8_SA(0, 1), a2 + hstep, voffA);
      PG8_WAIT_L(8); PG8_BAR; PG8_WAIT_L(0); PG8_MMA(0, 0, At, B0); PG8_BAR; PG8_SCHED;
      PG8_LDB(B1, 1, 1); PG8_STAGE(PG8_SB(1, 0), b3, voffB);
      PG8_BAR; PG8_WAIT_L(0); PG8_MMA(0, 1, At, B1); PG8_BAR;
      PG8_LDA(At, 1, 1); PG8_STAGE(PG8_SA(1, 0), a3, voffA);
      PG8_BAR; PG8_WAIT_L(0); PG8_MMA(1, 0, At, B0); PG8_BAR; PG8_SCHED;
      PG8_STAGE(PG8_SB(1, 1), b3 + hstep, voffB);
      PG8_WAIT_V(6); PG8_BAR; PG8_MMA(1, 1, At, B1); PG8_BAR;
    }
    E(acc, cur, wr, wc, fr, fq, (const PG8_LAS float*)(lds + 131072) + ui * 256);
    if (!has_next) break;
#pragma unroll
    for (int a = 0; a < 2; ++a)
#pragma unroll
      for (int b = 0; b < 2; ++b)
#pragma unroll
        for (int m = 0; m < 4; ++m)
#pragma unroll
          for (int n = 0; n < 2; ++n) acc[a][b][m][n] = (f32x4){0.f, 0.f, 0.f, 0.f};
    cur = nxt; cA = nA; cB = nB; ++ui;
  }
  PG8_WAIT_V(0);
  if (wr == 0) PG8_BAR;
  PG8_BAR;
#undef PG8_SA
#undef PG8_SB
#undef PG8_STAGE
#undef PG8_LDA
#undef PG8_LDB
#undef PG8_MMA
#undef PG8_WAIT_V
#undef PG8_WAIT_L
#undef PG8_BAR
#undef PG8_SCHED
}
}

typedef f32x4 AccT[2][2][4][2];
DI uint4 pack8(f32x4 a, f32x4 b) { return make_uint4(pack2(a[0], a[1]), pack2(a[2], a[3]), pack2(b[0], b[1]), pack2(b[2], b[3])); }

struct EpiRes {
  static constexpr bool PERM = false;
  const float* res_f32; u16* xb; float* out_f32; float* ssq_out;
  DI void operator()(const AccT& acc, const pg8::Unit& u, int wr, int wc, int fr, int fq, const PG8_LAS float* rtab) const {
    const int row0 = u.pm * 256 + wr * 64 + fr, col0 = u.pn * 256 + wc * 32 + 4 * fq;
#pragma unroll
    for (int ai = 0; ai < 2; ++ai)
#pragma unroll
      for (int m = 0; m < 4; ++m) {
        const size_t r = row0 + ai * 128 + m * 16;
        float part = 0.f;
#pragma unroll
        for (int bj = 0; bj < 2; ++bj)
#pragma unroll
          for (int n = 0; n < 2; ++n) {
            const int c = col0 + bj * 128 + n * 16;
            float4 r4;
            if (res_f32) r4 = *(const float4*)(res_f32 + r * 1024 + c);
            else { uint2 rr = *(const uint2*)(xb + r * 1024 + c); r4 = make_float4(bflo(rr.x), bfhi(rr.x), bflo(rr.y), bfhi(rr.y)); }
            f32x4 a = acc[ai][bj][m][n];
            float4 v = make_float4(r4.x + a[0], r4.y + a[1], r4.z + a[2], r4.w + a[3]);
            if (out_f32) *(float4*)(out_f32 + r * 1024 + c) = v;
            else *(uint2*)(xb + r * 1024 + c) = make_uint2(pack2(v.x, v.y), pack2(v.z, v.w));
            part += v.x * v.x + v.y * v.y + v.z * v.z + v.w * v.w;
          }
        if (ssq_out) {
          part = xor16_32_sum(part);
          if (fq == 0) atomicAdd(ssq_out + r, part);
        }
      }
  }
};

struct EpiSwiglu {
  static constexpr bool PERM = true;
  const float* ssq_in; u16* h_out;
  DI void operator()(const AccT& acc, const pg8::Unit& u, int wr, int wc, int fr, int fq, const PG8_LAS float* rtab) const {
    const int row0 = u.pm * 256 + wr * 64 + fr;
#pragma unroll
    for (int ai = 0; ai < 2; ++ai)
#pragma unroll
      for (int m = 0; m < 4; ++m) {
        const size_t r = row0 + ai * 128 + m * 16;
        const float rs = rtab[ai * 128 + wr * 64 + m * 16 + fr];
        f32x4 h0, h1;
#pragma unroll
        for (int e = 0; e < 4; ++e) {
          h0[e] = silu(acc[ai][0][m][0][e] * rs) * (acc[ai][1][m][0][e] * rs);
          h1[e] = silu(acc[ai][0][m][1][e] * rs) * (acc[ai][1][m][1][e] * rs);
        }
        *(uint4*)(h_out + r * 2816 + u.pn * 128 + wc * 32 + 8 * fq) = pack8(h0, h1);
      }
  }
};

template <int L1>
struct EpiQK {
  static constexpr bool PERM = true;
  char* ws; u16* zout; const float* qn; const float* kn; const float* ssq_in;
  DI void operator()(const AccT& acc, const pg8::Unit& u, int wr, int wc, int fr, int fq, const PG8_LAS float* rtab) const {
    const int pn = u.pn;
    const int row0 = u.pm * 256 + wr * 64 + fr;
    const bool headnorm = L1 ? true : (pn < 4);
    const bool is_q = L1 ? (pn < 4) : (pn < 2);
#pragma unroll
    for (int ai = 0; ai < 2; ++ai)
#pragma unroll
      for (int m = 0; m < 4; ++m) {
        const size_t r = row0 + ai * 128 + m * 16;
        const float rs = L1 ? rtab[ai * 128 + wr * 64 + m * 16 + fr] : 1.f;
        f32x4 v[2][2];
#pragma unroll
        for (int bj = 0; bj < 2; ++bj)
#pragma unroll
          for (int n = 0; n < 2; ++n) v[bj][n] = acc[ai][bj][m][n] * rs;
        if (headnorm) {
          float ss = 0.f;
#pragma unroll
          for (int bj = 0; bj < 2; ++bj)
#pragma unroll
            for (int n = 0; n < 2; ++n)
              ss += v[bj][n][0] * v[bj][n][0] + v[bj][n][1] * v[bj][n][1] + v[bj][n][2] * v[bj][n][2] + v[bj][n][3] * v[bj][n][3];
          ss = xor16_32_sum(ss);
          const float hn = rsqrtf(ss * (1.f / 64.f) + EPS) * (is_q ? 0.125f * LOG2E : 1.f);
          const float* gn = is_q ? qn : kn;
#pragma unroll
          for (int bj = 0; bj < 2; ++bj)
#pragma unroll
            for (int n = 0; n < 2; ++n) {
              float4 g4 = *(const float4*)(gn + bj * 32 + 8 * fq + 4 * n);
              v[bj][n][0] *= hn * g4.x; v[bj][n][1] *= hn * g4.y; v[bj][n][2] *= hn * g4.z; v[bj][n][3] *= hn * g4.w;
            }
          u16* dst;
          if (L1) {
            const int s = (int)(r & 2047);
            const float4* rt = (const float4*)(ws + O_ROPE) + (size_t)s * 16;
#pragma unroll
            for (int bj = 0; bj < 2; ++bj)
#pragma unroll
              for (int n = 0; n < 2; ++n) {
                float4 cs = rt[bj * 8 + 2 * fq + n];
                float a0 = v[bj][n][0], a1 = v[bj][n][1], b0 = v[bj][n][2], b1 = v[bj][n][3];
                v[bj][n][0] = a0 * cs.x - a1 * cs.y; v[bj][n][1] = a0 * cs.y + a1 * cs.x;
                v[bj][n][2] = b0 * cs.z - b1 * cs.w; v[bj][n][3] = b0 * cs.w + b1 * cs.z;
              }
            dst = is_q ? (u16*)(ws + O_Q1) + r * 1024 + (pn * 4 + wc) * 64 : (u16*)(ws + O_K1) + r * 256 + wc * 64;
          } else {
            dst = (is_q ? (u16*)(ws + O_Q0) : (u16*)(ws + O_K0)) + r * 512 + ((pn & 1) * 4 + wc) * 64;
          }
#pragma unroll
          for (int bj = 0; bj < 2; ++bj) *(uint4*)(dst + bj * 32 + 8 * fq) = pack8(v[bj][0], v[bj][1]);
        } else if (pn < 8) {
          u16* dst = zout + r * 1024 + (pn - 4) * 256 + wc * 32 + 8 * fq;
#pragma unroll
          for (int bj = 0; bj < 2; ++bj) *(uint4*)(dst + bj * 128) = pack8(v[bj][0], v[bj][1]);
        } else if (pn < 16) {
          u16* dst = (u16*)(ws + O_XBC) + r * 2048 + (pn - 8) * 256 + wc * 32 + 8 * fq;
#pragma unroll
          for (int bj = 0; bj < 2; ++bj) *(uint4*)(dst + bj * 128) = pack8(v[bj][0], v[bj][1]);
        } else if (wc == 0) {
          float* dst = (float*)(ws + O_DTB) + r * 32 + 8 * fq;
          *(float4*)(dst) = make_float4(v[0][0][0], v[0][0][1], v[0][0][2], v[0][0][3]);
          *(float4*)(dst + 4) = make_float4(v[0][1][0], v[0][1][1], v[0][1][2], v[0][1][3]);
        }
      }
  }
};

struct EpiVT {
  static constexpr bool PERM = true;
  const float* ssq_in; u16* vt; int nh;
  DI void operator()(const AccT& acc, const pg8::Unit& u, int wr, int wc, int fr, int fq, const PG8_LAS float* rtab) const {
#pragma unroll
    for (int bj = 0; bj < 2; ++bj) {
      const int tok0 = u.pn * 256 + bj * 128 + wc * 32 + 8 * fq;
      f32x4 r0 = {1.f, 1.f, 1.f, 1.f}, r1 = r0;
      if (ssq_in) {
        const int lo = bj * 128 + wc * 32 + 8 * fq;
        r0 = *(const PG8_LAS f32x4*)(rtab + lo); r1 = *(const PG8_LAS f32x4*)(rtab + lo + 4);
      }
      const int b = tok0 >> 11, s = tok0 & 2047;
#pragma unroll
      for (int ai = 0; ai < 2; ++ai)
#pragma unroll
        for (int m = 0; m < 4; ++m) {
          const int f = u.pm * 256 + ai * 128 + wr * 64 + m * 16 + fr;
          const int hd = f >> 6, d = f & 63;
          u16* dstp = vt + ((size_t)((b * nh + hd) * 64 + d)) * 2048;
          const uint4 pk = pack8(acc[ai][bj][m][0] * r0, acc[ai][bj][m][1] * r1);
          if (nh == 4) {
            const int c = (s >> 3) & 3, pos0 = (s & ~31) + 16 * (c & 1) + 4 * (c >> 1);
            *(uint2*)(dstp + pos0) = make_uint2(pk.x, pk.y);
            *(uint2*)(dstp + pos0 + 8) = make_uint2(pk.z, pk.w);
          } else {
            *(uint4*)(dstp + s) = pk;
          }
        }
    }
  }
};
enum { EK_RES = 0, EK_SWIGLU = 1, EK_QK0 = 2, EK_QK1 = 3, EK_VT = 4 };
struct EpiAny {
  int kind; bool perm;
  char* ws; u16* zout; const float* qn; const float* kn; const float* ssq_in; float* ssq_out; const float* res_in; float* res_out; u16* xb_out; u16* o16; int nh;
  DI void operator()(const AccT& acc, const pg8::Unit& u, int wr, int wc, int fr, int fq, const PG8_LAS float* rtab) const {
    switch (kind) {
      case EK_RES: { EpiRes e{res_in, xb_out, res_out, ssq_out}; e(acc, u, wr, wc, fr, fq, rtab); } break;
      case EK_SWIGLU: { EpiSwiglu e{ssq_in, o16}; e(acc, u, wr, wc, fr, fq, rtab); } break;
      case EK_QK0: { EpiQK<0> e{ws, zout, qn, kn, ssq_in}; e(acc, u, wr, wc, fr, fq, rtab); } break;
      case EK_QK1: { EpiQK<1> e{ws, zout, qn, kn, ssq_in}; e(acc, u, wr, wc, fr, fq, rtab); } break;
      default: { EpiVT e{ssq_in, o16, nh}; e(acc, u, wr, wc, fr, fq, rtab); } break;
    }
  }
};

__device__ void na_tile(const Params& p, int tile) {
  const int tid = vtid(), lane = tid & 63, wave = tid >> 6, l15 = lane & 15, quad = lane >> 4;
  const int h = tile & 7, r = (tile >> 3) & 31, b = tile >> 8;
  const int c0 = min(max(16 * wave - 8, 0), 32);
  const int rs = min(max(r - 4, 0), 24);
  const u16* Q0 = (const u16*)(p.ws + O_Q0);
  const u16* K0 = (const u16*)(p.ws + O_K0) + (size_t)(b * 2048 + rs * 64 + c0 + 8 * (l15 >> 2) + (l15 & 3)) * 512 + h * 64 + 8 * quad;
  const u16* VT = (const u16*)(p.ws + O_VT0) + (size_t)((b * 8 + h) * 64 + l15) * 2048 + rs * 64 + c0 + 8 * quad;
  u16* mix = (u16*)(p.ws + O_MIX);
  const int tq = b * 2048 + r * 64 + 16 * wave + l15;
  bf16x8 qf[2];
#pragma unroll
  for (int ks = 0; ks < 2; ++ks) qf[ks] = as_bf8(*(const uint4*)(Q0 + (size_t)tq * 512 + h * 64 + 32 * ks + 8 * quad));
  const int cq = 16 * wave + l15;
  const int cs = min(max(cq - 8, 0), 48);
  const float* rpb = p.na_rel_bias + h * 465 + (rs - r + 7) * 31;
  const int d0 = c0 + 8 * quad - cq;
  const int w0 = d0 + cq - cs;
  f32x4 s[16];
  uint4 kb[2][4];
#pragma unroll
  for (int q4 = 0; q4 < 4; ++q4) kb[0][q4] = *(const uint4*)(K0 + (size_t)(4 * (q4 >> 1)) * 512 + 32 * (q4 & 1));
#pragma unroll
  for (int jr = 0; jr < 8; ++jr) {
    if (jr + 1 < 8) {
#pragma unroll
      for (int q4 = 0; q4 < 4; ++q4)
        kb[(jr + 1) & 1][q4] = *(const uint4*)(K0 + (size_t)((jr + 1) * 64 + 4 * (q4 >> 1)) * 512 + 32 * (q4 & 1));
    }
    float bias[8];
#pragma unroll
    for (int e = 0; e < 8; ++e) bias[e] = rpb[jr * 31 + min(max(d0 + 4 * (e >> 2) + (e & 3), -15), 15) + 15];
#pragma unroll
    for (int tt = 0; tt < 2; ++tt) {
      f32x4 a = {0.f, 0.f, 0.f, 0.f};
      a = MFMA(as_bf8(kb[jr & 1][2 * tt]), qf[0], a);
      a = MFMA(as_bf8(kb[jr & 1][2 * tt + 1]), qf[1], a);
#pragma unroll
      for (int rr = 0; rr < 4; ++rr) a[rr] = ((unsigned)(w0 + 4 * tt + rr) < 16u) ? (a[rr] + bias[tt * 4 + rr] * LOG2E) : -INFINITY;
      s[jr * 2 + tt] = a;
    }
  }
  float mx = -INFINITY;
#pragma unroll
  for (int u = 0; u < 16; ++u) mx = fmaxf(mx, fmaxf(fmaxf(s[u][0], s[u][1]), fmaxf(s[u][2], s[u][3])));
  mx = xor16_32_max(mx);
  uint4 vbuf[3][4];
#define NA_VLOAD(jr, dst) do { \
    _Pragma("unroll") for (int i2 = 0; i2 < 4; ++i2) dst[i2] = *(const uint4*)(VT + (size_t)(16 * i2) * 2048 + (jr) * 64); } while (0)
  NA_VLOAD(0, vbuf[0]);
  NA_VLOAD(1, vbuf[1]);
  float sum = 0.f;
#pragma unroll
  for (int u = 0; u < 16; ++u)
#pragma unroll
    for (int rr = 0; rr < 4; ++rr) { float pv = ex2(s[u][rr] - mx); s[u][rr] = pv; sum += pv; }
  sum = xor16_32_sum(sum);
  f32x4 o[4];
#pragma unroll
  for (int i2 = 0; i2 < 4; ++i2) o[i2] = (f32x4){0.f, 0.f, 0.f, 0.f};
#pragma unroll
  for (int jr = 0; jr < 8; ++jr) {
    if (jr + 2 < 8) NA_VLOAD(jr + 2, vbuf[(jr + 2) % 3]);
    bf16x8 pf = cat_bf8(pack4(s[2 * jr]), pack4(s[2 * jr + 1]));
#pragma unroll
    for (int i2 = 0; i2 < 4; ++i2) o[i2] = MFMA(as_bf8(vbuf[jr % 3][i2]), pf, o[i2]);
  }
#undef NA_VLOAD
  const float inv = 1.f / sum;
#pragma unroll
  for (int i2 = 0; i2 < 4; ++i2) *(uint2*)(mix + (size_t)tq * 1536 + h * 64 + 16 * i2 + 4 * quad) = pack4(o[i2] * inv);
}

__device__ void conv_tile(const Params& p, int tile) {
  const int tb = tile >> 2, cb = tile & 3;
  const int ch = cb * 512 + 2 * vtid();
  const int b = tb >> 5, s0 = (tb & 31) * 64;
  float w[4][2], bias[2];
#pragma unroll
  for (int k = 0; k < 4; ++k) { const float2 t = *(const float2*)(p.conv_w + k * 2048 + ch); w[k][0] = t.x; w[k][1] = t.y; }
  { const float2 t = *(const float2*)(p.conv_b + ch); bias[0] = t.x; bias[1] = t.y; }
  const u16* src = (const u16*)(p.ws + O_XBC) + (size_t)(b * 2048) * 2048 + ch;
  unsigned um2 = (s0 >= 2) ? *(const unsigned*)(src + (size_t)(s0 - 2) * 2048) : 0u;
  unsigned um1 = (s0 >= 1) ? *(const unsigned*)(src + (size_t)(s0 - 1) * 2048) : 0u;
  unsigned u0 = *(const unsigned*)(src + (size_t)s0 * 2048);
  u16* XT = (u16*)p.out + 16 * MIB;
  for (int sg = 0; sg < 8; ++sg) {
    unsigned nx[8];
#pragma unroll
    for (int e = 0; e < 8; ++e) { const int s = s0 + sg * 8 + e; nx[e] = (s + 1 < 2048) ? *(const unsigned*)(src + (size_t)(s + 1) * 2048) : 0u; }
    float y[2][8];
#pragma unroll
    for (int e = 0; e < 8; ++e) {
      const unsigned up1 = nx[e];
      y[0][e] = silu(w[0][0] * bflo(um2) + w[1][0] * bflo(um1) + w[2][0] * bflo(u0) + w[3][0] * bflo(up1) + bias[0]);
      y[1][e] = silu(w[0][1] * bfhi(um2) + w[1][1] * bfhi(um1) + w[2][1] * bfhi(u0) + w[3][1] * bfhi(up1) + bias[1]);
      um2 = um1; um1 = u0; u0 = up1;
    }
    const int sb = s0 + sg * 8;
    if (cb < 3) {
      u16* dstT = (cb < 2) ? XT + (size_t)(b * 1024 + ch) * 2048 + sb : (u16*)(p.ws + O_BT) + (size_t)(b * 512 + (ch - 1024)) * 2048 + sb;
#pragma unroll
      for (int c2 = 0; c2 < 2; ++c2)
        *(uint4*)(dstT + (size_t)c2 * 2048) = make_uint4(pack2(y[c2][0], y[c2][1]), pack2(y[c2][2], y[c2][3]), pack2(y[c2][4], y[c2][5]), pack2(y[c2][6], y[c2][7]));
    }
    if (cb >= 2) {
      u16* nat = (cb == 2) ? (u16*)(p.ws + O_BN) + (size_t)(b * 2048 + sb) * 512 + (ch - 1024)
                           : (u16*)(p.ws + O_CN) + (size_t)(b * 2048 + sb) * 512 + (ch - 1536);
#pragma unroll
      for (int e = 0; e < 8; ++e) *(unsigned*)(nat + e * 512) = pack2(y[0][e], y[1][e]);
    }
  }
}

__device__ void scan_item8(const Params& p, char* smem, int item) {
  const int tid = otid(), lane = tid & 63, wave = __builtin_amdgcn_readfirstlane(tid >> 6), l15 = lane & 15, quad = lane >> 4;
  const int dir = item & 1, h = (item >> 1) & 15, b = item >> 5, g = h >> 2;
  const float Ah = -__expf(p.A_log[dir * 16 + h]) * LOG2E;
  PG8_LAS float* wall = (PG8_LAS float*)((PG8_LAS unsigned char*)smem + 65536);
  PG8_LAS float* cdall = wall + 2048;
  const float* dtb = (const float*)(p.ws + O_DTB);
#pragma unroll
  for (int cc = 0; cc < 2; ++cc) {
    const int c = 2 * wave + cc;
    const int tokb = b * 2048 + c * 128;
    const float d0 = dtb[(size_t)(tokb + 2 * lane) * 32 + dir * 16 + h];
    const float d1 = dtb[(size_t)(tokb + 2 * lane + 1) * 32 + dir * 16 + h];
    const float a0 = d0 * Ah, a1 = d1 * Ah, ps = a0 + a1;
    float incl = ps;
#pragma unroll
    for (int o = 1; o < 64; o <<= 1) { float tv = __shfl_up(incl, o); if (lane >= o) incl += tv; }
    const float total = __shfl(incl, 63);
    const float excl = incl - ps;
    float w0, w1;
    if (dir == 0) { w0 = ex2(total - (excl + a0)) * d0; w1 = ex2(total - incl) * d1; }
    else { w0 = ex2(excl) * d0; w1 = ex2(excl + a0) * d1; }
    wall[c * 128 + 2 * lane] = w0; wall[c * 128 + 2 * lane + 1] = w1;
    if (lane == 0) cdall[c] = ex2(total);
  }
  __syncthreads();
  const int drow = 8 * wave + (lane >> 4);
  const u16* XTg = (const u16*)p.out + 16 * MIB + (size_t)(b * 1024 + h * 64) * 2048;
  const char* xsrc0 = (const char*)(XTg + (size_t)drow * 2048) + (((lane & 15) ^ (drow & 15)) << 4);
  const char* xsrc1 = (const char*)(XTg + (size_t)(drow + 4) * 2048) + (((lane & 15) ^ ((drow + 4) & 15)) << 4);
  PG8_LAS unsigned char* lds = (PG8_LAS unsigned char*)smem;
  const u16* BT = (const u16*)(p.ws + O_BT) + (size_t)(b * 512 + g * 128 + 16 * wave + l15) * 2048 + 8 * quad;
  u16* HP = (u16*)(p.ws + O_HPREV);
  f32x4 acc[4];
#pragma unroll
  for (int j = 0; j < 4; ++j) acc[j] = (f32x4){0.f, 0.f, 0.f, 0.f};
  u32x4v bA[4], bB[4], bC[4], bD[4];
#define SC_ISSUE(Bf, st, c) do { \
    __builtin_amdgcn_global_load_lds((const unsigned*)(xsrc0 + (c) * 256), (PG8_LAS unsigned*)(lds + (st) * 16384 + wave * 2048), 16, 0, 0); \
    __builtin_amdgcn_global_load_lds((const unsigned*)(xsrc1 + (c) * 256), (PG8_LAS unsigned*)(lds + (st) * 16384 + wave * 2048 + 1024), 16, 0, 0); \
    { const u16* _bp = BT + (c) * 128; \
      asm volatile("global_load_dwordx4 %0, %4, off\n\tglobal_load_dwordx4 %1, %4, off offset:64\n\tglobal_load_dwordx4 %2, %4, off offset:128\n\tglobal_load_dwordx4 %3, %4, off offset:192" \
                   : "=&v"(Bf[0]), "=&v"(Bf[1]), "=&v"(Bf[2]), "=&v"(Bf[3]) : "v"(_bp) : "memory"); } } while (0)
#define SC_STEP(Bf, st, c) do { \
    u16* hp = HP + ((size_t)(((b * 16 + (c)) * 16 + h) * 2 + dir) << 13); \
    _Pragma("unroll") for (int j = 0; j < 4; ++j) *(uint2*)(hp + (16 * j + l15) * 128 + 16 * wave + 4 * quad) = pack4(acc[j]); \
    const float cd = cdall[(c)]; \
    _Pragma("unroll") for (int j = 0; j < 4; ++j) acc[j] *= cd; \
    _Pragma("unroll") for (int ks = 0; ks < 4; ++ks) { \
      const f32x4 wav = *(const PG8_LAS f32x4*)(wall + (c) * 128 + 32 * ks + 8 * quad); \
      const f32x4 wbv = *(const PG8_LAS f32x4*)(wall + (c) * 128 + 32 * ks + 8 * quad + 4); \
      const float4 wa = make_float4(wav[0], wav[1], wav[2], wav[3]), wb = make_float4(wbv[0], wbv[1], wbv[2], wbv[3]); \
      _Pragma("unroll") for (int j = 0; j < 4; ++j) { \
        const u32x4v rawv = *(const PG8_LAS u32x4v*)(lds + (st) * 16384 + (16 * j + l15) * 256 + (((4 * ks + quad) ^ l15) << 4)); \
        const uint4 raw = make_uint4(rawv[0], rawv[1], rawv[2], rawv[3]); uint4 sc; \
        sc.x = pack2(bflo(raw.x) * wa.x, bfhi(raw.x) * wa.y); sc.y = pack2(bflo(raw.y) * wa.z, bfhi(raw.y) * wa.w); \
        sc.z = pack2(bflo(raw.z) * wb.x, bfhi(raw.z) * wb.y); sc.w = pack2(bflo(raw.w) * wb.z, bfhi(raw.w) * wb.w); \
        acc[j] = MFMA(__builtin_bit_cast(bf16x8, Bf[ks]), as_bf8(sc), acc[j]); } } } while (0)
#define SC_CH(s) (dir ? 15 - (s) : (s))
  SC_ISSUE(bA, 0, SC_CH(0)); SC_ISSUE(bB, 1, SC_CH(1)); SC_ISSUE(bC, 2, SC_CH(2));
#define SC_BAR() do { asm volatile("" ::: "memory"); __builtin_amdgcn_s_barrier(); asm volatile("" ::: "memory"); } while (0)
#define SC_WAIT(nlast, Bf) do { if (s4 == 12) asm volatile("s_waitcnt vmcnt(" #nlast ")" : "+v"(Bf[0]), "+v"(Bf[1]), "+v"(Bf[2]), "+v"(Bf[3]) :: "memory"); \
    else asm volatile("s_waitcnt vmcnt(18)" : "+v"(Bf[0]), "+v"(Bf[1]), "+v"(Bf[2]), "+v"(Bf[3]) :: "memory"); } while (0)
  for (int s4 = 0; s4 < 16; s4 += 4) {
    SC_ISSUE(bD, 3, SC_CH(s4 + 3));
    SC_WAIT(18, bA); SC_BAR();
    SC_STEP(bA, 0, SC_CH(s4));
    SC_BAR();
    if (s4 + 4 < 16) SC_ISSUE(bA, 0, SC_CH(s4 + 4));
    SC_WAIT(12, bB); SC_BAR();
    SC_STEP(bB, 1, SC_CH(s4 + 1));
    SC_BAR();
    if (s4 + 5 < 16) SC_ISSUE(bB, 1, SC_CH(s4 + 5));
    SC_WAIT(6, bC); SC_BAR();
    SC_STEP(bC, 2, SC_CH(s4 + 2));
    SC_BAR();
    if (s4 + 6 < 16) SC_ISSUE(bC, 2, SC_CH(s4 + 6));
    SC_WAIT(0, bD); SC_BAR();
    SC_STEP(bD, 3, SC_CH(s4 + 3));
    SC_BAR();
  }
#undef SC_BAR
#undef SC_WAIT
#undef SC_ISSUE
#undef SC_STEP
#undef SC_CH
  asm volatile("s_waitcnt vmcnt(0)" ::: "memory");
  __syncthreads();
}

__device__ void ssd_out_tile(const Params& p, char* smem, int tile) {
  const int tid = vtid(), lane = tid & 63, wave = tid >> 6, l15 = lane & 15, quad = lane >> 4;
  const int g = tile & 3, c = (tile >> 2) & 15, b = tile >> 6;
  const int hh = g * 4 + wave;
  u16* Gs = (u16*)smem;
  float* wv = (float*)(smem + 34816) + wave * 512;
  float* red = (float*)(smem + 34816 + 8192);
  const int tok0 = b * 2048 + c * 128;
  const u16* Cn = (const u16*)(p.ws + O_CN) + (size_t)tok0 * 512 + g * 128;
  const u16* Bn = (const u16*)(p.ws + O_BN) + (size_t)tok0 * 512 + g * 128;
  const float* dtb = (const float*)(p.ws + O_DTB);
  {
    f32x4 ga[8][2];
#pragma unroll
    for (int i = 0; i < 8; ++i) { ga[i][0] = (f32x4){0.f, 0.f, 0.f, 0.f}; ga[i][1] = ga[i][0]; }
#pragma unroll 2
    for (int ks = 0; ks < 4; ++ks) {
      bf16x8 cf[2];
#pragma unroll
      for (int jj = 0; jj < 2; ++jj)
        cf[jj] = as_bf8(*(const uint4*)(Cn + (size_t)(16 * (2 * wave + jj) + l15) * 512 + 32 * ks + 8 * quad));
#pragma unroll
      for (int i = 0; i < 8; ++i) {
        bf16x8 bf = as_bf8(*(const uint4*)(Bn + (size_t)(16 * i + l15) * 512 + 32 * ks + 8 * quad));
        ga[i][0] = MFMA(bf, cf[0], ga[i][0]);
        ga[i][1] = MFMA(bf, cf[1], ga[i][1]);
      }
    }
#pragma unroll
    for (int i = 0; i < 8; ++i)
#pragma unroll
      for (int jj = 0; jj < 2; ++jj)
        *(uint2*)(Gs + (16 * (2 * wave + jj) + l15) * 136 + 16 * i + 4 * quad) = pack4(ga[i][jj]);
  }
  {
    const float Af = -__expf(p.A_log[hh]) * LOG2E, Ab = -__expf(p.A_log[16 + hh]) * LOG2E;
    const float d0f = dtb[(size_t)(tok0 + 2 * lane) * 32 + hh], d1f = dtb[(size_t)(tok0 + 2 * lane + 1) * 32 + hh];
    const float d0b = dtb[(size_t)(tok0 + 2 * lane) * 32 + 16 + hh], d1b = dtb[(size_t)(tok0 + 2 * lane + 1) * 32 + 16 + hh];
    const float a0 = d0f * Af, a1 = d1f * Af, c0 = d0b * Ab, c1 = d1b * Ab;
    float inf_ = a0 + a1, inb = c0 + c1;
#pragma unroll
    for (int o = 1; o < 64; o <<= 1) {
      float t1 = __shfl_up(inf_, o), t2 = __shfl_up(inb, o);
      if (lane >= o) { inf_ += t1; inb += t2; }
    }
    const float totb = __shfl(inb, 63);
    const float exf = inf_ - (a0 + a1), exb = inb - (c0 + c1);
    *(float2*)(wv + 2 * lane) = make_float2(exf + a0, inf_);
    *(float2*)(wv + 128 + 2 * lane) = make_float2(totb - exb, totb - (exb + c0));
    *(float2*)(wv + 256 + 2 * lane) = make_float2(d0f, d1f);
    *(float2*)(wv + 384 + 2 * lane) = make_float2(d0b, d1b);
  }
  __syncthreads();
  const float Dh = p.Dskip[hh];
  const u16* XT = (const u16*)p.out + 16 * MIB + (size_t)(b * 1024 + hh * 64) * 2048 + c * 128;
  const u16* hf = (const u16*)(p.ws + O_HPREV) + ((size_t)(((b * 16 + c) * 16 + hh) * 2) << 13);
  const u16* hb = hf + 8192;
  const u16* Z = (const u16*)p.out;
  u16* mix = (u16*)(p.ws + O_MIX);
  #pragma unroll 1
  for (int jh = 0; jh < 2; ++jh) {
    f32x4 y[4][4];
    {
      float efv[4], ebv[4];
#pragma unroll
      for (int j = 0; j < 4; ++j) {
        const int l = 64 * jh + 16 * j + l15;
        efv[j] = ex2(wv[l]); ebv[j] = ex2(wv[128 + l]);
      }
#pragma unroll
      for (int i = 0; i < 4; ++i)
#pragma unroll
        for (int j = 0; j < 4; ++j) y[i][j] = (f32x4){0.f, 0.f, 0.f, 0.f};
#pragma unroll 2
      for (int ks = 0; ks < 4; ++ks) {
        bf16x8 cF[4], cB[4];
#pragma unroll
        for (int j = 0; j < 4; ++j) {
          const uint4 raw = *(const uint4*)(Cn + (size_t)(64 * jh + 16 * j + l15) * 512 + 32 * ks + 8 * quad);
          float f[8];
          unpack8(raw, f);
          cF[j] = as_bf8(make_uint4(pack2(f[0] * efv[j], f[1] * efv[j]), pack2(f[2] * efv[j], f[3] * efv[j]), pack2(f[4] * efv[j], f[5] * efv[j]), pack2(f[6] * efv[j], f[7] * efv[j])));
          cB[j] = as_bf8(make_uint4(pack2(f[0] * ebv[j], f[1] * ebv[j]), pack2(f[2] * ebv[j], f[3] * ebv[j]), pack2(f[4] * ebv[j], f[5] * ebv[j]), pack2(f[6] * ebv[j], f[7] * ebv[j])));
        }
#pragma unroll
        for (int i = 0; i < 4; ++i) {
          bf16x8 f1 = as_bf8(*(const uint4*)(hf + (16 * i + l15) * 128 + 32 * ks + 8 * quad));
          bf16x8 f2 = as_bf8(*(const uint4*)(hb + (16 * i + l15) * 128 + 32 * ks + 8 * quad));
#pragma unroll
          for (int j = 0; j < 4; ++j) { y[i][j] = MFMA(f1, cF[j], y[i][j]); y[i][j] = MFMA(f2, cB[j], y[i][j]); }
        }
      }
    }
#pragma unroll 2
    for (int ks = 0; ks < 4; ++ks) {
      const int sb = 32 * ks + 8 * quad;
      float afs[8], rbs[8], d0s[8], d1s[8];
      *(float4*)(afs) = *(const float4*)(wv + sb); *(float4*)(afs + 4) = *(const float4*)(wv + sb + 4);
      *(float4*)(rbs) = *(const float4*)(wv + 128 + sb); *(float4*)(rbs + 4) = *(const float4*)(wv + 128 + sb + 4);
      *(float4*)(d0s) = *(const float4*)(wv + 256 + sb); *(float4*)(d0s + 4) = *(const float4*)(wv + 256 + sb + 4);
      *(float4*)(d1s) = *(const float4*)(wv + 384 + sb); *(float4*)(d1s + 4) = *(const float4*)(wv + 384 + sb + 4);
      bf16x8 xf[4];
#pragma unroll
      for (int i = 0; i < 4; ++i) xf[i] = as_bf8(*(const uint4*)(XT + (size_t)(16 * i + l15) * 2048 + sb));
#pragma unroll
      for (int j = 0; j < 4; ++j) {
        const int l = 64 * jh + 16 * j + l15;
        const float afl = wv[l], rbl = wv[128 + l];
        float gv[8], m[8];
        unpack8(*(const uint4*)(Gs + l * 136 + sb), gv);
#pragma unroll
        for (int e = 0; e < 8; ++e) {
          const int s = sb + e;
          float ff = (s <= l) ? ex2(afl - afs[e]) * d0s[e] : 0.f;
          float fb = (s >= l) ? ex2(rbl - rbs[e]) * d1s[e] : 0.f;
          m[e] = gv[e] * (ff + fb) + ((s == l) ? Dh : 0.f);
        }
        bf16x8 mf = as_bf8(make_uint4(pack2(m[0], m[1]), pack2(m[2], m[3]), pack2(m[4], m[5]), pack2(m[6], m[7])));
#pragma unroll
        for (int i = 0; i < 4; ++i) y[i][j] = MFMA(xf[i], mf, y[i][j]);
      }
    }
#pragma unroll
    for (int j = 0; j < 4; ++j) {
      const int tok = tok0 + 64 * jh + 16 * j + l15;
      float part = 0.f;
#pragma unroll
      for (int i = 0; i < 4; ++i) {
        uint2 zr = *(const uint2*)(Z + (size_t)tok * 1024 + hh * 64 + 16 * i + 4 * quad);
        float z0 = bflo(zr.x), z1 = bfhi(zr.x), z2 = bflo(zr.y), z3 = bfhi(zr.y);
        y[i][j][0] *= silu(z0); y[i][j][1] *= silu(z1); y[i][j][2] *= silu(z2); y[i][j][3] *= silu(z3);
        part += y[i][j][0] * y[i][j][0] + y[i][j][1] * y[i][j][1] + y[i][j][2] * y[i][j][2] + y[i][j][3] * y[i][j][3];
      }
      part = xor16_32_sum(part);
      if (quad == 0) red[wave * 64 + 16 * j + l15] = part;
    }
    __syncthreads();
#pragma unroll
    for (int j = 0; j < 4; ++j) {
      const int tok = tok0 + 64 * jh + 16 * j + l15;
      const int q = 16 * j + l15;
      const float tot = red[q] + red[64 + q] + red[128 + q] + red[192 + q];
      const float rs = rsqrtf(tot * (1.f / 256.f) + EPS);
#pragma unroll
      for (int i = 0; i < 4; ++i) {
        float4 g4 = *(const float4*)(p.out_norm + hh * 64 + 16 * i + 4 * quad);
        f32x4 o;
        o[0] = y[i][j][0] * rs * g4.x; o[1] = y[i][j][1] * rs * g4.y; o[2] = y[i][j][2] * rs * g4.z; o[3] = y[i][j][3] * rs * g4.w;
        *(uint2*)(mix + (size_t)tok * 1536 + 512 + hh * 64 + 16 * i + 4 * quad) = pack4(o);
      }
    }
    __syncthreads();
  }
}

__device__ void gqa_tile8(const Params& p, char* smem, int tile) {
  const int tid = otid(), lane = tid & 63, wave = __builtin_amdgcn_readfirstlane(tid >> 6), l15 = lane & 15, quad = lane >> 4;
  const int rep = tile & 3, qb = (tile >> 2) & 3, kvh = (tile >> 4) & 3, b = tile >> 6;
  const int h = kvh * 4 + rep;
  const u16* Q1 = (const u16*)(p.ws + O_Q1);
  const u16* K1 = (const u16*)(p.ws + O_K1) + (size_t)(b * 2048) * 256 + kvh * 64;
  const u16* VT = (const u16*)(p.ws + O_VT1) + (size_t)((b * 4 + kvh) * 64) * 2048;
  u16* AO = (u16*)(p.ws + O_AO);
  const int tq0 = b * 2048 + qb * 512 + 64 * wave;
  bf16x8 qf[4][2];
#pragma unroll
  for (int j = 0; j < 4; ++j)
#pragma unroll
    for (int ks = 0; ks < 2; ++ks)
      qf[j][ks] = as_bf8(*(const uint4*)(Q1 + (size_t)(tq0 + 16 * j + l15) * 1024 + h * 64 + 32 * ks + 8 * quad));
  PG8_LAS unsigned char* lds = (PG8_LAS unsigned char*)smem;
  const int kr0 = 16 * wave + (lane >> 3), kr1 = kr0 + 8;
  const char* ksrc0 = (const char*)(K1 + (size_t)kr0 * 256) + ((((lane & 7) ^ ((kr0 >> 1) & 7))) << 4);
  const char* ksrc1 = (const char*)(K1 + (size_t)kr1 * 256) + ((((lane & 7) ^ ((kr1 >> 1) & 7))) << 4);
  const int vr0 = 8 * wave + (lane >> 4), vr1 = vr0 + 4;
  const char* vsrc0 = (const char*)(VT + (size_t)vr0 * 2048) + ((((lane & 15) ^ (vr0 & 15))) << 4);
  const char* vsrc1 = (const char*)(VT + (size_t)vr1 * 2048) + ((((lane & 15) ^ (vr1 & 15))) << 4);
  f32x4 o[4][4];
#pragma unroll
  for (int i = 0; i < 4; ++i)
#pragma unroll
    for (int j = 0; j < 4; ++j) o[i][j] = (f32x4){0.f, 0.f, 0.f, 0.f};
  float m[4] = {-1e30f, -1e30f, -1e30f, -1e30f}, lsum[4] = {0.f, 0.f, 0.f, 0.f};
#define GQ_ISSUE(t) do { const int _st = (t) & 3; \
    __builtin_amdgcn_global_load_lds((const unsigned*)(ksrc0 + (size_t)(t) * (128 * 512)), (PG8_LAS unsigned*)(lds + _st * 32768 + wave * 2048), 16, 0, 0); \
    __builtin_amdgcn_global_load_lds((const unsigned*)(ksrc1 + (size_t)(t) * (128 * 512)), (PG8_LAS unsigned*)(lds + _st * 32768 + wave * 2048 + 1024), 16, 0, 0); \
    __builtin_amdgcn_global_load_lds((const unsigned*)(vsrc0 + (t) * 256), (PG8_LAS unsigned*)(lds + _st * 32768 + 16384 + wave * 2048), 16, 0, 0); \
    __builtin_amdgcn_global_load_lds((const unsigned*)(vsrc1 + (t) * 256), (PG8_LAS unsigned*)(lds + _st * 32768 + 16384 + wave * 2048 + 1024), 16, 0, 0); } while (0)
#define GQ_BODY(st, hk, jb) do { \
    PG8_LAS const unsigned char* sK = lds + (st) * 32768; PG8_LAS const unsigned char* sV = sK + 16384; \
    f32x4 s[4][2]; \
    _Pragma("unroll") for (int i = 0; i < 4; ++i) { s[i][0] = (f32x4){0.f, 0.f, 0.f, 0.f}; s[i][1] = s[i][0]; } \
    _Pragma("unroll") for (int ks = 0; ks < 2; ++ks) \
      _Pragma("unroll") for (int i = 0; i < 4; ++i) { \
        const int kr = 64 * (hk) + 16 * i + l15; \
        bf16x8 kf = *(PG8_LAS const bf16x8*)(sK + kr * 128 + (((4 * ks + quad) ^ ((kr >> 1) & 7)) << 4)); \
        s[i][0] = MFMA(kf, qf[(jb)][ks], s[i][0]); s[i][1] = MFMA(kf, qf[(jb) + 1][ks], s[i][1]); } \
    bf16x8 pf[2][2]; \
    _Pragma("unroll") for (int j = 0; j < 2; ++j) { \
      float mx = -1e30f; \
      _Pragma("unroll") for (int i = 0; i < 4; ++i) mx = fmaxf(mx, fmaxf(fmaxf(s[i][j][0], s[i][j][1]), fmaxf(s[i][j][2], s[i][j][3]))); \
      mx = xor16_32_max(mx); \
      const float mn = fmaxf(m[(jb) + j], mx); \
      if (__builtin_amdgcn_ballot_w64(mn > m[(jb) + j]) != 0ull) { \
        const float alpha = ex2(m[(jb) + j] - mn); m[(jb) + j] = mn; lsum[(jb) + j] *= alpha; \
        _Pragma("unroll") for (int i2 = 0; i2 < 4; ++i2) o[i2][(jb) + j] *= alpha; } \
      float ps = 0.f; \
      _Pragma("unroll") for (int i = 0; i < 4; ++i) \
        _Pragma("unroll") for (int r = 0; r < 4; ++r) { float pv = ex2(s[i][j][r] - mn); s[i][j][r] = pv; ps += pv; } \
      lsum[(jb) + j] += ps; \
      pf[j][0] = cat_bf8(pack4(s[0][j]), pack4(s[1][j])); pf[j][1] = cat_bf8(pack4(s[2][j]), pack4(s[3][j])); } \
    _Pragma("unroll") for (int ks2 = 0; ks2 < 2; ++ks2) \
      _Pragma("unroll") for (int i2 = 0; i2 < 4; ++i2) { \
        const int vd = 16 * i2 + l15; \
        bf16x8 vf = *(PG8_LAS const bf16x8*)(sV + vd * 256 + (((8 * (hk) + 4 * ks2 + quad) ^ (vd & 15)) << 4)); \
        o[i2][(jb)] = MFMA(vf, pf[0][ks2], o[i2][(jb)]); o[i2][(jb) + 1] = MFMA(vf, pf[1][ks2], o[i2][(jb) + 1]); } \
    __builtin_amdgcn_sched_barrier(0); \
  } while (0)
  __syncthreads();
  GQ_ISSUE(0); GQ_ISSUE(1);
  for (int kt = 0; kt < 16; ++kt) {
    if (kt + 2 < 16) GQ_ISSUE(kt + 2);
    if (kt < 14) asm volatile("s_waitcnt vmcnt(8)" ::: "memory");
    else if (kt == 14) asm volatile("s_waitcnt vmcnt(4)" ::: "memory");
    else asm volatile("s_waitcnt vmcnt(0)" ::: "memory");
    asm volatile("" ::: "memory"); __builtin_amdgcn_s_barrier(); asm volatile("" ::: "memory");
    const int st = kt & 3;
    GQ_BODY(st, 0, 0); GQ_BODY(st, 0, 2); GQ_BODY(st, 1, 0); GQ_BODY(st, 1, 2);
  }
#undef GQ_ISSUE
#undef GQ_BODY
#pragma unroll
  for (int j = 0; j < 4; ++j) {
    const float inv = 1.f / xor16_32_sum(lsum[j]);
    const int tq = tq0 + 16 * j + l15;
#pragma unroll
    for (int i2 = 0; i2 < 4; ++i2) *(uint2*)(AO + (size_t)tq * 1024 + h * 64 + 16 * i2 + 4 * quad) = pack4(o[i2][j] * inv);
  }
}

#ifndef ONLY_PHASE
#define ONLY_PHASE -1
#endif
__device__ void run_phase(const Params& p, char* smem, int ph) {
  if (ONLY_PHASE >= 0 && ph != ONLY_PHASE) return;
  char* ws = p.ws;
  asm volatile("" : "+s"(ws));
  float* ssq = (float*)(ws + O_SSQ);
  u16* xb = (u16*)(ws + O_XB);
  const int half = __builtin_amdgcn_readfirstlane(threadIdx_x_raw() >> 8);
  char* sh = smem + half * 65536;
  const int G = gridDim.x, bid = blockIdx.x;
  const int vb = bid * 2 + half, nvb = G * 2;
  const bool is_gemm = (ph == 1) || (ph >= 5 && ph != 9);
  if (is_gemm) {
    const int nsub = (ph == 1 || ph == 8) ? 2 : 1;
    for (int sub = 0; sub < nsub; ++sub) {
      pg8::Gemm g{}; EpiAny E{}; E.ws = ws; E.zout = (u16*)p.out; E.perm = true; int c = bid;
      E.qn = (ph >= 8) ? p.gqa_q_norm : p.na_q_norm; E.kn = (ph >= 8) ? p.gqa_k_norm : p.na_k_norm;
      const bool l1 = ph >= 8;
      const u16* W13 = (const u16*)(ws + (l1 ? O_W13_1 : O_W13_0));
      const u16* W2 = (const u16*)(ws + (l1 ? O_W2_1 : O_W2_0));
      if (ph == 1 || ph == 8) {
        const float* sq = l1 ? ssq + 2 * T : nullptr;
        if (sub == 0) { g = pg8::Gemm{xb, (const u16*)(ws + (l1 ? O_WQKV1 : O_WIN0)), T, l1 ? 1280 : 4352, 1024}; E.kind = l1 ? EK_QK1 : EK_QK0; E.ssq_in = sq; }
        else { g = pg8::Gemm{(const u16*)(ws + (l1 ? O_WV1 : O_WV0)), xb, l1 ? 256 : 512, T, 1024}; E.kind = EK_VT; E.ssq_in = sq;
               E.o16 = (u16*)(ws + (l1 ? O_VT1 : O_VT0)); E.nh = l1 ? 4 : 8; c = (bid + G - 64) % G; }
      } else if (ph == 5 || ph == 10) {
        g = pg8::Gemm{(const u16*)(ws + (l1 ? O_AO : O_MIX)), (const u16*)(ws + (l1 ? O_WOUT1 : O_WOUT0)), T, 1024, l1 ? 1024 : 1536};
        E.kind = EK_RES; E.perm = false; E.res_in = l1 ? nullptr : p.x; E.res_out = nullptr; E.xb_out = xb; E.ssq_out = ssq + (l1 ? 3 * T : T);
      } else if (ph == 6 || ph == 11) {
        g = pg8::Gemm{xb, W13, T, 5632, 1024}; E.kind = EK_SWIGLU; E.ssq_in = ssq + (l1 ? 3 * T : T); E.o16 = (u16*)(ws + O_H);
      } else {
        g = pg8::Gemm{(const u16*)(ws + O_H), W2, T, 1024, 2816};
        E.kind = EK_RES; E.perm = false; E.res_in = nullptr; E.res_out = l1 ? p.out : nullptr; E.xb_out = xb; E.ssq_out = l1 ? nullptr : ssq + 2 * T;
      }
      pg8::StaticOrder S; S.init(g.M, g.N, G, c);
      pg8::gemm_phase(( PG8_LAS unsigned char*)smem, g, S, E);
      if (ph == 6 && G == 256 && bid >= 128) {
        const int tid = otid();
        phase_prep_l1(p, ws, (bid - 128) * 8 + (tid >> 6), 128 * 8, tid & 63);
      }
    }
    return;
  }
  switch (ph) {
    case 0: phase_prep(p); break;
    case 2: {
      PSUB(4) for (int t = vb; t < 2048; t += nvb) na_tile(p, t);
      PSUB(5) for (int t = vb; t < 1024; t += nvb) conv_tile(p, t);
      float* dtb = (float*)(ws + O_DTB);
      for (int idx = bid * 512 + otid(); idx < T * 32; idx += G * 512) {
        float v = dtb[idx] + p.dt_bias[idx & 31];
        dtb[idx] = (v > 20.f) ? v : log1pf(expf(v));
      }
    } break;
    case 3: {
      for (int t0 = 0; t0 < 256; t0 += G) {
        int item = min(t0 + bid, 255);
        if (G == 256) {
          const int xcd = bid & 7, j = bid >> 3, grp = xcd * 4 + (j >> 3), idx8 = j & 7;
          item = (idx8 & 1) + 2 * ((grp & 3) * 4 + (idx8 >> 1)) + 32 * (grp >> 2);
        }
        scan_item8(p, smem, item);
      }
      if (G != 256) { const int tid = otid(); phase_prep_l1(p, ws, bid * 8 + (tid >> 6), G * 8, tid & 63); }
    } break;
    case 4:
      for (int t0 = 0; t0 < 512; t0 += nvb) ssd_out_tile(p, sh, min(t0 + vb, 511));
      break;
    case 9:
      if (G == 256) {
        const int xcd = bid & 7, j = bid >> 3;
        for (int r = 0; r < 2; ++r) gqa_tile8(p, smem, (r * 16 + xcd * 2 + (j >> 4)) * 16 + (j & 15));
      } else {
        for (int t0 = 0; t0 < 512; t0 += G) gqa_tile8(p, smem, min(t0 + bid, 511));
      }
      break;
    default: break;
  }
}

#define XB_TMO      128
#define XB_XCNT(j)  (256  + 64 * (j))
#define XB_XSUB(j)  (1280 + 64 * (j))
#define XB_XGEN(j)  (2304 + 64 * (j))
#define XB_TOP      3328
#define XB_TOPGEN   3392
#define XCD_BAR_WORDS 3456
#define XB_SPIN_CAP (1u << 18)
#define LAS __attribute__((address_space(3)))
DI unsigned xb_ld(unsigned* p) { return __hip_atomic_load(p, __ATOMIC_RELAXED, __HIP_MEMORY_SCOPE_AGENT); }
DI unsigned xb_add(unsigned* p, unsigned v) { return __hip_atomic_fetch_add(p, v, __ATOMIC_RELAXED, __HIP_MEMORY_SCOPE_AGENT); }
DI unsigned xb_xcc_id() { return (unsigned)__builtin_amdgcn_s_getreg((3 << 11) | 20) & 0xFu; }
#define XB_SPIN(cond, bar) do { unsigned _sp = 0; while (cond) { __builtin_amdgcn_s_sleep(1); \
    if ((++_sp & 255u) == 0u) { if (xb_ld(&(bar)[XB_TMO])) break; if (_sp > XB_SPIN_CAP) { atomicAdd(&(bar)[XB_TMO], 1u); break; } } } } while (0)
struct XcdBarrier { unsigned* bar; unsigned x; volatile LAS unsigned* st; };
DI XcdBarrier xcd_barrier_post(unsigned* bar, volatile LAS unsigned* st) {
  XcdBarrier b; b.bar = bar; b.x = xb_xcc_id(); b.st = st;
  if (threadIdx_x_raw() == 0) (void)xb_add(&bar[XB_XCNT(b.x)], 1u);
  return b;
}
DI void xcd_barrier_complete(unsigned* bar, unsigned x, unsigned& nloc, unsigned& nx) {
  const unsigned G = gridDim.x * gridDim.y * gridDim.z;
  unsigned sum, cnt, mine, sp = 0u;
  for (;;) {
    sum = 0u; cnt = 0u; mine = 0u;
#pragma unroll
    for (unsigned j = 0; j < 16; ++j) { const unsigned c = xb_ld(&bar[XB_XCNT(j)]); sum += c; cnt += (c > 0u) ? 1u : 0u; mine = (j == x) ? c : mine; }
    if (sum == G) break;
    __builtin_amdgcn_s_sleep(1);
    if ((++sp & 255u) == 0u) { if (xb_ld(&bar[XB_TMO])) break; if (sp > XB_SPIN_CAP) { atomicAdd(&bar[XB_TMO], 1u); break; } }
  }
  nloc = mine > 0u ? mine : 1u; nx = cnt > 0u ? cnt : 1u;
}
DI void xcd_barrier(const XcdBarrier& b) {
  asm volatile("s_waitcnt vmcnt(0)" ::: "memory");
  __syncthreads();
  if (threadIdx_x_raw() == 0) {
    unsigned* bar = b.bar;
    asm volatile("" : "+s"(bar));
    __builtin_amdgcn_s_waitcnt(0);
    unsigned nloc = b.st[0], nx = b.st[1];
    if (nloc == 0u) { xcd_barrier_complete(bar, b.x, nloc, nx); b.st[0] = nloc; b.st[1] = nx; }
    const unsigned old = xb_add(&bar[XB_XSUB(b.x)], 1u);
    const unsigned gen = old / nloc;
    if (old + 1u == (gen + 1u) * nloc) {
      __builtin_amdgcn_fence(__ATOMIC_RELEASE, "agent");
      asm volatile("s_waitcnt vmcnt(0)" ::: "memory");
      const unsigned og = xb_add(&bar[XB_TOP], 1u);
      const unsigned tg = og / nx;
      if (og + 1u == (tg + 1u) * nx) xb_add(&bar[XB_TOPGEN], 1u);
      else XB_SPIN(xb_ld(&bar[XB_TOPGEN]) == tg, bar);
      __builtin_amdgcn_fence(__ATOMIC_ACQUIRE, "agent");
      xb_add(&bar[XB_XGEN(b.x)], 1u);
      asm volatile("s_waitcnt vmcnt(0)" ::: "memory");
    } else {
      XB_SPIN(xb_ld(&bar[XB_XGEN(b.x)]) == gen, bar);
      __builtin_amdgcn_fence(__ATOMIC_ACQUIRE, "agent");
      asm volatile("s_waitcnt vmcnt(0)" ::: "memory");
    }
  }
  __syncthreads();
}

__global__ void __launch_bounds__(512, 2) mega(Params p) {
  extern __shared__ __attribute__((aligned(16))) char smem[];
  __shared__ uint4 xb_words;
  cg::grid_group grid = cg::this_grid();
  if (threadIdx_x_raw() == 0) xb_words = make_uint4(0u, 0u, 0u, 0u);
  __syncthreads();
  XcdBarrier xb = xcd_barrier_post((unsigned*)(p.ws + O_BAR), (volatile LAS unsigned*)&xb_words);
  if (p.ph0 < 0) grid.sync();
  for (int ph = p.ph0; ph < p.ph1; ++ph) {
    int nrep = 1;
#if PROBE_REP_MASK
    if ((PROBE_REP_MASK >> ph) & 1) nrep = 2;
#endif
    for (int r = 0; r < nrep; ++r) {
      run_phase(p, smem, ph);
      if (r + 1 < nrep || ph + 1 < p.ph1) xcd_barrier(xb);
    }
  }
#if PROBE_EXTRA_SYNCS
  for (int i = 0; i < PROBE_EXTRA_SYNCS; ++i) xcd_barrier(xb);
#endif
}

extern "C" void kernel_launch(void* const* d_in, const int* in_sizes, int n_in, void* d_out, int out_size, void* d_ws,
                              size_t ws_size, hipStream_t stream) {
  static int grid_blocks = 0;
  if (!grid_blocks) {
    (void)hipFuncSetAttribute((const void*)mega, hipFuncAttributeMaxDynamicSharedMemorySize, SMEM_BYTES);
    int dev = 0, cus = 0, per_cu = 0;
    (void)hipGetDevice(&dev);
    (void)hipDeviceGetAttribute(&cus, hipDeviceAttributeMultiprocessorCount, dev);
    (void)hipOccupancyMaxActiveBlocksPerMultiprocessor(&per_cu, mega, 512, SMEM_BYTES);
    if (per_cu < 1) per_cu = 1;
    grid_blocks = cus;
  }
  Params p{};
  const float** pp = (const float**)&p;
  for (int i = 0; i < 21; ++i) pp[i] = (const float*)d_in[i];
  p.out = (float*)d_out;
  p.ws = (char*)d_ws;
  (void)hipMemsetAsync((char*)d_ws + O_BAR, 0, XCD_BAR_WORDS * 4, stream);
#if MULTI_LAUNCH
  for (int ph = 0; ph < NPHASE; ++ph) {
    p.ph0 = ph; p.ph1 = ph + 1;
    hipLaunchKernelGGL(mega, dim3(grid_blocks), dim3(512), SMEM_BYTES, stream, p);
  }
#else
  p.ph0 = 0; p.ph1 = NPHASE;
  void* args[] = {&p};
  hipError_t e = hipLaunchCooperativeKernel((const void*)mega, dim3(grid_blocks), dim3(512), args, SMEM_BYTES, stream);
  if (e != hipSuccess) fprintf(stderr, "cooperative launch failed: %s (grid %d)\n", hipGetErrorString(e), grid_blocks);
#endif
}
```

```cpp
#include <hip/hip_runtime.h>
#include <hip/hip_bf16.h>
#include <hip/hip_cooperative_groups.h>
#include <cstdio>
namespace cg = cooperative_groups;

#define PROBE_REP_MASK 0
#define PROBE_EXTRA_SYNCS 0
#define PROBE_SUB 0
#define PSUB(k) for (int _r = 0; _r < ((PROBE_SUB == (k)) ? 2 : 1); ++_r)
#ifndef MULTI_LAUNCH
#define MULTI_LAUNCH 0
#endif

typedef __attribute__((ext_vector_type(8))) short bf16x8;
typedef __attribute__((ext_vector_type(4))) float f32x4;
typedef __attribute__((ext_vector_type(2))) float f32x2;
typedef __attribute__((ext_vector_type(2))) __bf16 bf16v2;
typedef unsigned short u16;
typedef unsigned u32x4v __attribute__((ext_vector_type(4)));

#define DI __device__ __forceinline__
#define MFMA(a, b, c) __builtin_amdgcn_mfma_f32_16x16x32_bf16((a), (b), (c), 0, 0, 0)

constexpr int T = 16384;
constexpr float EPS = 1e-6f;
constexpr float LOG2E = 1.4426950408889634f;
constexpr int NPHASE = 13;
constexpr int SMEM_BYTES = 131072 + 8192;

constexpr size_t MIB = 1u << 20;
constexpr size_t O_WIN0 = 0;
constexpr size_t O_WV0 = O_WIN0 + 4352ull * 1024 * 2;
constexpr size_t O_WOUT0 = O_WV0 + 512ull * 1024 * 2;
constexpr size_t O_W13_0 = O_WOUT0 + 1024ull * 1536 * 2;
constexpr size_t O_W2_0 = O_W13_0 + 5632ull * 1024 * 2;
constexpr size_t O_ROPE = 31 * MIB;
constexpr size_t O_DTB = O_ROPE + 524288;
constexpr size_t O_SSQ = O_DTB + 2097152;
constexpr size_t O_BAR = O_SSQ + 262144;
constexpr size_t O_XB = 34 * MIB;
constexpr size_t O_BN = O_XB;
constexpr size_t O_BT = O_XB + 16 * MIB;
constexpr size_t O_Q0 = 66 * MIB;
constexpr size_t O_K0 = 82 * MIB;
constexpr size_t O_VT0 = 98 * MIB;
constexpr size_t O_WQKV1 = 66 * MIB;
constexpr size_t O_WV1 = O_WQKV1 + 1280ull * 1024 * 2;
constexpr size_t O_WOUT1 = O_WV1 + 256ull * 1024 * 2;
constexpr size_t O_W13_1 = O_WOUT1 + 1024ull * 1024 * 2;
constexpr size_t O_W2_1 = O_W13_1 + 5632ull * 1024 * 2;
constexpr size_t O_BIG = 114 * MIB;
constexpr size_t O_XBC = O_BIG;
constexpr size_t O_HPREV = O_BIG;
constexpr size_t O_CN = O_BIG + 64 * MIB;
constexpr size_t O_MIX = O_BIG + 80 * MIB;
constexpr size_t O_H = O_BIG;
constexpr size_t O_Q1 = O_BIG;
constexpr size_t O_K1 = O_BIG + 32 * MIB;
constexpr size_t O_VT1 = O_BIG + 40 * MIB;
constexpr size_t O_AO = O_BIG + 48 * MIB;

struct Params {
  const float *x, *even_mix_norm, *even_w_in, *na_q_norm, *na_k_norm, *na_rel_bias, *conv_w, *conv_b, *dt_bias, *A_log,
      *Dskip, *out_norm, *even_w_out, *odd_mix_norm, *odd_w_qkv, *gqa_q_norm, *gqa_k_norm, *odd_w_out, *ffn_norm,
      *ffn_w13, *ffn_w2;
  float* out;
  char* ws;
  int ph0, ph1;
};

__device__ __forceinline__ int threadIdx_x_raw() { return (int)__builtin_amdgcn_workitem_id_x(); }
DI unsigned pack2(float a, float b) {
  f32x2 v = {a, b};
  bf16v2 r = __builtin_convertvector(v, bf16v2);
  return __builtin_bit_cast(unsigned, r);
}
DI uint2 pack4(f32x4 v) { return make_uint2(pack2(v[0], v[1]), pack2(v[2], v[3])); }
DI u16 f2bf(float a) { return (u16)(pack2(a, 0.f) & 0xffffu); }
DI float bflo(unsigned u) { return __uint_as_float(u << 16); }
DI float bfhi(unsigned u) { return __uint_as_float(u & 0xffff0000u); }
DI float bf2f(u16 h) { return __uint_as_float(((unsigned)h) << 16); }
DI bf16x8 as_bf8(uint4 v) { return __builtin_bit_cast(bf16x8, v); }
DI bf16x8 cat_bf8(uint2 a, uint2 b) { return as_bf8(make_uint4(a.x, a.y, b.x, b.y)); }
DI int vtid() { int t = threadIdx_x_raw() & 255; asm volatile("" : "+v"(t)); return t; }
DI int otid() { int t = threadIdx_x_raw(); asm volatile("" : "+v"(t)); return t; }
DI float silu(float x) { return x * __builtin_amdgcn_rcpf(1.f + __builtin_amdgcn_exp2f(-1.4426950408889634f * x)); }
DI float ex2(float x) { return __builtin_amdgcn_exp2f(x); }
DI float xor16_32_sum(float v) { v += __shfl_xor(v, 16); v += __shfl_xor(v, 32); return v; }
DI float xor16_32_max(float v) { v = fmaxf(v, __shfl_xor(v, 16)); v = fmaxf(v, __shfl_xor(v, 32)); return v; }
DI void wave_sync_lds() { __builtin_amdgcn_fence(__ATOMIC_ACQ_REL, "wavefront"); __builtin_amdgcn_wave_barrier(); }
DI void unpack8(uint4 u, float* f) {
  f[0] = bflo(u.x); f[1] = bfhi(u.x); f[2] = bflo(u.y); f[3] = bfhi(u.y);
  f[4] = bflo(u.z); f[5] = bfhi(u.z); f[6] = bflo(u.w); f[7] = bfhi(u.w);
}

struct WDesc { const float* W; int ldn, K, rows; u16* dst; const float* gain; int mode, coloff; };
DI int wt_srccol(int mode, int R, int coloff) {
  if (mode == 0) return coloff + R;
  const int pn = R >> 8, c = R & 255, bj = c >> 7, j = c & 127;
  if (mode == 1) return bj * 2816 + pn * 128 + j;
  const int wc = j >> 5, e = j & 31;
  if (mode == 2) {
    if (pn < 4) return (pn >> 1) * 512 + ((pn & 1) * 4 + wc) * 64 + bj * 32 + e;
    if (pn < 8) return 1536 + (R - 1024);
    if (pn < 16) return 2560 + (R - 2048);
    return (R - 4096 < 32) ? 4608 + (R - 4096) : -1;
  }
  if (pn < 4) return (pn * 4 + wc) * 64 + bj * 32 + e;
  return 1024 + wc * 64 + bj * 32 + e;
}
__device__ void wt_item(const WDesc& d, int item, int lane) {
  const int nr = d.rows >> 6, nn = item % nr, kk = item / nr;
  const int R = nn * 64 + lane;
  const int sc = wt_srccol(d.mode, R, d.coloff);
  const float* src = d.W + (sc >= 0 ? sc : 0);
  u16* dst = d.dst + (size_t)R * d.K + kk * 64;
#pragma unroll 2
  for (int k8 = 0; k8 < 8; ++k8) {
    float v[8];
#pragma unroll
    for (int e = 0; e < 8; ++e) {
      const int k = kk * 64 + k8 * 8 + e;
      float x = src[(size_t)k * d.ldn];
      if (d.gain) x *= d.gain[k];
      v[e] = (sc >= 0) ? x : 0.f;
    }
    *(uint4*)(dst + k8 * 8) = make_uint4(pack2(v[0], v[1]), pack2(v[2], v[3]), pack2(v[4], v[5]), pack2(v[6], v[7]));
  }
}
DI WDesc wt_desc(const Params& p, char* ws, int set, int i) {
  if (set == 0) {
    switch (i) {
      case 0: return WDesc{p.even_w_in, 4640, 1024, 4352, (u16*)(ws + O_WIN0), p.even_mix_norm, 2, 0};
      case 1: return WDesc{p.even_w_in, 4640, 1024, 512, (u16*)(ws + O_WV0), p.even_mix_norm, 0, 1024};
      case 2: return WDesc{p.even_w_out, 1024, 1536, 1024, (u16*)(ws + O_WOUT0), nullptr, 0, 0};
      case 3: return WDesc{p.ffn_w13, 5632, 1024, 5632, (u16*)(ws + O_W13_0), p.ffn_norm, 1, 0};
      default: return WDesc{p.ffn_w2, 1024, 2816, 1024, (u16*)(ws + O_W2_0), nullptr, 0, 0};
    }
  }
  switch (i) {
    case 0: return WDesc{p.odd_w_qkv, 1536, 1024, 1280, (u16*)(ws + O_WQKV1), p.odd_mix_norm, 3, 0};
    case 1: return WDesc{p.odd_w_qkv, 1536, 1024, 256, (u16*)(ws + O_WV1), p.odd_mix_norm, 0, 1280};
    case 2: return WDesc{p.odd_w_out, 1024, 1024, 1024, (u16*)(ws + O_WOUT1), nullptr, 0, 0};
    case 3: return WDesc{p.ffn_w13 + (size_t)1024 * 5632, 5632, 1024, 5632, (u16*)(ws + O_W13_1), p.ffn_norm + 1024, 1, 0};
    default: return WDesc{p.ffn_w2 + (size_t)2816 * 1024, 1024, 2816, 1024, (u16*)(ws + O_W2_1), nullptr, 0, 0};
  }
}
__device__ void wt_run(const Params& p, char* ws, int set, int gw, int nw, int lane) {
  const int c0 = set ? 320 : 1088, c1 = c0 + (set ? 64 : 128), c2 = c1 + (set ? 256 : 384), c3 = c2 + 1408, total = c3 + 704;
  for (int it = gw; it < total; it += nw) {
    const int i = it < c0 ? 0 : it < c1 ? 1 : it < c2 ? 2 : it < c3 ? 3 : 4;
    const int base = i == 0 ? 0 : i == 1 ? c0 : i == 2 ? c1 : i == 3 ? c2 : c3;
    const WDesc d = wt_desc(p, ws, set, i);
    wt_item(d, it - base, lane);
  }
}

__device__ void phase_prep(const Params& p) {
  char* ws = p.ws;
  asm volatile("" : "+s"(ws));
  const int tid = otid(), lane = tid & 63;
  const int gw = blockIdx.x * 8 + (tid >> 6), nw = gridDim.x * 8;
  PSUB(1) wt_run(p, ws, 0, gw, nw, lane);
  PSUB(2) for (int row0 = gw * 4; row0 < T; row0 += nw * 4) {
    float4 v[4][4];
#pragma unroll
    for (int rr = 0; rr < 4; ++rr)
#pragma unroll
      for (int i = 0; i < 4; ++i) v[rr][i] = *(const float4*)(p.x + (size_t)(row0 + rr) * 1024 + i * 256 + lane * 4);
#pragma unroll
    for (int rr = 0; rr < 4; ++rr) {
      u16* xb = (u16*)(ws + O_XB) + (size_t)(row0 + rr) * 1024;
      float ss = 0.f;
#pragma unroll
      for (int i = 0; i < 4; ++i) { const float4 a = v[rr][i]; ss += a.x * a.x + a.y * a.y + a.z * a.z + a.w * a.w; }
#pragma unroll
      for (int o = 32; o >= 1; o >>= 1) ss += __shfl_xor(ss, o);
      const float rs = rsqrtf(ss * (1.f / 1024.f) + EPS);
#pragma unroll
      for (int i = 0; i < 4; ++i) {
        const float4 a = v[rr][i];
        *(uint2*)(xb + i * 256 + lane * 4) = make_uint2(pack2(a.x * rs, a.y * rs), pack2(a.z * rs, a.w * rs));
      }
      if (lane == 0) {
        float* ssq = (float*)(ws + O_SSQ);
        const int row = row0 + rr;
        ssq[row] = ss; ssq[T + row] = 0.f; ssq[2 * T + row] = 0.f; ssq[3 * T + row] = 0.f;
      }
    }
  }
  PSUB(3) for (int idx = blockIdx.x * 512 + tid; idx < 65536; idx += gridDim.x * 512) {
    int s = idx >> 5, pp = idx & 31;
    float pos = (pp < 16) ? (float)(s >> 6) : (float)(s & 63);
    float freq = powf(10000.f, -(float)(pp & 15) / 16.f);
    float sn, cs;
    sincosf(pos * freq, &sn, &cs);
    ((float2*)(ws + O_ROPE))[idx] = make_float2(cs, sn);
  }
}
__device__ void phase_prep_l1(const Params& p, char* ws, int gw, int nw, int lane) { wt_run(p, ws, 1, gw, nw, lane); }
namespace pg8 {
#define PG8_LAS __attribute__((address_space(3)))
typedef unsigned short bf16_t;
constexpr int BM = 256, BK = 64, HALF = 128, HTB = HALF * BK * 2, STAGE_BYTES = 8 * HTB, NXCD = 8, WGM = 8;
DI int lds_byte(int r, int c) { const int st = (r >> 4) * 2 + (c >> 5), rr = r & 15, cc = c & 31, ob = rr * 64 + cc * 2; return st * 1024 + (ob ^ (((ob >> 9) & 1) << 5)); }
DI void stage_rc(int b, int& R, int& C) { const int st = b / 1024, sb = b % 1024, swz = sb ^ (((sb >> 9) & 1) << 5); R = (st >> 1) * 16 + swz / 64; C = (st & 1) * 32 + (swz % 64) / 2; }
DI int perm32(int rho) { const int n = rho >> 4, i = rho & 15; return 8 * (i >> 2) + 4 * n + (i & 3); }
struct Unit { int pm, pn; };
struct Gemm { const bf16_t* A; const bf16_t* Bt; int M, N, K; };
struct StaticOrder {
  int nM, nN, nwg, G, c;
  DI void init(int M, int N, int G_, int c_) { nM = M / BM; nN = N / BM; nwg = nM * nN; G = G_; c = c_; }
  DI bool next(int i, Unit& u) const {
    const long L = (long)i * G + c; if (L >= nwg) return false;
    int wgid = (int)L; { const int q = nwg / NXCD, r = nwg % NXCD, xcd = wgid % NXCD, off = wgid / NXCD; wgid = (xcd < r ? xcd * (q + 1) : r * (q + 1) + (xcd - r) * q) + off; }
    const int nig = WGM * nN, gid = wgid / nig, fm = gid * WGM, gsz = (nM - fm) < WGM ? (nM - fm) : WGM;
    u.pm = fm + ((wgid % nig) % gsz); u.pn = (wgid % nig) / gsz; return true;
  }
};
template <class Epi>
DI void gemm_phase(PG8_LAS unsigned char* lds, const Gemm g, const StaticOrder& S, const Epi& E) {
  const int tid = otid(), wid = __builtin_amdgcn_readfirstlane(tid >> 6), lane = tid & 63, wr = wid >> 2, wc = wid & 3, fr = lane & 15, fq = lane >> 4;
  const int K = g.K, nt = K / BK;
  unsigned voffA[2], voffB[2];
#pragma unroll
  for (int i = 0; i < 2; ++i) { int R, C; stage_rc(tid * 16 + i * 8192, R, C); const int Rb = E.perm ? ((R & ~31) + perm32(R & 31)) : R;
    voffA[i] = (unsigned)(R * K + C) * 2u; voffB[i] = (unsigned)(Rb * K + C) * 2u; }
  const size_t kstep = (size_t)(BK * 2);
  const size_t hstep = (size_t)HALF * K * 2;
  const size_t tstep = 2 * hstep;
  const unsigned ldsw = (unsigned)wid * 1024u;
  const int aoff = lds_byte(wr * 64 + fr, fq * 8), boff = lds_byte(wc * 32 + fr, fq * 8);
#define PG8_SA(b, h) (((b) * 2 + (h)) * HTB)
#define PG8_SB(b, h) ((4 + (b) * 2 + (h)) * HTB)
#define PG8_STAGE(bufoff, gbase, voff) do { _Pragma("unroll") for (int _i = 0; _i < 2; ++_i) \
    __builtin_amdgcn_global_load_lds((const unsigned*)((const char*)(gbase) + (voff)[_i]), (PG8_LAS unsigned*)(lds + (bufoff) + ldsw + _i * 8192), 16, 0, 0); } while (0)
#define PG8_LDA(dst, b, h) do { _Pragma("unroll") for (int m = 0; m < 4; ++m) _Pragma("unroll") for (int k = 0; k < 2; ++k) dst[m][k] = *(const PG8_LAS bf16x8*)(lds + PG8_SA(b, h) + aoff + m * 2048 + k * 1024); } while (0)
#define PG8_LDB(dst, b, h) do { _Pragma("unroll") for (int n = 0; n < 2; ++n) _Pragma("unroll") for (int k = 0; k < 2; ++k) dst[n][k] = *(const PG8_LAS bf16x8*)(lds + PG8_SB(b, h) + boff + n * 2048 + k * 1024); } while (0)
#define PG8_MMA(ai, bj, At, Bt) do { __builtin_amdgcn_s_setprio(1); _Pragma("unroll") for (int m = 0; m < 4; ++m) _Pragma("unroll") for (int n = 0; n < 2; ++n) _Pragma("unroll") for (int k = 0; k < 2; ++k) \
    acc[ai][bj][m][n] = __builtin_amdgcn_mfma_f32_16x16x32_bf16(Bt[n][k], At[m][k], acc[ai][bj][m][n], 0, 0, 0); __builtin_amdgcn_s_setprio(0); } while (0)
#define PG8_WAIT_V(n) asm volatile("s_waitcnt vmcnt(" #n ")" ::: "memory")
#define PG8_WAIT_L(n) asm volatile("s_waitcnt lgkmcnt(" #n ")" ::: "memory")
#define PG8_BAR __builtin_amdgcn_s_barrier()
#define PG8_SCHED __builtin_amdgcn_sched_barrier(0)
  Unit cur, nxt; int ui = 0;
  if (!S.next(0, cur)) return;
  if (E.ssq_in) {
    PG8_LAS float* rtab = (PG8_LAS float*)(lds + 131072);
    Unit uu;
    for (int q = 0; q < 8 && S.next(q, uu); ++q)
      if (tid < 256) rtab[q * 256 + tid] = rsqrtf(E.ssq_in[(E.kind == 4 ? uu.pn : uu.pm) * 256 + tid] * (1.f / 1024.f) + EPS);
    __syncthreads();
  }
  f32x4 acc[2][2][4][2];
#pragma unroll
  for (int a = 0; a < 2; ++a)
#pragma unroll
    for (int b = 0; b < 2; ++b)
#pragma unroll
      for (int m = 0; m < 4; ++m)
#pragma unroll
        for (int n = 0; n < 2; ++n) acc[a][b][m][n] = (f32x4){0.f, 0.f, 0.f, 0.f};
  bf16x8 At[4][2], B0[2][2], B1[2][2];
  const char* cA = (const char*)g.A + (size_t)cur.pm * tstep; const char* cB = (const char*)g.Bt + (size_t)cur.pn * tstep;
  PG8_STAGE(PG8_SB(0, 0), cB, voffB); PG8_STAGE(PG8_SA(0, 0), cA, voffA); PG8_STAGE(PG8_SB(0, 1), cB + hstep, voffB); PG8_STAGE(PG8_SA(0, 1), cA + hstep, voffA);
  if (wr == 1) PG8_BAR;
  PG8_WAIT_V(4); PG8_BAR;
  PG8_STAGE(PG8_SB(1, 0), cB + kstep, voffB); PG8_STAGE(PG8_SA(1, 0), cA + kstep, voffA); PG8_STAGE(PG8_SB(1, 1), cB + hstep + kstep, voffB);
  PG8_WAIT_V(6); PG8_BAR;
  for (;;) {
    const bool has_next = S.next(ui + 1, nxt);
    const char* nA = has_next ? (const char*)g.A + (size_t)nxt.pm * tstep : cA; const char* nB = has_next ? (const char*)g.Bt + (size_t)nxt.pn * tstep : cB;
    for (int t = 0; t < nt; t += 2) {
      const bool last = (t == nt - 2);
      const char* a1 = cA + (size_t)(t + 1) * kstep;
      const char* a2 = last ? nA : cA + (size_t)(t + 2) * kstep; const char* b2 = last ? nB : cB + (size_t)(t + 2) * kstep;
      const char* a3 = a2 + kstep; const char* b3 = b2 + kstep;
      PG8_LDB(B0, 0, 0); PG8_SCHED; PG8_LDA(At, 0, 0); PG8_STAGE(PG8_SA(1, 1), a1 + hstep, voffA);
      PG8_WAIT_L(8); PG8_BAR; PG8_WAIT_L(0); PG8_MMA(0, 0, At, B0); PG8_BAR; PG8_SCHED;
      PG8_LDB(B1, 0, 1); PG8_STAGE(PG8_SB(0, 0), b2, voffB);
      PG8_BAR; PG8_WAIT_L(0); PG8_MMA(0, 1, At, B1); PG8_BAR;
      PG8_LDA(At, 0, 1); PG8_STAGE(PG8_SA(0, 0), a2, voffA);
      PG8_BAR; PG8_WAIT_L(0); PG8_MMA(1, 0, At, B0); PG8_BAR; PG8_SCHED;
      PG8_STAGE(PG8_SB(0, 1), b2 + hstep, voffB);
      PG8_WAIT_V(6); PG8_BAR; PG8_MMA(1, 1, At, B1); PG8_BAR;
      PG8_LDB(B0, 1, 0); PG8_SCHED; PG8_LDA(At, 1, 0); PG8_STAGE(PG8_SA(0, 1), a2 + hstep, voffA);
      PG8_WAIT_L(8); PG8_BAR; PG8_WAIT_L(0); PG8_MMA(0, 0, At, B0); PG8_BAR; PG8_SCHED;
      PG8_LDB(B1, 1, 1); PG8_STAGE(PG8_SB(1, 0), b3, voffB);
      PG8_BAR; PG8_WAIT_L(0); PG8_MMA(0, 1, At, B1); PG8_BAR;
      PG8_LDA(At, 1, 1); PG8_STAGE(PG8_SA(1, 0), a3, voffA);
      PG8_BAR; PG8_WAIT_L(0); PG8_MMA(1, 0, At, B0); PG8_BAR; PG8_SCHED;
      PG8_STAGE(PG8_SB(1, 1), b3 + hstep, voffB);
      PG8_WAIT_V(6); PG8_BAR; PG8_MMA(1, 1, At, B1); PG8_BAR;
    }
    E(acc, cur, wr, wc, fr, fq, (const PG8_LAS float*)(lds + 131072) + ui * 256);
    if (!has_next) break;
#pragma unroll
    for (int a = 0; a < 2; ++a)
#pragma unroll
      for (int b = 0; b < 2; ++b)
#pragma unroll
        for (int m = 0; m < 4; ++m)
#pragma unroll
          for (int n = 0; n < 2; ++n) acc[a][b][m][n] = (f32x4){0.f, 0.f, 0.f, 0.f};
    cur = nxt; cA = nA; cB = nB; ++ui;
  }
  PG8_WAIT_V(0);
  if (wr == 0) PG8_BAR;
  PG8_BAR;
#undef PG8_SA
#undef PG8_SB
#undef PG8_STAGE
#undef PG8_LDA
#undef PG8_LDB
#undef PG8_MMA
#undef PG8_WAIT_V
#undef PG8_WAIT_L
#undef PG8_BAR
#undef PG8_SCHED
}
}

typedef f32x4 AccT[2][2][4][2];
DI uint4 pack8(f32x4 a, f32x4 b) { return make_uint4(pack2(a[0], a[1]), pack2(a[2], a[3]), pack2(b[0], b[1]), pack2(b[2], b[3])); }

struct EpiRes {
  static constexpr bool PERM = false;
  const float* res_f32; u16* xb; float* out_f32; float* ssq_out;
  DI void operator()(const AccT& acc, const pg8::Unit& u, int wr, int wc, int fr, int fq, const PG8_LAS float* rtab) const {
    const int row0 = u.pm * 256 + wr * 64 + fr, col0 = u.pn * 256 + wc * 32 + 4 * fq;
#pragma unroll
    for (int ai = 0; ai < 2; ++ai)
#pragma unroll
      for (int m = 0; m < 4; ++m) {
        const size_t r = row0 + ai * 128 + m * 16;
        float part = 0.f;
#pragma unroll
        for (int bj = 0; bj < 2; ++bj)
#pragma unroll
          for (int n = 0; n < 2; ++n) {
            const int c = col0 + bj * 128 + n * 16;
            float4 r4;
            if (res_f32) r4 = *(const float4*)(res_f32 + r * 1024 + c);
            else { uint2 rr = *(const uint2*)(xb + r * 1024 + c); r4 = make_float4(bflo(rr.x), bfhi(rr.x), bflo(rr.y), bfhi(rr.y)); }
            f32x4 a = acc[ai][bj][m][n];
            float4 v = make_float4(r4.x + a[0], r4.y + a[1], r4.z + a[2], r4.w + a[3]);
            if (out_f32) *(float4*)(out_f32 + r * 1024 + c) = v;
            else *(uint2*)(xb + r * 1024 + c) = make_uint2(pack2(v.x, v.y), pack2(v.z, v.w));
            part += v.x * v.x + v.y * v.y + v.z * v.z + v.w * v.w;
          }
        if (ssq_out) {
          part = xor16_32_sum(part);
          if (fq == 0) atomicAdd(ssq_out + r, part);
        }
      }
  }
};

struct EpiSwiglu {
  static constexpr bool PERM = true;
  const float* ssq_in; u16* h_out;
  DI void operator()(const AccT& acc, const pg8::Unit& u, int wr, int wc, int fr, int fq, const PG8_LAS float* rtab) const {
    const int row0 = u.pm * 256 + wr * 64 + fr;
#pragma unroll
    for (int ai = 0; ai < 2; ++ai)
#pragma unroll
      for (int m = 0; m < 4; ++m) {
        const size_t r = row0 + ai * 128 + m * 16;
        const float rs = rtab[ai * 128 + wr * 64 + m * 16 + fr];
        f32x4 h0, h1;
#pragma unroll
        for (int e = 0; e < 4; ++e) {
          h0[e] = silu(acc[ai][0][m][0][e] * rs) * (acc[ai][1][m][0][e] * rs);
          h1[e] = silu(acc[ai][0][m][1][e] * rs) * (acc[ai][1][m][1][e] * rs);
        }
        *(uint4*)(h_out + r * 2816 + u.pn * 128 + wc * 32 + 8 * fq) = pack8(h0, h1);
      }
  }
};

template <int L1>
struct EpiQK {
  static constexpr bool PERM = true;
  char* ws; u16* zout; const float* qn; const float* kn; const float* ssq_in;
  DI void operator()(const AccT& acc, const pg8::Unit& u, int wr, int wc, int fr, int fq, const PG8_LAS float* rtab) const {
    const int pn = u.pn;
    const int row0 = u.pm * 256 + wr * 64 + fr;
    const bool headnorm = L1 ? true : (pn < 4);
    const bool is_q = L1 ? (pn < 4) : (pn < 2);
#pragma unroll
    for (int ai = 0; ai < 2; ++ai)
#pragma unroll
      for (int m = 0; m < 4; ++m) {
        const size_t r = row0 + ai * 128 + m * 16;
        const float rs = L1 ? rtab[ai * 128 + wr * 64 + m * 16 + fr] : 1.f;
        f32x4 v[2][2];
#pragma unroll
        for (int bj = 0; bj < 2; ++bj)
#pragma unroll
          for (int n = 0; n < 2; ++n) v[bj][n] = acc[ai][bj][m][n] * rs;
        if (headnorm) {
          float ss = 0.f;
#pragma unroll
          for (int bj = 0; bj < 2; ++bj)
#pragma unroll
            for (int n = 0; n < 2; ++n)
              ss += v[bj][n][0] * v[bj][n][0] + v[bj][n][1] * v[bj][n][1] + v[bj][n][2] * v[bj][n][2] + v[bj][n][3] * v[bj][n][3];
          ss = xor16_32_sum(ss);
          const float hn = rsqrtf(ss * (1.f / 64.f) + EPS) * (is_q ? 0.125f * LOG2E : 1.f);
          const float* gn = is_q ? qn : kn;
#pragma unroll
          for (int bj = 0; bj < 2; ++bj)
#pragma unroll
            for (int n = 0; n < 2; ++n) {
              float4 g4 = *(const float4*)(gn + bj * 32 + 8 * fq + 4 * n);
              v[bj][n][0] *= hn * g4.x; v[bj][n][1] *= hn * g4.y; v[bj][n][2] *= hn * g4.z; v[bj][n][3] *= hn * g4.w;
            }
          u16* dst;
          if (L1) {
            const int s = (int)(r & 2047);
            const float4* rt = (const float4*)(ws + O_ROPE) + (size_t)s * 16;
#pragma unroll
            for (int bj = 0; bj < 2; ++bj)
#pragma unroll
              for (int n = 0; n < 2; ++n) {
                float4 cs = rt[bj * 8 + 2 * fq + n];
                float a0 = v[bj][n][0], a1 = v[bj][n][1], b0 = v[bj][n][2], b1 = v[bj][n][3];
                v[bj][n][0] = a0 * cs.x - a1 * cs.y; v[bj][n][1] = a0 * cs.y + a1 * cs.x;
                v[bj][n][2] = b0 * cs.z - b1 * cs.w; v[bj][n][3] = b0 * cs.w + b1 * cs.z;
              }
            dst = is_q ? (u16*)(ws + O_Q1) + r * 1024 + (pn * 4 + wc) * 64 : (u16*)(ws + O_K1) + r * 256 + wc * 64;
          } else {
            dst = (is_q ? (u16*)(ws + O_Q0) : (u16*)(ws + O_K0)) + r * 512 + ((pn & 1) * 4 + wc) * 64;
          }
#pragma unroll
          for (int bj = 0; bj < 2; ++bj) *(uint4*)(dst + bj * 32 + 8 * fq) = pack8(v[bj][0], v[bj][1]);
        } else if (pn < 8) {
          u16* dst = zout + r * 1024 + (pn - 4) * 256 + wc * 32 + 8 * fq;
#pragma unroll
          for (int bj = 0; bj < 2; ++bj) *(uint4*)(dst + bj * 128) = pack8(v[bj][0], v[bj][1]);
        } else if (pn < 16) {
          u16* dst = (u16*)(ws + O_XBC) + r * 2048 + (pn - 8) * 256 + wc * 32 + 8 * fq;
#pragma unroll
          for (int bj = 0; bj < 2; ++bj) *(uint4*)(dst + bj * 128) = pack8(v[bj][0], v[bj][1]);
        } else if (wc == 0) {
          float* dst = (float*)(ws + O_DTB) + r * 32 + 8 * fq;
          *(float4*)(dst) = make_float4(v[0][0][0], v[0][0][1], v[0][0][2], v[0][0][3]);
          *(float4*)(dst + 4) = make_float4(v[0][1][0], v[0][1][1], v[0][1][2], v[0][1][3]);
        }
      }
  }
};

struct EpiVT {
  static constexpr bool PERM = true;
  const float* ssq_in; u16* vt; int nh;
  DI void operator()(const AccT& acc, const pg8::Unit& u, int wr, int wc, int fr, int fq, const PG8_LAS float* rtab) const {
#pragma unroll
    for (int bj = 0; bj < 2; ++bj) {
      const int tok0 = u.pn * 256 + bj * 128 + wc * 32 + 8 * fq;
      f32x4 r0 = {1.f, 1.f, 1.f, 1.f}, r1 = r0;
      if (ssq_in) {
        const int lo = bj * 128 + wc * 32 + 8 * fq;
        r0 = *(const PG8_LAS f32x4*)(rtab + lo); r1 = *(const PG8_LAS f32x4*)(rtab + lo + 4);
      }
      const int b = tok0 >> 11, s = tok0 & 2047;
#pragma unroll
      for (int ai = 0; ai < 2; ++ai)
#pragma unroll
        for (int m = 0; m < 4; ++m) {
          const int f = u.pm * 256 + ai * 128 + wr * 64 + m * 16 + fr;
          const int hd = f >> 6, d = f & 63;
          u16* dstp = vt + ((size_t)((b * nh + hd) * 64 + d)) * 2048;
          const uint4 pk = pack8(acc[ai][bj][m][0] * r0, acc[ai][bj][m][1] * r1);
          if (nh == 4) {
            const int c = (s >> 3) & 3, pos0 = (s & ~31) + 16 * (c & 1) + 4 * (c >> 1);
            *(uint2*)(dstp + pos0) = make_uint2(pk.x, pk.y);
            *(uint2*)(dstp + pos0 + 8) = make_uint2(pk.z, pk.w);
          } else {
            *(uint4*)(dstp + s) = pk;
          }
        }
    }
  }
};
enum { EK_RES = 0, EK_SWIGLU = 1, EK_QK0 = 2, EK_QK1 = 3, EK_VT = 4 };
struct EpiAny {
  int kind; bool perm;
  char* ws; u16* zout; const float* qn; const float* kn; const float* ssq_in; float* ssq_out; const float* res_in; float* res_out; u16* xb_out; u16* o16; int nh;
  DI void operator()(const AccT& acc, const pg8::Unit& u, int wr, int wc, int fr, int fq, const PG8_LAS float* rtab) const {
    switch (kind) {
      case EK_RES: { EpiRes e{res_in, xb_out, res_out, ssq_out}; e(acc, u, wr, wc, fr, fq, rtab); } break;
      case EK_SWIGLU: { EpiSwiglu e{ssq_in, o16}; e(acc, u, wr, wc, fr, fq, rtab); } break;
      case EK_QK0: { EpiQK<0> e{ws, zout, qn, kn, ssq_in}; e(acc, u, wr, wc, fr, fq, rtab); } break;
      case EK_QK1: { EpiQK<1> e{ws, zout, qn, kn, ssq_in}; e(acc, u, wr, wc, fr, fq, rtab); } break;
      default: { EpiVT e{ssq_in, o16, nh}; e(acc, u, wr, wc, fr, fq, rtab); } break;
    }
  }
};

__device__ void na_tile(const Params& p, int tile) {
  const int tid = vtid(), lane = tid & 63, wave = tid >> 6, l15 = lane & 15, quad = lane >> 4;
  const int h = tile & 7, r = (tile >> 3) & 31, b = tile >> 8;
  const int c0 = min(max(16 * wave - 8, 0), 32);
  const int rs = min(max(r - 4, 0), 24);
  const u16* Q0 = (const u16*)(p.ws + O_Q0);
  const u16* K0 = (const u16*)(p.ws + O_K0) + (size_t)(b * 2048 + rs * 64 + c0 + 8 * (l15 >> 2) + (l15 & 3)) * 512 + h * 64 + 8 * quad;
  const u16* VT = (const u16*)(p.ws + O_VT0) + (size_t)((b * 8 + h) * 64 + l15) * 2048 + rs * 64 + c0 + 8 * quad;
  u16* mix = (u16*)(p.ws + O_MIX);
  const int tq = b * 2048 + r * 64 + 16 * wave + l15;
  bf16x8 qf[2];
#pragma unroll
  for (int ks = 0; ks < 2; ++ks) qf[ks] = as_bf8(*(const uint4*)(Q0 + (size_t)tq * 512 + h * 64 + 32 * ks + 8 * quad));
  const int cq = 16 * wave + l15;
  const int cs = min(max(cq - 8, 0), 48);
  const float* rpb = p.na_rel_bias + h * 465 + (rs - r + 7) * 31;
  const int d0 = c0 + 8 * quad - cq;
  const int w0 = d0 + cq - cs;
  f32x4 s[16];
  uint4 kb[2][4];
#pragma unroll
  for (int q4 = 0; q4 < 4; ++q4) kb[0][q4] = *(const uint4*)(K0 + (size_t)(4 * (q4 >> 1)) * 512 + 32 * (q4 & 1));
#pragma unroll
  for (int jr = 0; jr < 8; ++jr) {
    if (jr + 1 < 8) {
#pragma unroll
      for (int q4 = 0; q4 < 4; ++q4)
        kb[(jr + 1) & 1][q4] = *(const uint4*)(K0 + (size_t)((jr + 1) * 64 + 4 * (q4 >> 1)) * 512 + 32 * (q4 & 1));
    }
    float bias[8];
#pragma unroll
    for (int e = 0; e < 8; ++e) bias[e] = rpb[jr * 31 + min(max(d0 + 4 * (e >> 2) + (e & 3), -15), 15) + 15];
#pragma unroll
    for (int tt = 0; tt < 2; ++tt) {
      f32x4 a = {0.f, 0.f, 0.f, 0.f};
      a = MFMA(as_bf8(kb[jr & 1][2 * tt]), qf[0], a);
      a = MFMA(as_bf8(kb[jr & 1][2 * tt + 1]), qf[1], a);
#pragma unroll
      for (int rr = 0; rr < 4; ++rr) a[rr] = ((unsigned)(w0 + 4 * tt + rr) < 16u) ? (a[rr] + bias[tt * 4 + rr] * LOG2E) : -INFINITY;
      s[jr * 2 + tt] = a;
    }
  }
  float mx = -INFINITY;
#pragma unroll
  for (int u = 0; u < 16; ++u) mx = fmaxf(mx, fmaxf(fmaxf(s[u][0], s[u][1]), fmaxf(s[u][2], s[u][3])));
  mx = xor16_32_max(mx);
  uint4 vbuf[3][4];
#define NA_VLOAD(jr, dst) do { \
    _Pragma("unroll") for (int i2 = 0; i2 < 4; ++i2) dst[i2] = *(const uint4*)(VT + (size_t)(16 * i2) * 2048 + (jr) * 64); } while (0)
  NA_VLOAD(0, vbuf[0]);
  NA_VLOAD(1, vbuf[1]);
  float sum = 0.f;
#pragma unroll
  for (int u = 0; u < 16; ++u)
#pragma unroll
    for (int rr = 0; rr < 4; ++rr) { float pv = ex2(s[u][rr] - mx); s[u][rr] = pv; sum += pv; }
  sum = xor16_32_sum(sum);
  f32x4 o[4];
#pragma unroll
  for (int i2 = 0; i2 < 4; ++i2) o[i2] = (f32x4){0.f, 0.f, 0.f, 0.f};
#pragma unroll
  for (int jr = 0; jr < 8; ++jr) {
    if (jr + 2 < 8) NA_VLOAD(jr + 2, vbuf[(jr + 2) % 3]);
    bf16x8 pf = cat_bf8(pack4(s[2 * jr]), pack4(s[2 * jr + 1]));
#pragma unroll
    for (int i2 = 0; i2 < 4; ++i2) o[i2] = MFMA(as_bf8(vbuf[jr % 3][i2]), pf, o[i2]);
  }
#undef NA_VLOAD
  const float inv = 1.f / sum;
#pragma unroll
  for (int i2 = 0; i2 < 4; ++i2) *(uint2*)(mix + (size_t)tq * 1536 + h * 64 + 16 * i2 + 4 * quad) = pack4(o[i2] * inv);
}

__device__ void conv_tile(const Params& p, int tile) {
  const int tb = tile >> 2, cb = tile & 3;
  const int ch = cb * 512 + 2 * vtid();
  const int b = tb >> 5, s0 = (tb & 31) * 64;
  float w[4][2], bias[2];
#pragma unroll
  for (int k = 0; k < 4; ++k) { const float2 t = *(const float2*)(p.conv_w + k * 2048 + ch); w[k][0] = t.x; w[k][1] = t.y; }
  { const float2 t = *(const float2*)(p.conv_b + ch); bias[0] = t.x; bias[1] = t.y; }
  const u16* src = (const u16*)(p.ws + O_XBC) + (size_t)(b * 2048) * 2048 + ch;
  unsigned um2 = (s0 >= 2) ? *(const unsigned*)(src + (size_t)(s0 - 2) * 2048) : 0u;
  unsigned um1 = (s0 >= 1) ? *(const unsigned*)(src + (size_t)(s0 - 1) * 2048) : 0u;
  unsigned u0 = *(const unsigned*)(src + (size_t)s0 * 2048);
  u16* XT = (u16*)p.out + 16 * MIB;
  for (int sg = 0; sg < 8; ++sg) {
    unsigned nx[8];
#pragma unroll
    for (int e = 0; e < 8; ++e) { const int s = s0 + sg * 8 + e; nx[e] = (s + 1 < 2048) ? *(const unsigned*)(src + (size_t)(s + 1) * 2048) : 0u; }
    float y[2][8];
#pragma unroll
    for (int e = 0; e < 8; ++e) {
      const unsigned up1 = nx[e];
      y[0][e] = silu(w[0][0] * bflo(um2) + w[1][0] * bflo(um1) + w[2][0] * bflo(u0) + w[3][0] * bflo(up1) + bias[0]);
      y[1][e] = silu(w[0][1] * bfhi(um2) + w[1][1] * bfhi(um1) + w[2][1] * bfhi(u0) + w[3][1] * bfhi(up1) + bias[1]);
      um2 = um1; um1 = u0; u0 = up1;
    }
    const int sb = s0 + sg * 8;
    if (cb < 3) {
      u16* dstT = (cb < 2) ? XT + (size_t)(b * 1024 + ch) * 2048 + sb : (u16*)(p.ws + O_BT) + (size_t)(b * 512 + (ch - 1024)) * 2048 + sb;
#pragma unroll
      for (int c2 = 0; c2 < 2; ++c2)
        *(uint4*)(dstT + (size_t)c2 * 2048) = make_uint4(pack2(y[c2][0], y[c2][1]), pack2(y[c2][2], y[c2][3]), pack2(y[c2][4], y[c2][5]), pack2(y[c2][6], y[c2][7]));
    }
    if (cb >= 2) {
      u16* nat = (cb == 2) ? (u16*)(p.ws + O_BN) + (size_t)(b * 2048 + sb) * 512 + (ch - 1024)
                           : (u16*)(p.ws + O_CN) + (size_t)(b * 2048 + sb) * 512 + (ch - 1536);
#pragma unroll
      for (int e = 0; e < 8; ++e) *(unsigned*)(nat + e * 512) = pack2(y[0][e], y[1][e]);
    }
  }
}

__device__ void scan_item8(const Params& p, char* smem, int item) {
  const int tid = otid(), lane = tid & 63, wave = __builtin_amdgcn_readfirstlane(tid >> 6), l15 = lane & 15, quad = lane >> 4;
  const int dir = item & 1, h = (item >> 1) & 15, b = item >> 5, g = h >> 2;
  const float Ah = -__expf(p.A_log[dir * 16 + h]) * LOG2E;
  PG8_LAS float* wall = (PG8_LAS float*)((PG8_LAS unsigned char*)smem + 65536);
  PG8_LAS float* cdall = wall + 2048;
  const float* dtb = (const float*)(p.ws + O_DTB);
#pragma unroll
  for (int cc = 0; cc < 2; ++cc) {
    const int c = 2 * wave + cc;
    const int tokb = b * 2048 + c * 128;
    const float d0 = dtb[(size_t)(tokb + 2 * lane) * 32 + dir * 16 + h];
    const float d1 = dtb[(size_t)(tokb + 2 * lane + 1) * 32 + dir * 16 + h];
    const float a0 = d0 * Ah, a1 = d1 * Ah, ps = a0 + a1;
    float incl = ps;
#pragma unroll
    for (int o = 1; o < 64; o <<= 1) { float tv = __shfl_up(incl, o); if (lane >= o) incl += tv; }
    const float total = __shfl(incl, 63);
    const float excl = incl - ps;
    float w0, w1;
    if (dir == 0) { w0 = ex2(total - (excl + a0)) * d0; w1 = ex2(total - incl) * d1; }
    else { w0 = ex2(excl) * d0; w1 = ex2(excl + a0) * d1; }
    wall[c * 128 + 2 * lane] = w0; wall[c * 128 + 2 * lane + 1] = w1;
    if (lane == 0) cdall[c] = ex2(total);
  }
  __syncthreads();
  const int drow = 8 * wave + (lane >> 4);
  const u16* XTg = (const u16*)p.out + 16 * MIB + (size_t)(b * 1024 + h * 64) * 2048;
  const char* xsrc0 = (const char*)(XTg + (size_t)drow * 2048) + (((lane & 15) ^ (drow & 15)) << 4);
  const char* xsrc1 = (const char*)(XTg + (size_t)(drow + 4) * 2048) + (((lane & 15) ^ ((drow + 4) & 15)) << 4);
  PG8_LAS unsigned char* lds = (PG8_LAS unsigned char*)smem;
  const u16* BT = (const u16*)(p.ws + O_BT) + (size_t)(b * 512 + g * 128 + 16 * wave + l15) * 2048 + 8 * quad;
  u16* HP = (u16*)(p.ws + O_HPREV);
  f32x4 acc[4];
#pragma unroll
  for (int j = 0; j < 4; ++j) acc[j] = (f32x4){0.f, 0.f, 0.f, 0.f};
  u32x4v bA[4], bB[4], bC[4], bD[4];
#define SC_ISSUE(Bf, st, c) do { \
    __builtin_amdgcn_global_load_lds((const unsigned*)(xsrc0 + (c) * 256), (PG8_LAS unsigned*)(lds + (st) * 16384 + wave * 2048), 16, 0, 0); \
    __builtin_amdgcn_global_load_lds((const unsigned*)(xsrc1 + (c) * 256), (PG8_LAS unsigned*)(lds + (st) * 16384 + wave * 2048 + 1024), 16, 0, 0); \
    { const u16* _bp = BT + (c) * 128; \
      asm volatile("global_load_dwordx4 %0, %4, off\n\tglobal_load_dwordx4 %1, %4, off offset:64\n\tglobal_load_dwordx4 %2, %4, off offset:128\n\tglobal_load_dwordx4 %3, %4, off offset:192" \
                   : "=&v"(Bf[0]), "=&v"(Bf[1]), "=&v"(Bf[2]), "=&v"(Bf[3]) : "v"(_bp) : "memory"); } } while (0)
#define SC_STEP(Bf, st, c) do { \
    u16* hp = HP + ((size_t)(((b * 16 + (c)) * 16 + h) * 2 + dir) << 13); \
    _Pragma("unroll") for (int j = 0; j < 4; ++j) *(uint2*)(hp + (16 * j + l15) * 128 + 16 * wave + 4 * quad) = pack4(acc[j]); \
    const float cd = cdall[(c)]; \
    _Pragma("unroll") for (int j = 0; j < 4; ++j) acc[j] *= cd; \
    _Pragma("unroll") for (int ks = 0; ks < 4; ++ks) { \
      const f32x4 wav = *(const PG8_LAS f32x4*)(wall + (c) * 128 + 32 * ks + 8 * quad); \
      const f32x4 wbv = *(const PG8_LAS f32x4*)(wall + (c) * 128 + 32 * ks + 8 * quad + 4); \
      const float4 wa = make_float4(wav[0], wav[1], wav[2], wav[3]), wb = make_float4(wbv[0], wbv[1], wbv[2], wbv[3]); \
      _Pragma("unroll") for (int j = 0; j < 4; ++j) { \
        const u32x4v rawv = *(const PG8_LAS u32x4v*)(lds + (st) * 16384 + (16 * j + l15) * 256 + (((4 * ks + quad) ^ l15) << 4)); \
        const uint4 raw = make_uint4(rawv[0], rawv[1], rawv[2], rawv[3]); uint4 sc; \
        sc.x = pack2(bflo(raw.x) * wa.x, bfhi(raw.x) * wa.y); sc.y = pack2(bflo(raw.y) * wa.z, bfhi(raw.y) * wa.w); \
        sc.z = pack2(bflo(raw.z) * wb.x, bfhi(raw.z) * wb.y); sc.w = pack2(bflo(raw.w) * wb.z, bfhi(raw.w) * wb.w); \
        acc[j] = MFMA(__builtin_bit_cast(bf16x8, Bf[ks]), as_bf8(sc), acc[j]); } } } while (0)
#define SC_CH(s) (dir ? 15 - (s) : (s))
  SC_ISSUE(bA, 0, SC_CH(0)); SC_ISSUE(bB, 1, SC_CH(1)); SC_ISSUE(bC, 2, SC_CH(2));
#define SC_BAR() do { asm volatile("" ::: "memory"); __builtin_amdgcn_s_barrier(); asm volatile("" ::: "memory"); } while (0)
#define SC_WAIT(nlast, Bf) do { if (s4 == 12) asm volatile("s_waitcnt vmcnt(" #nlast ")" : "+v"(Bf[0]), "+v"(Bf[1]), "+v"(Bf[2]), "+v"(Bf[3]) :: "memory"); \
    else asm volatile("s_waitcnt vmcnt(18)" : "+v"(Bf[0]), "+v"(Bf[1]), "+v"(Bf[2]), "+v"(Bf[3]) :: "memory"); } while (0)
  for (int s4 = 0; s4 < 16; s4 += 4) {
    SC_ISSUE(bD, 3, SC_CH(s4 + 3));
    SC_WAIT(18, bA); SC_BAR();
    SC_STEP(bA, 0, SC_CH(s4));
    SC_BAR();
    if (s4 + 4 < 16) SC_ISSUE(bA, 0, SC_CH(s4 + 4));
    SC_WAIT(12, bB); SC_BAR();
    SC_STEP(bB, 1, SC_CH(s4 + 1));
    SC_BAR();
    if (s4 + 5 < 16) SC_ISSUE(bB, 1, SC_CH(s4 + 5));
    SC_WAIT(6, bC); SC_BAR();
    SC_STEP(bC, 2, SC_CH(s4 + 2));
    SC_BAR();
    if (s4 + 6 < 16) SC_ISSUE(bC, 2, SC_CH(s4 + 6));
    SC_WAIT(0, bD); SC_BAR();
    SC_STEP(bD, 3, SC_CH(s4 + 3));
    SC_BAR();
  }
#undef SC_BAR
#undef SC_WAIT
#undef SC_ISSUE
#undef SC_STEP
#undef SC_CH
  asm volatile("s_waitcnt vmcnt(0)" ::: "memory");
  __syncthreads();
}

__device__ void ssd_out_tile(const Params& p, char* smem, int tile) {
  const int tid = vtid(), lane = tid & 63, wave = tid >> 6, l15 = lane & 15, quad = lane >> 4;
  const int g = tile & 3, c = (tile >> 2) & 15, b = tile >> 6;
  const int hh = g * 4 + wave;
  u16* Gs = (u16*)smem;
  float* wv = (float*)(smem + 34816) + wave * 512;
  float* red = (float*)(smem + 34816 + 8192);
  const int tok0 = b * 2048 + c * 128;
  const u16* Cn = (const u16*)(p.ws + O_CN) + (size_t)tok0 * 512 + g * 128;
  const u16* Bn = (const u16*)(p.ws + O_BN) + (size_t)tok0 * 512 + g * 128;
  const float* dtb = (const float*)(p.ws + O_DTB);
  {
    f32x4 ga[8][2];
#pragma unroll
    for (int i = 0; i < 8; ++i) { ga[i][0] = (f32x4){0.f, 0.f, 0.f, 0.f}; ga[i][1] = ga[i][0]; }
#pragma unroll 2
    for (int ks = 0; ks < 4; ++ks) {
      bf16x8 cf[2];
#pragma unroll
      for (int jj = 0; jj < 2; ++jj)
        cf[jj] = as_bf8(*(const uint4*)(Cn + (size_t)(16 * (2 * wave + jj) + l15) * 512 + 32 * ks + 8 * quad));
#pragma unroll
      for (int i = 0; i < 8; ++i) {
        bf16x8 bf = as_bf8(*(const uint4*)(Bn + (size_t)(16 * i + l15) * 512 + 32 * ks + 8 * quad));
        ga[i][0] = MFMA(bf, cf[0], ga[i][0]);
        ga[i][1] = MFMA(bf, cf[1], ga[i][1]);
      }
    }
#pragma unroll
    for (int i = 0; i < 8; ++i)
#pragma unroll
      for (int jj = 0; jj < 2; ++jj)
        *(uint2*)(Gs + (16 * (2 * wave + jj) + l15) * 136 + 16 * i + 4 * quad) = pack4(ga[i][jj]);
  }
  {
    const float Af = -__expf(p.A_log[hh]) * LOG2E, Ab = -__expf(p.A_log[16 + hh]) * LOG2E;
    const float d0f = dtb[(size_t)(tok0 + 2 * lane) * 32 + hh], d1f = dtb[(size_t)(tok0 + 2 * lane + 1) * 32 + hh];
    const float d0b = dtb[(size_t)(tok0 + 2 * lane) * 32 + 16 + hh], d1b = dtb[(size_t)(tok0 + 2 * lane + 1) * 32 + 16 + hh];
    const float a0 = d0f * Af, a1 = d1f * Af, c0 = d0b * Ab, c1 = d1b * Ab;
    float inf_ = a0 + a1, inb = c0 + c1;
#pragma unroll
    for (int o = 1; o < 64; o <<= 1) {
      float t1 = __shfl_up(inf_, o), t2 = __shfl_up(inb, o);
      if (lane >= o) { inf_ += t1; inb += t2; }
    }
    const float totb = __shfl(inb, 63);
    const float exf = inf_ - (a0 + a1), exb = inb - (c0 + c1);
    *(float2*)(wv + 2 * lane) = make_float2(exf + a0, inf_);
    *(float2*)(wv + 128 + 2 * lane) = make_float2(totb - exb, totb - (exb + c0));
    *(float2*)(wv + 256 + 2 * lane) = make_float2(d0f, d1f);
    *(float2*)(wv + 384 + 2 * lane) = make_float2(d0b, d1b);
  }
  __syncthreads();
  const float Dh = p.Dskip[hh];
  const u16* XT = (const u16*)p.out + 16 * MIB + (size_t)(b * 1024 + hh * 64) * 2048 + c * 128;
  const u16* hf = (const u16*)(p.ws + O_HPREV) + ((size_t)(((b * 16 + c) * 16 + hh) * 2) << 13);
  const u16* hb = hf + 8192;
  const u16* Z = (const u16*)p.out;
  u16* mix = (u16*)(p.ws + O_MIX);
  #pragma unroll 1
  for (int jh = 0; jh < 2; ++jh) {
    f32x4 y[4][4];
    {
      float efv[4], ebv[4];
#pragma unroll
      for (int j = 0; j < 4; ++j) {
        const int l = 64 * jh + 16 * j + l15;
        efv[j] = ex2(wv[l]); ebv[j] = ex2(wv[128 + l]);
      }
#pragma unroll
      for (int i = 0; i < 4; ++i)
#pragma unroll
        for (int j = 0; j < 4; ++j) y[i][j] = (f32x4){0.f, 0.f, 0.f, 0.f};
#pragma unroll 2
      for (int ks = 0; ks < 4; ++ks) {
        bf16x8 cF[4], cB[4];
#pragma unroll
        for (int j = 0; j < 4; ++j) {
          const uint4 raw = *(const uint4*)(Cn + (size_t)(64 * jh + 16 * j + l15) * 512 + 32 * ks + 8 * quad);
          float f[8];
          unpack8(raw, f);
          cF[j] = as_bf8(make_uint4(pack2(f[0] * efv[j], f[1] * efv[j]), pack2(f[2] * efv[j], f[3] * efv[j]), pack2(f[4] * efv[j], f[5] * efv[j]), pack2(f[6] * efv[j], f[7] * efv[j])));
          cB[j] = as_bf8(make_uint4(pack2(f[0] * ebv[j], f[1] * ebv[j]), pack2(f[2] * ebv[j], f[3] * ebv[j]), pack2(f[4] * ebv[j], f[5] * ebv[j]), pack2(f[6] * ebv[j], f[7] * ebv[j])));
        }
#pragma unroll
        for (int i = 0; i < 4; ++i) {
          bf16x8 f1 = as_bf8(*(const uint4*)(hf + (16 * i + l15) * 128 + 32 * ks + 8 * quad));
          bf16x8 f2 = as_bf8(*(const uint4*)(hb + (16 * i + l15) * 128 + 32 * ks + 8 * quad));
#pragma unroll
          for (int j = 0; j < 4; ++j) { y[i][j] = MFMA(f1, cF[j], y[i][j]); y[i][j] = MFMA(f2, cB[j], y[i][j]); }
        }
      }
    }
#pragma unroll 2
    for (int ks = 0; ks < 4; ++ks) {
      const int sb = 32 * ks + 8 * quad;
      float afs[8], rbs[8], d0s[8], d1s[8];
      *(float4*)(afs) = *(const float4*)(wv + sb); *(float4*)(afs + 4) = *(const float4*)(wv + sb + 4);
      *(float4*)(rbs) = *(const float4*)(wv + 128 + sb); *(float4*)(rbs + 4) = *(const float4*)(wv + 128 + sb + 4);
      *(float4*)(d0s) = *(const float4*)(wv + 256 + sb); *(float4*)(d0s + 4) = *(const float4*)(wv + 256 + sb + 4);
      *(float4*)(d1s) = *(const float4*)(wv + 384 + sb); *(float4*)(d1s + 4) = *(const float4*)(wv + 384 + sb + 4);
      bf16x8 xf[4];
#pragma unroll
      for (int i = 0; i < 4; ++i) xf[i] = as_bf8(*(const uint4*)(XT + (size_t)(16 * i + l15) * 2048 + sb));
#pragma unroll
      for (int j = 0; j < 4; ++j) {
        const int l = 64 * jh + 16 * j + l15;
        const float afl = wv[l], rbl = wv[128 + l];
        float gv[8], m[8];
        unpack8(*(const uint4*)(Gs + l * 136 + sb), gv);
#pragma unroll
        for (int e = 0; e < 8; ++e) {
          const int s = sb + e;
          float ff = (s <= l) ? ex2(afl - afs[e]) * d0s[e] : 0.f;
          float fb = (s >= l) ? ex2(rbl - rbs[e]) * d1s[e] : 0.f;
          m[e] = gv[e] * (ff + fb) + ((s == l) ? Dh : 0.f);
        }
        bf16x8 mf = as_bf8(make_uint4(pack2(m[0], m[1]), pack2(m[2], m[3]), pack2(m[4], m[5]), pack2(m[6], m[7])));
#pragma unroll
        for (int i = 0; i < 4; ++i) y[i][j] = MFMA(xf[i], mf, y[i][j]);
      }
    }
#pragma unroll
    for (int j = 0; j < 4; ++j) {
      const int tok = tok0 + 64 * jh + 16 * j + l15;
      float part = 0.f;
#pragma unroll
      for (int i = 0; i < 4; ++i) {
        uint2 zr = *(const uint2*)(Z + (size_t)tok * 1024 + hh * 64 + 16 * i + 4 * quad);
        float z0 = bflo(zr.x), z1 = bfhi(zr.x), z2 = bflo(zr.y), z3 = bfhi(zr.y);
        y[i][j][0] *= silu(z0); y[i][j][1] *= silu(z1); y[i][j][2] *= silu(z2); y[i][j][3] *= silu(z3);
        part += y[i][j][0] * y[i][j][0] + y[i][j][1] * y[i][j][1] + y[i][j][2] * y[i][j][2] + y[i][j][3] * y[i][j][3];
      }
      part = xor16_32_sum(part);
      if (quad == 0) red[wave * 64 + 16 * j + l15] = part;
    }
    __syncthreads();
#pragma unroll
    for (int j = 0; j < 4; ++j) {
      const int tok = tok0 + 64 * jh + 16 * j + l15;
      const int q = 16 * j + l15;
      const float tot = red[q] + red[64 + q] + red[128 + q] + red[192 + q];
      const float rs = rsqrtf(tot * (1.f / 256.f) + EPS);
#pragma unroll
      for (int i = 0; i < 4; ++i) {
        float4 g4 = *(const float4*)(p.out_norm + hh * 64 + 16 * i + 4 * quad);
        f32x4 o;
        o[0] = y[i][j][0] * rs * g4.x; o[1] = y[i][j][1] * rs * g4.y; o[2] = y[i][j][2] * rs * g4.z; o[3] = y[i][j][3] * rs * g4.w;
        *(uint2*)(mix + (size_t)tok * 1536 + 512 + hh * 64 + 16 * i + 4 * quad) = pack4(o);
      }
    }
    __syncthreads();
  }
}

__device__ void gqa_tile8(const Params& p, char* smem, int tile) {
  const int tid = otid(), lane = tid & 63, wave = __builtin_amdgcn_readfirstlane(tid >> 6), l15 = lane & 15, quad = lane >> 4;
  const int rep = tile & 3, qb = (tile >> 2) & 3, kvh = (tile >> 4) & 3, b = tile >> 6;
  const int h = kvh * 4 + rep;
  const u16* Q1 = (const u16*)(p.ws + O_Q1);
  const u16* K1 = (const u16*)(p.ws + O_K1) + (size_t)(b * 2048) * 256 + kvh * 64;
  const u16* VT = (const u16*)(p.ws + O_VT1) + (size_t)((b * 4 + kvh) * 64) * 2048;
  u16* AO = (u16*)(p.ws + O_AO);
  const int tq0 = b * 2048 + qb * 512 + 64 * wave;
  bf16x8 qf[4][2];
#pragma unroll
  for (int j = 0; j < 4; ++j)
#pragma unroll
    for (int ks = 0; ks < 2; ++ks)
      qf[j][ks] = as_bf8(*(const uint4*)(Q1 + (size_t)(tq0 + 16 * j + l15) * 1024 + h * 64 + 32 * ks + 8 * quad));
  PG8_LAS unsigned char* lds = (PG8_LAS unsigned char*)smem;
  const int kr0 = 16 * wave + (lane >> 3), kr1 = kr0 + 8;
  const char* ksrc0 = (const char*)(K1 + (size_t)kr0 * 256) + ((((lane & 7) ^ ((kr0 >> 1) & 7))) << 4);
  const char* ksrc1 = (const char*)(K1 + (size_t)kr1 * 256) + ((((lane & 7) ^ ((kr1 >> 1) & 7))) << 4);
  const int vr0 = 8 * wave + (lane >> 4), vr1 = vr0 + 4;
  const char* vsrc0 = (const char*)(VT + (size_t)vr0 * 2048) + ((((lane & 15) ^ (vr0 & 15))) << 4);
  const char* vsrc1 = (const char*)(VT + (size_t)vr1 * 2048) + ((((lane & 15) ^ (vr1 & 15))) << 4);
  float shift;
  {
    float gq = fabsf(p.gqa_q_norm[lane]), gk = fabsf(p.gqa_k_norm[lane]);
#pragma unroll
    for (int o_ = 32; o_ >= 1; o_ >>= 1) { gq = fmaxf(gq, __shfl_xor(gq, o_)); gk = fmaxf(gk, __shfl_xor(gk, o_)); }
    shift = 8.f * gq * gk * LOG2E;
  }
  f32x4 o[4][4];
#pragma unroll
  for (int i = 0; i < 4; ++i)
#pragma unroll
    for (int j = 0; j < 4; ++j) o[i][j] = (f32x4){0.f, 0.f, 0.f, 0.f};
  float lsum[4] = {0.f, 0.f, 0.f, 0.f};
  const f32x4 sinit = {-shift, -shift, -shift, -shift};
#define GQ_ISSUE(t) do { const int _st = (t) & 3; \
    __builtin_amdgcn_global_load_lds((const unsigned*)(ksrc0 + (size_t)(t) * (128 * 512)), (PG8_LAS unsigned*)(lds + _st * 32768 + wave * 2048), 16, 0, 0); \
    __builtin_amdgcn_global_load_lds((const unsigned*)(ksrc1 + (size_t)(t) * (128 * 512)), (PG8_LAS unsigned*)(lds + _st * 32768 + wave * 2048 + 1024), 16, 0, 0); \
    __builtin_amdgcn_global_load_lds((const unsigned*)(vsrc0 + (t) * 256), (PG8_LAS unsigned*)(lds + _st * 32768 + 16384 + wave * 2048), 16, 0, 0); \
    __builtin_amdgcn_global_load_lds((const unsigned*)(vsrc1 + (t) * 256), (PG8_LAS unsigned*)(lds + _st * 32768 + 16384 + wave * 2048 + 1024), 16, 0, 0); } while (0)
#define GQ_BODY(st, hk, jb) do { \
    PG8_LAS const unsigned char* sK = lds + (st) * 32768; PG8_LAS const unsigned char* sV = sK + 16384; \
    f32x4 s[4][2]; \
    _Pragma("unroll") for (int i = 0; i < 4; ++i) { s[i][0] = sinit; s[i][1] = sinit; } \
    _Pragma("unroll") for (int ks = 0; ks < 2; ++ks) \
      _Pragma("unroll") for (int i = 0; i < 4; ++i) { \
        const int kr = 64 * (hk) + 16 * i + l15; \
        bf16x8 kf = *(PG8_LAS const bf16x8*)(sK + kr * 128 + (((4 * ks + quad) ^ ((kr >> 1) & 7)) << 4)); \
        s[i][0] = MFMA(kf, qf[(jb)][ks], s[i][0]); s[i][1] = MFMA(kf, qf[(jb) + 1][ks], s[i][1]); } \
    bf16x8 pf[2][2]; \
    _Pragma("unroll") for (int j = 0; j < 2; ++j) { \
      float ps = 0.f; \
      _Pragma("unroll") for (int i = 0; i < 4; ++i) \
        _Pragma("unroll") for (int r = 0; r < 4; ++r) { float pv = ex2(s[i][j][r]); s[i][j][r] = pv; ps += pv; } \
      lsum[(jb) + j] += ps; \
      pf[j][0] = cat_bf8(pack4(s[0][j]), pack4(s[1][j])); pf[j][1] = cat_bf8(pack4(s[2][j]), pack4(s[3][j])); } \
    _Pragma("unroll") for (int ks2 = 0; ks2 < 2; ++ks2) \
      _Pragma("unroll") for (int i2 = 0; i2 < 4; ++i2) { \
        const int vd = 16 * i2 + l15; \
        bf16x8 vf = *(PG8_LAS const bf16x8*)(sV + vd * 256 + (((8 * (hk) + 4 * ks2 + quad) ^ (vd & 15)) << 4)); \
        o[i2][(jb)] = MFMA(vf, pf[0][ks2], o[i2][(jb)]); o[i2][(jb) + 1] = MFMA(vf, pf[1][ks2], o[i2][(jb) + 1]); } \
    __builtin_amdgcn_sched_barrier(0); \
  } while (0)
  __syncthreads();
  GQ_ISSUE(0); GQ_ISSUE(1);
  for (int kt = 0; kt < 16; ++kt) {
    if (kt + 2 < 16) GQ_ISSUE(kt + 2);
    if (kt < 14) asm volatile("s_waitcnt vmcnt(8)" ::: "memory");
    else if (kt == 14) asm volatile("s_waitcnt vmcnt(4)" ::: "memory");
    else asm volatile("s_waitcnt vmcnt(0)" ::: "memory");
    asm volatile("" ::: "memory"); __builtin_amdgcn_s_barrier(); asm volatile("" ::: "memory");
    const int st = kt & 3;
    GQ_BODY(st, 0, 0); GQ_BODY(st, 0, 2); GQ_BODY(st, 1, 0); GQ_BODY(st, 1, 2);
  }
#undef GQ_ISSUE
#undef GQ_BODY
#pragma unroll
  for (int j = 0; j < 4; ++j) {
    const float inv = 1.f / xor16_32_sum(lsum[j]);
    const int tq = tq0 + 16 * j + l15;
#pragma unroll
    for (int i2 = 0; i2 < 4; ++i2) *(uint2*)(AO + (size_t)tq * 1024 + h * 64 + 16 * i2 + 4 * quad) = pack4(o[i2][j] * inv);
  }
}

#ifndef ONLY_PHASE
#define ONLY_PHASE -1
#endif
__device__ void run_phase(const Params& p, char* smem, int ph) {
  if (ONLY_PHASE >= 0 && ph != ONLY_PHASE) return;
  char* ws = p.ws;
  asm volatile("" : "+s"(ws));
  float* ssq = (float*)(ws + O_SSQ);
  u16* xb = (u16*)(ws + O_XB);
  const int half = __builtin_amdgcn_readfirstlane(threadIdx_x_raw() >> 8);
  char* sh = smem + half * 65536;
  const int G = gridDim.x, bid = blockIdx.x;
  const int vb = bid * 2 + half, nvb = G * 2;
  const bool is_gemm = (ph == 1) || (ph >= 5 && ph != 9);
  if (is_gemm) {
    const int nsub = (ph == 1 || ph == 8) ? 2 : 1;
    for (int sub = 0; sub < nsub; ++sub) {
      pg8::Gemm g{}; EpiAny E{}; E.ws = ws; E.zout = (u16*)p.out; E.perm = true; int c = bid;
      E.qn = (ph >= 8) ? p.gqa_q_norm : p.na_q_norm; E.kn = (ph >= 8) ? p.gqa_k_norm : p.na_k_norm;
      const bool l1 = ph >= 8;
      const u16* W13 = (const u16*)(ws + (l1 ? O_W13_1 : O_W13_0));
      const u16* W2 = (const u16*)(ws + (l1 ? O_W2_1 : O_W2_0));
      if (ph == 1 || ph == 8) {
        const float* sq = l1 ? ssq + 2 * T : nullptr;
        if (sub == 0) { g = pg8::Gemm{xb, (const u16*)(ws + (l1 ? O_WQKV1 : O_WIN0)), T, l1 ? 1280 : 4352, 1024}; E.kind = l1 ? EK_QK1 : EK_QK0; E.ssq_in = sq; }
        else { g = pg8::Gemm{(const u16*)(ws + (l1 ? O_WV1 : O_WV0)), xb, l1 ? 256 : 512, T, 1024}; E.kind = EK_VT; E.ssq_in = sq;
               E.o16 = (u16*)(ws + (l1 ? O_VT1 : O_VT0)); E.nh = l1 ? 4 : 8; c = (bid + G - 64) % G; }
      } else if (ph == 5 || ph == 10) {
        g = pg8::Gemm{(const u16*)(ws + (l1 ? O_AO : O_MIX)), (const u16*)(ws + (l1 ? O_WOUT1 : O_WOUT0)), T, 1024, l1 ? 1024 : 1536};
        E.kind = EK_RES; E.perm = false; E.res_in = l1 ? nullptr : p.x; E.res_out = nullptr; E.xb_out = xb; E.ssq_out = ssq + (l1 ? 3 * T : T);
      } else if (ph == 6 || ph == 11) {
        g = pg8::Gemm{xb, W13, T, 5632, 1024}; E.kind = EK_SWIGLU; E.ssq_in = ssq + (l1 ? 3 * T : T); E.o16 = (u16*)(ws + O_H);
      } else {
        g = pg8::Gemm{(const u16*)(ws + O_H), W2, T, 1024, 2816};
        E.kind = EK_RES; E.perm = false; E.res_in = nullptr; E.res_out = l1 ? p.out : nullptr; E.xb_out = xb; E.ssq_out = l1 ? nullptr : ssq + 2 * T;
      }
      pg8::StaticOrder S; S.init(g.M, g.N, G, c);
      pg8::gemm_phase(( PG8_LAS unsigned char*)smem, g, S, E);
      if (ph == 6 && G == 256 && bid >= 128) {
        const int tid = otid();
        phase_prep_l1(p, ws, (bid - 128) * 8 + (tid >> 6), 128 * 8, tid & 63);
      }
    }
    return;
  }
  switch (ph) {
    case 0: phase_prep(p); break;
    case 2: {
      PSUB(4) for (int t = vb; t < 2048; t += nvb) na_tile(p, t);
      PSUB(5) for (int t = vb; t < 1024; t += nvb) conv_tile(p, t);
      float* dtb = (float*)(ws + O_DTB);
      for (int idx = bid * 512 + otid(); idx < T * 32; idx += G * 512) {
        float v = dtb[idx] + p.dt_bias[idx & 31];
        dtb[idx] = (v > 20.f) ? v : log1pf(expf(v));
      }
    } break;
    case 3: {
      for (int t0 = 0; t0 < 256; t0 += G) {
        int item = min(t0 + bid, 255);
        if (G == 256) {
          const int xcd = bid & 7, j = bid >> 3, grp = xcd * 4 + (j >> 3), idx8 = j & 7;
          item = (idx8 & 1) + 2 * ((grp & 3) * 4 + (idx8 >> 1)) + 32 * (grp >> 2);
        }
        scan_item8(p, smem, item);
      }
      if (G != 256) { const int tid = otid(); phase_prep_l1(p, ws, bid * 8 + (tid >> 6), G * 8, tid & 63); }
    } break;
    case 4:
      for (int t0 = 0; t0 < 512; t0 += nvb) ssd_out_tile(p, sh, min(t0 + vb, 511));
      break;
    case 9:
      if (G == 256) {
        const int xcd = bid & 7, j = bid >> 3;
        for (int r = 0; r < 2; ++r) gqa_tile8(p, smem, (r * 16 + xcd * 2 + (j >> 4)) * 16 + (j & 15));
      } else {
        for (int t0 = 0; t0 < 512; t0 += G) gqa_tile8(p, smem, min(t0 + bid, 511));
      }
      break;
    default: break;
  }
}

#define XB_TMO      128
#define XB_XCNT(j)  (256  + 64 * (j))
#define XB_XSUB(j)  (1280 + 64 * (j))
#define XB_XGEN(j)  (2304 + 64 * (j))
#define XB_TOP      3328
#define XB_TOPGEN   3392
#define XCD_BAR_WORDS 3456
#define XB_SPIN_CAP (1u << 18)
#define LAS __attribute__((address_space(3)))
DI unsigned xb_ld(unsigned* p) { return __hip_atomic_load(p, __ATOMIC_RELAXED, __HIP_MEMORY_SCOPE_AGENT); }
DI unsigned xb_add(unsigned* p, unsigned v) { return __hip_atomic_fetch_add(p, v, __ATOMIC_RELAXED, __HIP_MEMORY_SCOPE_AGENT); }
DI unsigned xb_xcc_id() { return (unsigned)__builtin_amdgcn_s_getreg((3 << 11) | 20) & 0xFu; }
#define XB_SPIN(cond, bar) do { unsigned _sp = 0; while (cond) { __builtin_amdgcn_s_sleep(1); \
    if ((++_sp & 255u) == 0u) { if (xb_ld(&(bar)[XB_TMO])) break; if (_sp > XB_SPIN_CAP) { atomicAdd(&(bar)[XB_TMO], 1u); break; } } } } while (0)
struct XcdBarrier { unsigned* bar; unsigned x; volatile LAS unsigned* st; };
DI XcdBarrier xcd_barrier_post(unsigned* bar, volatile LAS unsigned* st) {
  XcdBarrier b; b.bar = bar; b.x = xb_xcc_id(); b.st = st;
  if (threadIdx_x_raw() == 0) (void)xb_add(&bar[XB_XCNT(b.x)], 1u);
  return b;
}
DI void xcd_barrier_complete(unsigned* bar, unsigned x, unsigned& nloc, unsigned& nx) {
  const unsigned G = gridDim.x * gridDim.y * gridDim.z;
  unsigned sum, cnt, mine, sp = 0u;
  for (;;) {
    sum = 0u; cnt = 0u; mine = 0u;
#pragma unroll
    for (unsigned j = 0; j < 16; ++j) { const unsigned c = xb_ld(&bar[XB_XCNT(j)]); sum += c; cnt += (c > 0u) ? 1u : 0u; mine = (j == x) ? c : mine; }
    if (sum == G) break;
    __builtin_amdgcn_s_sleep(1);
    if ((++sp & 255u) == 0u) { if (xb_ld(&bar[XB_TMO])) break; if (sp > XB_SPIN_CAP) { atomicAdd(&bar[XB_TMO], 1u); break; } }
  }
  nloc = mine > 0u ? mine : 1u; nx = cnt > 0u ? cnt : 1u;
}
DI void xcd_barrier(const XcdBarrier& b) {
  asm volatile("s_waitcnt vmcnt(0)" ::: "memory");
  __syncthreads();
  if (threadIdx_x_raw() == 0) {
    unsigned* bar = b.bar;
    asm volatile("" : "+s"(bar));
    __builtin_amdgcn_s_waitcnt(0);
    unsigned nloc = b.st[0], nx = b.st[1];
    if (nloc == 0u) { xcd_barrier_complete(bar, b.x, nloc, nx); b.st[0] = nloc; b.st[1] = nx; }
    const unsigned old = xb_add(&bar[XB_XSUB(b.x)], 1u);
    const unsigned gen = old / nloc;
    if (old + 1u == (gen + 1u) * nloc) {
      __builtin_amdgcn_fence(__ATOMIC_RELEASE, "agent");
      asm volatile("s_waitcnt vmcnt(0)" ::: "memory");
      const unsigned og = xb_add(&bar[XB_TOP], 1u);
      const unsigned tg = og / nx;
      if (og + 1u == (tg + 1u) * nx) xb_add(&bar[XB_TOPGEN], 1u);
      else XB_SPIN(xb_ld(&bar[XB_TOPGEN]) == tg, bar);
      __builtin_amdgcn_fence(__ATOMIC_ACQUIRE, "agent");
      xb_add(&bar[XB_XGEN(b.x)], 1u);
      asm volatile("s_waitcnt vmcnt(0)" ::: "memory");
    } else {
      XB_SPIN(xb_ld(&bar[XB_XGEN(b.x)]) == gen, bar);
      __builtin_amdgcn_fence(__ATOMIC_ACQUIRE, "agent");
      asm volatile("s_waitcnt vmcnt(0)" ::: "memory");
    }
  }
  __syncthreads();
}

__global__ void __launch_bounds__(512, 2) mega(Params p) {
  extern __shared__ __attribute__((aligned(16))) char smem[];
  __shared__ uint4 xb_words;
  cg::grid_group grid = cg::this_grid();
  if (threadIdx_x_raw() == 0) xb_words = make_uint4(0u, 0u, 0u, 0u);
  __syncthreads();
  XcdBarrier xb = xcd_barrier_post((unsigned*)(p.ws + O_BAR), (volatile LAS unsigned*)&xb_words);
  if (p.ph0 < 0) grid.sync();
  for (int ph = p.ph0; ph < p.ph1; ++ph) {
    int nrep = 1;
#if PROBE_REP_MASK
    if ((PROBE_REP_MASK >> ph) & 1) nrep = 2;
#endif
    for (int r = 0; r < nrep; ++r) {
      run_phase(p, smem, ph);
      if (r + 1 < nrep || ph + 1 < p.ph1) xcd_barrier(xb);
    }
  }
#if PROBE_EXTRA_SYNCS
  for (int i = 0; i < PROBE_EXTRA_SYNCS; ++i) xcd_barrier(xb);
#endif
}

extern "C" void kernel_launch(void* const* d_in, const int* in_sizes, int n_in, void* d_out, int out_size, void* d_ws,
                              size_t ws_size, hipStream_t stream) {
  static int grid_blocks = 0;
  if (!grid_blocks) {
    (void)hipFuncSetAttribute((const void*)mega, hipFuncAttributeMaxDynamicSharedMemorySize, SMEM_BYTES);
    int dev = 0, cus = 0, per_cu = 0;
    (void)hipGetDevice(&dev);
    (void)hipDeviceGetAttribute(&cus, hipDeviceAttributeMultiprocessorCount, dev);
    (void)hipOccupancyMaxActiveBlocksPerMultiprocessor(&per_cu, mega, 512, SMEM_BYTES);
    if (per_cu < 1) per_cu = 1;
    grid_blocks = cus;
  }
  Params p{};
  const float** pp = (const float**)&p;
  for (int i = 0; i < 21; ++i) pp[i] = (const float*)d_in[i];
  p.out = (float*)d_out;
  p.ws = (char*)d_ws;
  (void)hipMemsetAsync((char*)d_ws + O_BAR, 0, XCD_BAR_WORDS * 4, stream);
#if MULTI_LAUNCH
  for (int ph = 0; ph < NPHASE; ++ph) {
    p.ph0 = ph; p.ph1 = ph + 1;
    hipLaunchKernelGGL(mega, dim3(grid_blocks), dim3(512), SMEM_BYTES, stream, p);
  }
#else
  p.ph0 = 0; p.ph1 = NPHASE;
  void* args[] = {&p};
  hipError_t e = hipLaunchCooperativeKernel((const void*)mega, dim3(grid_blocks), dim3(512), args, SMEM_BYTES, stream);
  if (e != hipSuccess) fprintf(stderr, "cooperative launch failed: %s (grid %d)\n", hipGetErrorString(e), grid_blocks);
#endif
}
```

```cpp
#include <hip/hip_runtime.h>
#include <hip/hip_bf16.h>
#include <hip/hip_cooperative_groups.h>
#include <cstdio>
namespace cg = cooperative_groups;

#define PROBE_REP_MASK 0
#define PROBE_EXTRA_SYNCS 0
#define PROBE_SUB 0
#define PSUB(k) for (int _r = 0; _r < ((PROBE_SUB == (k)) ? 2 : 1); ++_r)
#ifndef MULTI_LAUNCH
#define MULTI_LAUNCH 0
#endif

typedef __attribute__((ext_vector_type(8))) short bf16x8;
typedef __attribute__((ext_vector_type(4))) float f32x4;
typedef __attribute__((ext_vector_type(2))) float f32x2;
typedef __attribute__((ext_vector_type(2))) __bf16 bf16v2;
typedef unsigned short u16;
typedef unsigned u32x4v __attribute__((ext_vector_type(4)));

#define DI __device__ __forceinline__
#define MFMA(a, b, c) __builtin_amdgcn_mfma_f32_16x16x32_bf16((a), (b), (c), 0, 0, 0)

constexpr int T = 16384;
constexpr float EPS = 1e-6f;
constexpr float LOG2E = 1.4426950408889634f;
constexpr int NPHASE = 13;
constexpr int SMEM_BYTES = 131072 + 8192;

constexpr size_t MIB = 1u << 20;
constexpr size_t O_WIN0 = 0;
constexpr size_t O_WV0 = O_WIN0 + 4352ull * 1024 * 2;
constexpr size_t O_WOUT0 = O_WV0 + 512ull * 1024 * 2;
constexpr size_t O_W13_0 = O_WOUT0 + 1024ull * 1536 * 2;
constexpr size_t O_W2_0 = O_W13_0 + 5632ull * 1024 * 2;
constexpr size_t O_ROPE = 31 * MIB;
constexpr size_t O_DTB = O_ROPE + 524288;
constexpr size_t O_SSQ = O_DTB + 2097152;
constexpr size_t O_BAR = O_SSQ + 262144;
constexpr size_t O_XB = 34 * MIB;
constexpr size_t O_BN = O_XB;
constexpr size_t O_BT = O_XB + 16 * MIB;
constexpr size_t O_Q0 = 66 * MIB;
constexpr size_t O_K0 = 82 * MIB;
constexpr size_t O_VT0 = 98 * MIB;
constexpr size_t O_WQKV1 = 66 * MIB;
constexpr size_t O_WV1 = O_WQKV1 + 1280ull * 1024 * 2;
constexpr size_t O_WOUT1 = O_WV1 + 256ull * 1024 * 2;
constexpr size_t O_W13_1 = O_WOUT1 + 1024ull * 1024 * 2;
constexpr size_t O_W2_1 = O_W13_1 + 5632ull * 1024 * 2;
constexpr size_t O_BIG = 114 * MIB;
constexpr size_t O_XBC = O_BIG;
constexpr size_t O_HPREV = O_BIG;
constexpr size_t O_CN = O_BIG + 64 * MIB;
constexpr size_t O_MIX = O_BIG + 80 * MIB;
constexpr size_t O_H = O_BIG;
constexpr size_t O_Q1 = O_BIG;
constexpr size_t O_K1 = O_BIG + 32 * MIB;
constexpr size_t O_VT1 = O_BIG + 40 * MIB;
constexpr size_t O_AO = O_BIG + 48 * MIB;

struct Params {
  const float *x, *even_mix_norm, *even_w_in, *na_q_norm, *na_k_norm, *na_rel_bias, *conv_w, *conv_b, *dt_bias, *A_log,
      *Dskip, *out_norm, *even_w_out, *odd_mix_norm, *odd_w_qkv, *gqa_q_norm, *gqa_k_norm, *odd_w_out, *ffn_norm,
      *ffn_w13, *ffn_w2;
  float* out;
  char* ws;
  int ph0, ph1;
};

__device__ __forceinline__ int threadIdx_x_raw() { return (int)__builtin_amdgcn_workitem_id_x(); }
DI unsigned pack2(float a, float b) {
  f32x2 v = {a, b};
  bf16v2 r = __builtin_convertvector(v, bf16v2);
  return __builtin_bit_cast(unsigned, r);
}
DI uint2 pack4(f32x4 v) { return make_uint2(pack2(v[0], v[1]), pack2(v[2], v[3])); }
DI u16 f2bf(float a) { return (u16)(pack2(a, 0.f) & 0xffffu); }
DI float bflo(unsigned u) { return __uint_as_float(u << 16); }
DI float bfhi(unsigned u) { return __uint_as_float(u & 0xffff0000u); }
DI float bf2f(u16 h) { return __uint_as_float(((unsigned)h) << 16); }
DI bf16x8 as_bf8(uint4 v) { return __builtin_bit_cast(bf16x8, v); }
DI bf16x8 cat_bf8(uint2 a, uint2 b) { return as_bf8(make_uint4(a.x, a.y, b.x, b.y)); }
DI int vtid() { int t = threadIdx_x_raw() & 255; asm volatile("" : "+v"(t)); return t; }
DI int otid() { int t = threadIdx_x_raw(); asm volatile("" : "+v"(t)); return t; }
DI float silu(float x) { return x * __builtin_amdgcn_rcpf(1.f + __builtin_amdgcn_exp2f(-1.4426950408889634f * x)); }
DI float ex2(float x) { return __builtin_amdgcn_exp2f(x); }
DI float xor16_32_sum(float v) { v += __shfl_xor(v, 16); v += __shfl_xor(v, 32); return v; }
DI float xor16_32_max(float v) { v = fmaxf(v, __shfl_xor(v, 16)); v = fmaxf(v, __shfl_xor(v, 32)); return v; }
DI void wave_sync_lds() { __builtin_amdgcn_fence(__ATOMIC_ACQ_REL, "wavefront"); __builtin_amdgcn_wave_barrier(); }
DI void unpack8(uint4 u, float* f) {
  f[0] = bflo(u.x); f[1] = bfhi(u.x); f[2] = bflo(u.y); f[3] = bfhi(u.y);
  f[4] = bflo(u.z); f[5] = bfhi(u.z); f[6] = bflo(u.w); f[7] = bfhi(u.w);
}

struct WDesc { const float* W; int ldn, K, rows; u16* dst; const float* gain; int mode, coloff; };
DI int wt_srccol(int mode, int R, int coloff) {
  if (mode == 0) return coloff + R;
  const int pn = R >> 8, c = R & 255, bj = c >> 7, j = c & 127;
  if (mode == 1) return bj * 2816 + pn * 128 + j;
  const int wc = j >> 5, e = j & 31;
  if (mode == 2) {
    if (pn < 4) return (pn >> 1) * 512 + ((pn & 1) * 4 + wc) * 64 + bj * 32 + e;
    if (pn < 8) return 1536 + (R - 1024);
    if (pn < 16) return 2560 + (R - 2048);
    return (R - 4096 < 32) ? 4608 + (R - 4096) : -1;
  }
  if (pn < 4) return (pn * 4 + wc) * 64 + bj * 32 + e;
  return 1024 + wc * 64 + bj * 32 + e;
}
__device__ void wt_item(const WDesc& d, int item, int lane) {
  const int nr = d.rows >> 6, nn = item % nr, kk = item / nr;
  const int R = nn * 64 + lane;
  const int sc = wt_srccol(d.mode, R, d.coloff);
  const float* src = d.W + (sc >= 0 ? sc : 0);
  u16* dst = d.dst + (size_t)R * d.K + kk * 64;
#pragma unroll 2
  for (int k8 = 0; k8 < 8; ++k8) {
    float v[8];
#pragma unroll
    for (int e = 0; e < 8; ++e) {
      const int k = kk * 64 + k8 * 8 + e;
      float x = src[(size_t)k * d.ldn];
      if (d.gain) x *= d.gain[k];
      v[e] = (sc >= 0) ? x : 0.f;
    }
    *(uint4*)(dst + k8 * 8) = make_uint4(pack2(v[0], v[1]), pack2(v[2], v[3]), pack2(v[4], v[5]), pack2(v[6], v[7]));
  }
}
DI WDesc wt_desc(const Params& p, char* ws, int set, int i) {
  if (set == 0) {
    switch (i) {
      case 0: return WDesc{p.even_w_in, 4640, 1024, 4352, (u16*)(ws + O_WIN0), p.even_mix_norm, 2, 0};
      case 1: return WDesc{p.even_w_in, 4640, 1024, 512, (u16*)(ws + O_WV0), p.even_mix_norm, 0, 1024};
      case 2: return WDesc{p.even_w_out, 1024, 1536, 1024, (u16*)(ws + O_WOUT0), nullptr, 0, 0};
      case 3: return WDesc{p.ffn_w13, 5632, 1024, 5632, (u16*)(ws + O_W13_0), p.ffn_norm, 1, 0};
      default: return WDesc{p.ffn_w2, 1024, 2816, 1024, (u16*)(ws + O_W2_0), nullptr, 0, 0};
    }
  }
  switch (i) {
    case 0: return WDesc{p.odd_w_qkv, 1536, 1024, 1280, (u16*)(ws + O_WQKV1), p.odd_mix_norm, 3, 0};
    case 1: return WDesc{p.odd_w_qkv, 1536, 1024, 256, (u16*)(ws + O_WV1), p.odd_mix_norm, 0, 1280};
    case 2: return WDesc{p.odd_w_out, 1024, 1024, 1024, (u16*)(ws + O_WOUT1), nullptr, 0, 0};
    case 3: return WDesc{p.ffn_w13 + (size_t)1024 * 5632, 5632, 1024, 5632, (u16*)(ws + O_W13_1), p.ffn_norm + 1024, 1, 0};
    default: return WDesc{p.ffn_w2 + (size_t)2816 * 1024, 1024, 2816, 1024, (u16*)(ws + O_W2_1), nullptr, 0, 0};
  }
}
__device__ void wt_run(const Params& p, char* ws, int set, int gw, int nw, int lane) {
  const int c0 = set ? 320 : 1088, c1 = c0 + (set ? 64 : 128), c2 = c1 + (set ? 256 : 384), c3 = c2 + 1408, total = c3 + 704;
  for (int it = gw; it < total; it += nw) {
    const int i = it < c0 ? 0 : it < c1 ? 1 : it < c2 ? 2 : it < c3 ? 3 : 4;
    const int base = i == 0 ? 0 : i == 1 ? c0 : i == 2 ? c1 : i == 3 ? c2 : c3;
    const WDesc d = wt_desc(p, ws, set, i);
    wt_item(d, it - base, lane);
  }
}

__device__ void phase_prep(const Params& p) {
  char* ws = p.ws;
  asm volatile("" : "+s"(ws));
  const int tid = otid(), lane = tid & 63;
  const int gw = blockIdx.x * 8 + (tid >> 6), nw = gridDim.x * 8;
  PSUB(1) wt_run(p, ws, 0, gw, nw, lane);
  PSUB(2) for (int row0 = gw * 4; row0 < T; row0 += nw * 4) {
    float4 v[4][4];
#pragma unroll
    for (int rr = 0; rr < 4; ++rr)
#pragma unroll
      for (int i = 0; i < 4; ++i) v[rr][i] = *(const float4*)(p.x + (size_t)(row0 + rr) * 1024 + i * 256 + lane * 4);
#pragma unroll
    for (int rr = 0; rr < 4; ++rr) {
      u16* xb = (u16*)(ws + O_XB) + (size_t)(row0 + rr) * 1024;
      float ss = 0.f;
#pragma unroll
      for (int i = 0; i < 4; ++i) { const float4 a = v[rr][i]; ss += a.x * a.x + a.y * a.y + a.z * a.z + a.w * a.w; }
#pragma unroll
      for (int o = 32; o >= 1; o >>= 1) ss += __shfl_xor(ss, o);
      const float rs = rsqrtf(ss * (1.f / 1024.f) + EPS);
#pragma unroll
      for (int i = 0; i < 4; ++i) {
        const float4 a = v[rr][i];
        *(uint2*)(xb + i * 256 + lane * 4) = make_uint2(pack2(a.x * rs, a.y * rs), pack2(a.z * rs, a.w * rs));
      }
      if (lane == 0) {
        float* ssq = (float*)(ws + O_SSQ);
        const int row = row0 + rr;
        ssq[row] = ss; ssq[T + row] = 0.f; ssq[2 * T + row] = 0.f; ssq[3 * T + row] = 0.f;
      }
    }
  }
  PSUB(3) for (int idx = blockIdx.x * 512 + tid; idx < 65536; idx += gridDim.x * 512) {
    int s = idx >> 5, pp = idx & 31;
    float pos = (pp < 16) ? (float)(s >> 6) : (float)(s & 63);
    float freq = powf(10000.f, -(float)(pp & 15) / 16.f);
    float sn, cs;
    sincosf(pos * freq, &sn, &cs);
    ((float2*)(ws + O_ROPE))[idx] = make_float2(cs, sn);
  }
}
__device__ void phase_prep_l1(const Params& p, char* ws, int gw, int nw, int lane) { wt_run(p, ws, 1, gw, nw, lane); }
namespace pg8 {
#define PG8_LAS __attribute__((address_space(3)))
typedef unsigned short bf16_t;
constexpr int BM = 256, BK = 64, HALF = 128, HTB = HALF * BK * 2, STAGE_BYTES = 8 * HTB, NXCD = 8, WGM = 8;
DI int lds_byte(int r, int c) { const int st = (r >> 4) * 2 + (c >> 5), rr = r & 15, cc = c & 31, ob = rr * 64 + cc * 2; return st * 1024 + (ob ^ (((ob >> 9) & 1) << 5)); }
DI void stage_rc(int b, int& R, int& C) { const int st = b / 1024, sb = b % 1024, swz = sb ^ (((sb >> 9) & 1) << 5); R = (st >> 1) * 16 + swz / 64; C = (st & 1) * 32 + (swz % 64) / 2; }
DI int perm32(int rho) { const int n = rho >> 4, i = rho & 15; return 8 * (i >> 2) + 4 * n + (i & 3); }
struct Unit { int pm, pn; };
struct Gemm { const bf16_t* A; const bf16_t* Bt; int M, N, K; };
struct StaticOrder {
  int nM, nN, nwg, G, c;
  DI void init(int M, int N, int G_, int c_) { nM = M / BM; nN = N / BM; nwg = nM * nN; G = G_; c = c_; }
  DI bool next(int i, Unit& u) const {
    const long L = (long)i * G + c; if (L >= nwg) return false;
    int wgid = (int)L; { const int q = nwg / NXCD, r = nwg % NXCD, xcd = wgid % NXCD, off = wgid / NXCD; wgid = (xcd < r ? xcd * (q + 1) : r * (q + 1) + (xcd - r) * q) + off; }
    const int nig = WGM * nN, gid = wgid / nig, fm = gid * WGM, gsz = (nM - fm) < WGM ? (nM - fm) : WGM;
    u.pm = fm + ((wgid % nig) % gsz); u.pn = (wgid % nig) / gsz; return true;
  }
};
template <class Epi>
DI void gemm_phase(PG8_LAS unsigned char* lds, const Gemm g, const StaticOrder& S, const Epi& E) {
  const int tid = otid(), wid = __builtin_amdgcn_readfirstlane(tid >> 6), lane = tid & 63, wr = wid >> 2, wc = wid & 3, fr = lane & 15, fq = lane >> 4;
  const int K = g.K, nt = K / BK;
  unsigned voffA[2], voffB[2];
#pragma unroll
  for (int i = 0; i < 2; ++i) { int R, C; stage_rc(tid * 16 + i * 8192, R, C); const int Rb = E.perm ? ((R & ~31) + perm32(R & 31)) : R;
    voffA[i] = (unsigned)(R * K + C) * 2u; voffB[i] = (unsigned)(Rb * K + C) * 2u; }
  const size_t kstep = (size_t)(BK * 2);
  const size_t hstep = (size_t)HALF * K * 2;
  const size_t tstep = 2 * hstep;
  const unsigned ldsw = (unsigned)wid * 1024u;
  const int aoff = lds_byte(wr * 64 + fr, fq * 8), boff = lds_byte(wc * 32 + fr, fq * 8);
#define PG8_SA(b, h) (((b) * 2 + (h)) * HTB)
#define PG8_SB(b, h) ((4 + (b) * 2 + (h)) * HTB)
#define PG8_STAGE(bufoff, gbase, voff) do { _Pragma("unroll") for (int _i = 0; _i < 2; ++_i) \
    __builtin_amdgcn_global_load_lds((const unsigned*)((const char*)(gbase) + (voff)[_i]), (PG8_LAS unsigned*)(lds + (bufoff) + ldsw + _i * 8192), 16, 0, 0); } while (0)
#define PG8_LDA(dst, b, h) do { _Pragma("unroll") for (int m = 0; m < 4; ++m) _Pragma("unroll") for (int k = 0; k < 2; ++k) dst[m][k] = *(const PG8_LAS bf16x8*)(lds + PG8_SA(b, h) + aoff + m * 2048 + k * 1024); } while (0)
#define PG8_LDB(dst, b, h) do { _Pragma("unroll") for (int n = 0; n < 2; ++n) _Pragma("unroll") for (int k = 0; k < 2; ++k) dst[n][k] = *(const PG8_LAS bf16x8*)(lds + PG8_SB(b, h) + boff + n * 2048 + k * 1024); } while (0)
#define PG8_MMA(ai, bj, At, Bt) do { __builtin_amdgcn_s_setprio(1); _Pragma("unroll") for (int m = 0; m < 4; ++m) _Pragma("unroll") for (int n = 0; n < 2; ++n) _Pragma("unroll") for (int k = 0; k < 2; ++k) \
    acc[ai][bj][m][n] = __builtin_amdgcn_mfma_f32_16x16x32_bf16(Bt[n][k], At[m][k], acc[ai][bj][m][n], 0, 0, 0); __builtin_amdgcn_s_setprio(0); } while (0)
#define PG8_WAIT_V(n) asm volatile("s_waitcnt vmcnt(" #n ")" ::: "memory")
#define PG8_WAIT_L(n) asm volatile("s_waitcnt lgkmcnt(" #n ")" ::: "memory")
#define PG8_BAR __builtin_amdgcn_s_barrier()
#define PG8_SCHED __builtin_amdgcn_sched_barrier(0)
  Unit cur, nxt; int ui = 0;
  if (!S.next(0, cur)) return;
  if (E.ssq_in) {
    PG8_LAS float* rtab = (PG8_LAS float*)(lds + 131072);
    Unit uu;
    for (int q = 0; q < 8 && S.next(q, uu); ++q)
      if (tid < 256) rtab[q * 256 + tid] = rsqrtf(E.ssq_in[(E.kind == 4 ? uu.pn : uu.pm) * 256 + tid] * (1.f / 1024.f) + EPS);
    __syncthreads();
  }
  f32x4 acc[2][2][4][2];
#pragma unroll
  for (int a = 0; a < 2; ++a)
#pragma unroll
    for (int b = 0; b < 2; ++b)
#pragma unroll
      for (int m = 0; m < 4; ++m)
#pragma unroll
        for (int n = 0; n < 2; ++n) acc[a][b][m][n] = (f32x4){0.f, 0.f, 0.f, 0.f};
  bf16x8 At[4][2], B0[2][2], B1[2][2];
  const char* cA = (const char*)g.A + (size_t)cur.pm * tstep; const char* cB = (const char*)g.Bt + (size_t)cur.pn * tstep;
  PG8_STAGE(PG8_SB(0, 0), cB, voffB); PG8_STAGE(PG8_SA(0, 0), cA, voffA); PG8_STAGE(PG8_SB(0, 1), cB + hstep, voffB); PG8_STAGE(PG8_SA(0, 1), cA + hstep, voffA);
  if (wr == 1) PG8_BAR;
  PG8_WAIT_V(4); PG8_BAR;
  PG8_STAGE(PG8_SB(1, 0), cB + kstep, voffB); PG8_STAGE(PG8_SA(1, 0), cA + kstep, voffA); PG8_STAGE(PG8_SB(1, 1), cB + hstep + kstep, voffB);
  PG8_WAIT_V(6); PG8_BAR;
  for (;;) {
    const bool has_next = S.next(ui + 1, nxt);
    const char* nA = has_next ? (const char*)g.A + (size_t)nxt.pm * tstep : cA; const char* nB = has_next ? (const char*)g.Bt + (size_t)nxt.pn * tstep : cB;
    for (int t = 0; t < nt; t += 2) {
      const bool last = (t == nt - 2);
      const char* a1 = cA + (size_t)(t + 1) * kstep;
      const char* a2 = last ? nA : cA + (size_t)(t + 2) * kstep; const char* b2 = last ? nB : cB + (size_t)(t + 2) * kstep;
      const char* a3 = a2 + kstep; const char* b3 = b2 + kstep;
      PG8_LDB(B0, 0, 0); PG8_SCHED; PG8_LDA(At, 0, 0); PG8_STAGE(PG8_SA(1, 1), a1 + hstep, voffA);
      PG8_WAIT_L(8); PG8_BAR; PG8_WAIT_L(0); PG8_MMA(0, 0, At, B0); PG8_BAR; PG8_SCHED;
      PG8_LDB(B1, 0, 1); PG8_STAGE(PG8_SB(0, 0), b2, voffB);
      PG8_BAR; PG8_WAIT_L(0); PG8_MMA(0, 1, At, B1); PG8_BAR;
      PG8_LDA(At, 0, 1); PG8_STAGE(PG8_SA(0, 0), a2, voffA);
      PG8_BAR; PG8_WAIT_L(0); PG8_MMA(1, 0, At, B0); PG8_BAR; PG8_SCHED;
      PG8_STAGE(PG8_SB(0, 1), b2 + hstep, voffB);
      PG8_WAIT_V(6); PG8_BAR; PG8_MMA(1, 1, At, B1); PG8_BAR;
      PG8_LDB(B0, 1, 0); PG8_SCHED; PG8_LDA(At, 1, 0); PG8_STAGE(PG8_SA(0, 1), a2 + hstep, voffA);
      PG8_WAIT_L(8); PG8_BAR; PG8_WAIT_L(0); PG8_MMA(0, 0, At, B0); PG8_BAR; PG8_SCHED;
      PG8_LDB(B1, 1, 1); PG8_STAGE(PG8_SB(1, 0), b3, voffB);
      PG8_BAR; PG8_WAIT_L(0); PG8_MMA(0, 1, At, B1); PG8_BAR;
      PG8_LDA(At, 1, 1); PG8_STAGE(PG8_SA(1, 0), a3, voffA);
      PG8_BAR; PG8_WAIT_L(0); PG8_MMA(1, 0, At, B0); PG8_BAR; PG8_SCHED;
      PG8_STAGE(PG8_SB(1, 1), b3 + hstep, voffB);
      PG8_WAIT_V(6); PG8_BAR; PG8_MMA(1, 1, At, B1); PG8_BAR;
    }
    E(acc, cur, wr, wc, fr, fq, (const PG8_LAS float*)(lds + 131072) + ui * 256);
    if (!has_next) break;
#pragma unroll
    for (int a = 0; a < 2; ++a)
#pragma unroll
      for (int b = 0; b < 2; ++b)
#pragma unroll
        for (int m = 0; m < 4; ++m)
#pragma unroll
          for (int n = 0; n < 2; ++n) acc[a][b][m][n] = (f32x4){0.f, 0.f, 0.f, 0.f};
    cur = nxt; cA = nA; cB = nB; ++ui;
  }
  PG8_WAIT_V(0);
  if (wr == 0) PG8_BAR;
  PG8_BAR;
#undef PG8_SA
#undef PG8_SB
#undef PG8_STAGE
#undef PG8_LDA
#undef PG8_LDB
#undef PG8_MMA
#undef PG8_WAIT_V
#undef PG8_WAIT_L
#undef PG8_BAR
#undef PG8_SCHED
}
}

typedef f32x4 AccT[2][2][4][2];
DI uint4 pack8(f32x4 a, f32x4 b) { return make_uint4(pack2(a[0], a[1]), pack2(a[2], a[3]), pack2(b[0], b[1]), pack2(b[2], b[3])); }

struct EpiRes {
  static constexpr bool PERM = false;
  const float* res_f32; u16* xb; float* out_f32; float* ssq_out;
  DI void operator()(const AccT& acc, const pg8::Unit& u, int wr, int wc, int fr, int fq, const PG8_LAS float* rtab) const {
    const int row0 = u.pm * 256 + wr * 64 + fr, col0 = u.pn * 256 + wc * 32 + 4 * fq;
#pragma unroll
    for (int ai = 0; ai < 2; ++ai)
#pragma unroll
      for (int m = 0; m < 4; ++m) {
        const size_t r = row0 + ai * 128 + m * 16;
        float part = 0.f;
#pragma unroll
        for (int bj = 0; bj < 2; ++bj)
#pragma unroll
          for (int n = 0; n < 2; ++n) {
            const int c = col0 + bj * 128 + n * 16;
            float4 r4;
            if (res_f32) r4 = *(const float4*)(res_f32 + r * 1024 + c);
            else { uint2 rr = *(const uint2*)(xb + r * 1024 + c); r4 = make_float4(bflo(rr.x), bfhi(rr.x), bflo(rr.y), bfhi(rr.y)); }
            f32x4 a = acc[ai][bj][m][n];
            float4 v = make_float4(r4.x + a[0], r4.y + a[1], r4.z + a[2], r4.w + a[3]);
            if (out_f32) *(float4*)(out_f32 + r * 1024 + c) = v;
            else *(uint2*)(xb + r * 1024 + c) = make_uint2(pack2(v.x, v.y), pack2(v.z, v.w));
            part += v.x * v.x + v.y * v.y + v.z * v.z + v.w * v.w;
          }
        if (ssq_out) {
          part = xor16_32_sum(part);
          if (fq == 0) atomicAdd(ssq_out + r, part);
        }
      }
  }
};

struct EpiSwiglu {
  static constexpr bool PERM = true;
  const float* ssq_in; u16* h_out;
  DI void operator()(const AccT& acc, const pg8::Unit& u, int wr, int wc, int fr, int fq, const PG8_LAS float* rtab) const {
    const int row0 = u.pm * 256 + wr * 64 + fr;
#pragma unroll
    for (int ai = 0; ai < 2; ++ai)
#pragma unroll
      for (int m = 0; m < 4; ++m) {
        const size_t r = row0 + ai * 128 + m * 16;
        const float rs = rtab[ai * 128 + wr * 64 + m * 16 + fr];
        f32x4 h0, h1;
#pragma unroll
        for (int e = 0; e < 4; ++e) {
          h0[e] = silu(acc[ai][0][m][0][e] * rs) * (acc[ai][1][m][0][e] * rs);
          h1[e] = silu(acc[ai][0][m][1][e] * rs) * (acc[ai][1][m][1][e] * rs);
        }
        *(uint4*)(h_out + r * 2816 + u.pn * 128 + wc * 32 + 8 * fq) = pack8(h0, h1);
      }
  }
};

template <int L1>
struct EpiQK {
  static constexpr bool PERM = true;
  char* ws; u16* zout; const float* qn; const float* kn; const float* ssq_in;
  DI void operator()(const AccT& acc, const pg8::Unit& u, int wr, int wc, int fr, int fq, const PG8_LAS float* rtab) const {
    const int pn = u.pn;
    const int row0 = u.pm * 256 + wr * 64 + fr;
    const bool headnorm = L1 ? true : (pn < 4);
    const bool is_q = L1 ? (pn < 4) : (pn < 2);
#pragma unroll
    for (int ai = 0; ai < 2; ++ai)
#pragma unroll
      for (int m = 0; m < 4; ++m) {
        const size_t r = row0 + ai * 128 + m * 16;
        const float rs = L1 ? rtab[ai * 128 + wr * 64 + m * 16 + fr] : 1.f;
        f32x4 v[2][2];
#pragma unroll
        for (int bj = 0; bj < 2; ++bj)
#pragma unroll
          for (int n = 0; n < 2; ++n) v[bj][n] = acc[ai][bj][m][n] * rs;
        if (headnorm) {
          float ss = 0.f;
#pragma unroll
          for (int bj = 0; bj < 2; ++bj)
#pragma unroll
            for (int n = 0; n < 2; ++n)
              ss += v[bj][n][0] * v[bj][n][0] + v[bj][n][1] * v[bj][n][1] + v[bj][n][2] * v[bj][n][2] + v[bj][n][3] * v[bj][n][3];
          ss = xor16_32_sum(ss);
          const float hn = rsqrtf(ss * (1.f / 64.f) + EPS) * (is_q ? 0.125f * LOG2E : 1.f);
          const float* gn = is_q ? qn : kn;
#pragma unroll
          for (int bj = 0; bj < 2; ++bj)
#pragma unroll
            for (int n = 0; n < 2; ++n) {
              float4 g4 = *(const float4*)(gn + bj * 32 + 8 * fq + 4 * n);
              v[bj][n][0] *= hn * g4.x; v[bj][n][1] *= hn * g4.y; v[bj][n][2] *= hn * g4.z; v[bj][n][3] *= hn * g4.w;
            }
          u16* dst;
          if (L1) {
            const int s = (int)(r & 2047);
            const float4* rt = (const float4*)(ws + O_ROPE) + (size_t)s * 16;
#pragma unroll
            for (int bj = 0; bj < 2; ++bj)
#pragma unroll
              for (int n = 0; n < 2; ++n) {
                float4 cs = rt[bj * 8 + 2 * fq + n];
                float a0 = v[bj][n][0], a1 = v[bj][n][1], b0 = v[bj][n][2], b1 = v[bj][n][3];
                v[bj][n][0] = a0 * cs.x - a1 * cs.y; v[bj][n][1] = a0 * cs.y + a1 * cs.x;
                v[bj][n][2] = b0 * cs.z - b1 * cs.w; v[bj][n][3] = b0 * cs.w + b1 * cs.z;
              }
            dst = is_q ? (u16*)(ws + O_Q1) + r * 1024 + (pn * 4 + wc) * 64 : (u16*)(ws + O_K1) + r * 256 + wc * 64;
          } else {
            dst = (is_q ? (u16*)(ws + O_Q0) : (u16*)(ws + O_K0)) + r * 512 + ((pn & 1) * 4 + wc) * 64;
          }
#pragma unroll
          for (int bj = 0; bj < 2; ++bj) *(uint4*)(dst + bj * 32 + 8 * fq) = pack8(v[bj][0], v[bj][1]);
        } else if (pn < 8) {
          u16* dst = zout + r * 1024 + (pn - 4) * 256 + wc * 32 + 8 * fq;
#pragma unroll
          for (int bj = 0; bj < 2; ++bj) *(uint4*)(dst + bj * 128) = pack8(v[bj][0], v[bj][1]);
        } else if (pn < 16) {
          u16* dst = (u16*)(ws + O_XBC) + r * 2048 + (pn - 8) * 256 + wc * 32 + 8 * fq;
#pragma unroll
          for (int bj = 0; bj < 2; ++bj) *(uint4*)(dst + bj * 128) = pack8(v[bj][0], v[bj][1]);
        } else if (wc == 0) {
          float* dst = (float*)(ws + O_DTB) + r * 32 + 8 * fq;
          *(float4*)(dst) = make_float4(v[0][0][0], v[0][0][1], v[0][0][2], v[0][0][3]);
          *(float4*)(dst + 4) = make_float4(v[0][1][0], v[0][1][1], v[0][1][2], v[0][1][3]);
        }
      }
  }
};

struct EpiVT {
  static constexpr bool PERM = true;
  const float* ssq_in; u16* vt; int nh;
  DI void operator()(const AccT& acc, const pg8::Unit& u, int wr, int wc, int fr, int fq, const PG8_LAS float* rtab) const {
#pragma unroll
    for (int bj = 0; bj < 2; ++bj) {
      const int tok0 = u.pn * 256 + bj * 128 + wc * 32 + 8 * fq;
      f32x4 r0 = {1.f, 1.f, 1.f, 1.f}, r1 = r0;
      if (ssq_in) {
        const int lo = bj * 128 + wc * 32 + 8 * fq;
        r0 = *(const PG8_LAS f32x4*)(rtab + lo); r1 = *(const PG8_LAS f32x4*)(rtab + lo + 4);
      }
      const int b = tok0 >> 11, s = tok0 & 2047;
#pragma unroll
      for (int ai = 0; ai < 2; ++ai)
#pragma unroll
        for (int m = 0; m < 4; ++m) {
          const int f = u.pm * 256 + ai * 128 + wr * 64 + m * 16 + fr;
          const int hd = f >> 6, d = f & 63;
          u16* dstp = vt + ((size_t)((b * nh + hd) * 64 + d)) * 2048;
          const uint4 pk = pack8(acc[ai][bj][m][0] * r0, acc[ai][bj][m][1] * r1);
          if (nh == 4) {
            const int c = (s >> 3) & 3, pos0 = (s & ~31) + 16 * (c & 1) + 4 * (c >> 1);
            *(uint2*)(dstp + pos0) = make_uint2(pk.x, pk.y);
            *(uint2*)(dstp + pos0 + 8) = make_uint2(pk.z, pk.w);
          } else {
            *(uint4*)(dstp + s) = pk;
          }
        }
    }
  }
};
enum { EK_RES = 0, EK_SWIGLU = 1, EK_QK0 = 2, EK_QK1 = 3, EK_VT = 4 };
struct EpiAny {
  int kind; bool perm;
  char* ws; u16* zout; const float* qn; const float* kn; const float* ssq_in; float* ssq_out; const float* res_in; float* res_out; u16* xb_out; u16* o16; int nh;
  DI void operator()(const AccT& acc, const pg8::Unit& u, int wr, int wc, int fr, int fq, const PG8_LAS float* rtab) const {
    switch (kind) {
      case EK_RES: { EpiRes e{res_in, xb_out, res_out, ssq_out}; e(acc, u, wr, wc, fr, fq, rtab); } break;
      case EK_SWIGLU: { EpiSwiglu e{ssq_in, o16}; e(acc, u, wr, wc, fr, fq, rtab); } break;
      case EK_QK0: { EpiQK<0> e{ws, zout, qn, kn, ssq_in}; e(acc, u, wr, wc, fr, fq, rtab); } break;
      case EK_QK1: { EpiQK<1> e{ws, zout, qn, kn, ssq_in}; e(acc, u, wr, wc, fr, fq, rtab); } break;
      default: { EpiVT e{ssq_in, o16, nh}; e(acc, u, wr, wc, fr, fq, rtab); } break;
    }
  }
};

__device__ void na_tile(const Params& p, int tile) {
  const int tid = vtid(), lane = tid & 63, wave = tid >> 6, l15 = lane & 15, quad = lane >> 4;
  const int h = tile & 7, r = (tile >> 3) & 31, b = tile >> 8;
  const int c0 = min(max(16 * wave - 8, 0), 32);
  const int rs = min(max(r - 4, 0), 24);
  const u16* Q0 = (const u16*)(p.ws + O_Q0);
  const u16* K0 = (const u16*)(p.ws + O_K0) + (size_t)(b * 2048 + rs * 64 + c0 + 8 * (l15 >> 2) + (l15 & 3)) * 512 + h * 64 + 8 * quad;
  const u16* VT = (const u16*)(p.ws + O_VT0) + (size_t)((b * 8 + h) * 64 + l15) * 2048 + rs * 64 + c0 + 8 * quad;
  u16* mix = (u16*)(p.ws + O_MIX);
  const int tq = b * 2048 + r * 64 + 16 * wave + l15;
  bf16x8 qf[2];
#pragma unroll
  for (int ks = 0; ks < 2; ++ks) qf[ks] = as_bf8(*(const uint4*)(Q0 + (size_t)tq * 512 + h * 64 + 32 * ks + 8 * quad));
  const int cq = 16 * wave + l15;
  const int cs = min(max(cq - 8, 0), 48);
  const float* rpb = p.na_rel_bias + h * 465 + (rs - r + 7) * 31;
  const int d0 = c0 + 8 * quad - cq;
  const int w0 = d0 + cq - cs;
  f32x4 s[16];
  uint4 kb[2][4];
#pragma unroll
  for (int q4 = 0; q4 < 4; ++q4) kb[0][q4] = *(const uint4*)(K0 + (size_t)(4 * (q4 >> 1)) * 512 + 32 * (q4 & 1));
#pragma unroll
  for (int jr = 0; jr < 8; ++jr) {
    if (jr + 1 < 8) {
#pragma unroll
      for (int q4 = 0; q4 < 4; ++q4)
        kb[(jr + 1) & 1][q4] = *(const uint4*)(K0 + (size_t)((jr + 1) * 64 + 4 * (q4 >> 1)) * 512 + 32 * (q4 & 1));
    }
    float bias[8];
#pragma unroll
    for (int e = 0; e < 8; ++e) bias[e] = rpb[jr * 31 + min(max(d0 + 4 * (e >> 2) + (e & 3), -15), 15) + 15];
#pragma unroll
    for (int tt = 0; tt < 2; ++tt) {
      f32x4 a = {0.f, 0.f, 0.f, 0.f};
      a = MFMA(as_bf8(kb[jr & 1][2 * tt]), qf[0], a);
      a = MFMA(as_bf8(kb[jr & 1][2 * tt + 1]), qf[1], a);
#pragma unroll
      for (int rr = 0; rr < 4; ++rr) a[rr] = ((unsigned)(w0 + 4 * tt + rr) < 16u) ? (a[rr] + bias[tt * 4 + rr] * LOG2E) : -INFINITY;
      s[jr * 2 + tt] = a;
    }
  }
  float mx = -INFINITY;
#pragma unroll
  for (int u = 0; u < 16; ++u) mx = fmaxf(mx, fmaxf(fmaxf(s[u][0], s[u][1]), fmaxf(s[u][2], s[u][3])));
  mx = xor16_32_max(mx);
  uint4 vbuf[3][4];
#define NA_VLOAD(jr, dst) do { \
    _Pragma("unroll") for (int i2 = 0; i2 < 4; ++i2) dst[i2] = *(const uint4*)(VT + (size_t)(16 * i2) * 2048 + (jr) * 64); } while (0)
  NA_VLOAD(0, vbuf[0]);
  NA_VLOAD(1, vbuf[1]);
  float sum = 0.f;
#pragma unroll
  for (int u = 0; u < 16; ++u)
#pragma unroll
    for (int rr = 0; rr < 4; ++rr) { float pv = ex2(s[u][rr] - mx); s[u][rr] = pv; sum += pv; }
  sum = xor16_32_sum(sum);
  f32x4 o[4];
#pragma unroll
  for (int i2 = 0; i2 < 4; ++i2) o[i2] = (f32x4){0.f, 0.f, 0.f, 0.f};
#pragma unroll
  for (int jr = 0; jr < 8; ++jr) {
    if (jr + 2 < 8) NA_VLOAD(jr + 2, vbuf[(jr + 2) % 3]);
    bf16x8 pf = cat_bf8(pack4(s[2 * jr]), pack4(s[2 * jr + 1]));
#pragma unroll
    for (int i2 = 0; i2 < 4; ++i2) o[i2] = MFMA(as_bf8(vbuf[jr % 3][i2]), pf, o[i2]);
  }
#undef NA_VLOAD
  const float inv = 1.f / sum;
#pragma unroll
  for (int i2 = 0; i2 < 4; ++i2) *(uint2*)(mix + (size_t)tq * 1536 + h * 64 + 16 * i2 + 4 * quad) = pack4(o[i2] * inv);
}

__device__ void conv_tile(const Params& p, int tile) {
  const int tb = tile >> 2, cb = tile & 3;
  const int ch = cb * 512 + 2 * vtid();
  const int b = tb >> 5, s0 = (tb & 31) * 64;
  float w[4][2], bias[2];
#pragma unroll
  for (int k = 0; k < 4; ++k) { const float2 t = *(const float2*)(p.conv_w + k * 2048 + ch); w[k][0] = t.x; w[k][1] = t.y; }
  { const float2 t = *(const float2*)(p.conv_b + ch); bias[0] = t.x; bias[1] = t.y; }
  const u16* src = (const u16*)(p.ws + O_XBC) + (size_t)(b * 2048) * 2048 + ch;
  unsigned um2 = (s0 >= 2) ? *(const unsigned*)(src + (size_t)(s0 - 2) * 2048) : 0u;
  unsigned um1 = (s0 >= 1) ? *(const unsigned*)(src + (size_t)(s0 - 1) * 2048) : 0u;
  unsigned u0 = *(const unsigned*)(src + (size_t)s0 * 2048);
  u16* XT = (u16*)p.out + 16 * MIB;
  for (int sg = 0; sg < 8; ++sg) {
    unsigned nx[8];
#pragma unroll
    for (int e = 0; e < 8; ++e) { const int s = s0 + sg * 8 + e; nx[e] = (s + 1 < 2048) ? *(const unsigned*)(src + (size_t)(s + 1) * 2048) : 0u; }
    float y[2][8];
#pragma unroll
    for (int e = 0; e < 8; ++e) {
      const unsigned up1 = nx[e];
      y[0][e] = silu(w[0][0] * bflo(um2) + w[1][0] * bflo(um1) + w[2][0] * bflo(u0) + w[3][0] * bflo(up1) + bias[0]);
      y[1][e] = silu(w[0][1] * bfhi(um2) + w[1][1] * bfhi(um1) + w[2][1] * bfhi(u0) + w[3][1] * bfhi(up1) + bias[1]);
      um2 = um1; um1 = u0; u0 = up1;
    }
    const int sb = s0 + sg * 8;
    if (cb < 3) {
      u16* dstT = (cb < 2) ? XT + (size_t)(b * 1024 + ch) * 2048 + sb : (u16*)(p.ws + O_BT) + (size_t)(b * 512 + (ch - 1024)) * 2048 + sb;
#pragma unroll
      for (int c2 = 0; c2 < 2; ++c2)
        *(uint4*)(dstT + (size_t)c2 * 2048) = make_uint4(pack2(y[c2][0], y[c2][1]), pack2(y[c2][2], y[c2][3]), pack2(y[c2][4], y[c2][5]), pack2(y[c2][6], y[c2][7]));
    }
    if (cb >= 2) {
      u16* nat = (cb == 2) ? (u16*)(p.ws + O_BN) + (size_t)(b * 2048 + sb) * 512 + (ch - 1024)
                           : (u16*)(p.ws + O_CN) + (size_t)(b * 2048 + sb) * 512 + (ch - 1536);
#pragma unroll
      for (int e = 0; e < 8; ++e) *(unsigned*)(nat + e * 512) = pack2(y[0][e], y[1][e]);
    }
  }
}

__device__ void scan_item8(const Params& p, char* smem, int item) {
  const int tid = otid(), lane = tid & 63, wave = __builtin_amdgcn_readfirstlane(tid >> 6), l15 = lane & 15, quad = lane >> 4;
  const int dir = item & 1, h = (item >> 1) & 15, b = item >> 5, g = h >> 2;
  const float Ah = -__expf(p.A_log[dir * 16 + h]) * LOG2E;
  PG8_LAS float* wall = (PG8_LAS float*)((PG8_LAS unsigned char*)smem + 65536);
  PG8_LAS float* cdall = wall + 2048;
  const float* dtb = (const float*)(p.ws + O_DTB);
#pragma unroll
  for (int cc = 0; cc < 2; ++cc) {
    const int c = 2 * wave + cc;
    const int tokb = b * 2048 + c * 128;
    const float d0 = dtb[(size_t)(tokb + 2 * lane) * 32 + dir * 16 + h];
    const float d1 = dtb[(size_t)(tokb + 2 * lane + 1) * 32 + dir * 16 + h];
    const float a0 = d0 * Ah, a1 = d1 * Ah, ps = a0 + a1;
    float incl = ps;
#pragma unroll
    for (int o = 1; o < 64; o <<= 1) { float tv = __shfl_up(incl, o); if (lane >= o) incl += tv; }
    const float total = __shfl(incl, 63);
    const float excl = incl - ps;
    float w0, w1;
    if (dir == 0) { w0 = ex2(total - (excl + a0)) * d0; w1 = ex2(total - incl) * d1; }
    else { w0 = ex2(excl) * d0; w1 = ex2(excl + a0) * d1; }
    wall[c * 128 + 2 * lane] = w0; wall[c * 128 + 2 * lane + 1] = w1;
    if (lane == 0) cdall[c] = ex2(total);
  }
  __syncthreads();
  const int drow = 8 * wave + (lane >> 4);
  const u16* XTg = (const u16*)p.out + 16 * MIB + (size_t)(b * 1024 + h * 64) * 2048;
  const char* xsrc0 = (const char*)(XTg + (size_t)drow * 2048) + (((lane & 15) ^ (drow & 15)) << 4);
  const char* xsrc1 = (const char*)(XTg + (size_t)(drow + 4) * 2048) + (((lane & 15) ^ ((drow + 4) & 15)) << 4);
  PG8_LAS unsigned char* lds = (PG8_LAS unsigned char*)smem;
  const u16* BT = (const u16*)(p.ws + O_BT) + (size_t)(b * 512 + g * 128 + 16 * wave + l15) * 2048 + 8 * quad;
  u16* HP = (u16*)(p.ws + O_HPREV);
  f32x4 acc[4];
#pragma unroll
  for (int j = 0; j < 4; ++j) acc[j] = (f32x4){0.f, 0.f, 0.f, 0.f};
  u32x4v bA[4], bB[4], bC[4], bD[4];
#define SC_ISSUE(Bf, st, c) do { \
    __builtin_amdgcn_global_load_lds((const unsigned*)(xsrc0 + (c) * 256), (PG8_LAS unsigned*)(lds + (st) * 16384 + wave * 2048), 16, 0, 0); \
    __builtin_amdgcn_global_load_lds((const unsigned*)(xsrc1 + (c) * 256), (PG8_LAS unsigned*)(lds + (st) * 16384 + wave * 2048 + 1024), 16, 0, 0); \
    { const u16* _bp = BT + (c) * 128; \
      asm volatile("global_load_dwordx4 %0, %4, off\n\tglobal_load_dwordx4 %1, %4, off offset:64\n\tglobal_load_dwordx4 %2, %4, off offset:128\n\tglobal_load_dwordx4 %3, %4, off offset:192" \
                   : "=&v"(Bf[0]), "=&v"(Bf[1]), "=&v"(Bf[2]), "=&v"(Bf[3]) : "v"(_bp) : "memory"); } } while (0)
#define SC_STEP(Bf, st, c) do { \
    u16* hp = HP + ((size_t)(((b * 16 + (c)) * 16 + h) * 2 + dir) << 13); \
    _Pragma("unroll") for (int j = 0; j < 4; ++j) *(uint2*)(hp + (16 * j + l15) * 128 + 16 * wave + 4 * quad) = pack4(acc[j]); \
    const float cd = cdall[(c)]; \
    _Pragma("unroll") for (int j = 0; j < 4; ++j) acc[j] *= cd; \
    _Pragma("unroll") for (int ks = 0; ks < 4; ++ks) { \
      const f32x4 wav = *(const PG8_LAS f32x4*)(wall + (c) * 128 + 32 * ks + 8 * quad); \
      const f32x4 wbv = *(const PG8_LAS f32x4*)(wall + (c) * 128 + 32 * ks + 8 * quad + 4); \
      const float4 wa = make_float4(wav[0], wav[1], wav[2], wav[3]), wb = make_float4(wbv[0], wbv[1], wbv[2], wbv[3]); \
      _Pragma("unroll") for (int j = 0; j < 4; ++j) { \
        const u32x4v rawv = *(const PG8_LAS u32x4v*)(lds + (st) * 16384 + (16 * j + l15) * 256 + (((4 * ks + quad) ^ l15) << 4)); \
        const uint4 raw = make_uint4(rawv[0], rawv[1], rawv[2], rawv[3]); uint4 sc; \
        sc.x = pack2(bflo(raw.x) * wa.x, bfhi(raw.x) * wa.y); sc.y = pack2(bflo(raw.y) * wa.z, bfhi(raw.y) * wa.w); \
        sc.z = pack2(bflo(raw.z) * wb.x, bfhi(raw.z) * wb.y); sc.w = pack2(bflo(raw.w) * wb.z, bfhi(raw.w) * wb.w); \
        acc[j] = MFMA(__builtin_bit_cast(bf16x8, Bf[ks]), as_bf8(sc), acc[j]); } } } while (0)
#define SC_CH(s) (dir ? 15 - (s) : (s))
  SC_ISSUE(bA, 0, SC_CH(0)); SC_ISSUE(bB, 1, SC_CH(1)); SC_ISSUE(bC, 2, SC_CH(2));
#define SC_BAR() do { asm volatile("" ::: "memory"); __builtin_amdgcn_s_barrier(); asm volatile("" ::: "memory"); } while (0)
#define SC_WAIT(nlast, Bf) do { if (s4 == 12) asm volatile("s_waitcnt vmcnt(" #nlast ")" : "+v"(Bf[0]), "+v"(Bf[1]), "+v"(Bf[2]), "+v"(Bf[3]) :: "memory"); \
    else asm volatile("s_waitcnt vmcnt(18)" : "+v"(Bf[0]), "+v"(Bf[1]), "+v"(Bf[2]), "+v"(Bf[3]) :: "memory"); } while (0)
  for (int s4 = 0; s4 < 16; s4 += 4) {
    SC_ISSUE(bD, 3, SC_CH(s4 + 3));
    SC_WAIT(18, bA); SC_BAR();
    SC_STEP(bA, 0, SC_CH(s4));
    SC_BAR();
    if (s4 + 4 < 16) SC_ISSUE(bA, 0, SC_CH(s4 + 4));
    SC_WAIT(12, bB); SC_BAR();
    SC_STEP(bB, 1, SC_CH(s4 + 1));
    SC_BAR();
    if (s4 + 5 < 16) SC_ISSUE(bB, 1, SC_CH(s4 + 5));
    SC_WAIT(6, bC); SC_BAR();
    SC_STEP(bC, 2, SC_CH(s4 + 2));
    SC_BAR();
    if (s4 + 6 < 16) SC_ISSUE(bC, 2, SC_CH(s4 + 6));
    SC_WAIT(0, bD); SC_BAR();
    SC_STEP(bD, 3, SC_CH(s4 + 3));
    SC_BAR();
  }
#undef SC_BAR
#undef SC_WAIT
#undef SC_ISSUE
#undef SC_STEP
#undef SC_CH
  asm volatile("s_waitcnt vmcnt(0)" ::: "memory");
  __syncthreads();
}

__device__ void ssd_out_tile(const Params& p, char* smem, int tile) {
  const int tid = vtid(), lane = tid & 63, wave = tid >> 6, l15 = lane & 15, quad = lane >> 4;
  const int g = tile & 3, c = (tile >> 2) & 15, b = tile >> 6;
  const int hh = g * 4 + wave;
  u16* Gs = (u16*)smem;
  float* wv = (float*)(smem + 34816) + wave * 512;
  float* red = (float*)(smem + 34816 + 8192);
  const int tok0 = b * 2048 + c * 128;
  const u16* Cn = (const u16*)(p.ws + O_CN) + (size_t)tok0 * 512 + g * 128;
  const u16* Bn = (const u16*)(p.ws + O_BN) + (size_t)tok0 * 512 + g * 128;
  const float* dtb = (const float*)(p.ws + O_DTB);
  {
    f32x4 ga[8][2];
#pragma unroll
    for (int i = 0; i < 8; ++i) { ga[i][0] = (f32x4){0.f, 0.f, 0.f, 0.f}; ga[i][1] = ga[i][0]; }
#pragma unroll 2
    for (int ks = 0; ks < 4; ++ks) {
      bf16x8 cf[2];
#pragma unroll
      for (int jj = 0; jj < 2; ++jj)
        cf[jj] = as_bf8(*(const uint4*)(Cn + (size_t)(16 * (2 * wave + jj) + l15) * 512 + 32 * ks + 8 * quad));
#pragma unroll
      for (int i = 0; i < 8; ++i) {
        bf16x8 bf = as_bf8(*(const uint4*)(Bn + (size_t)(16 * i + l15) * 512 + 32 * ks + 8 * quad));
        ga[i][0] = MFMA(bf, cf[0], ga[i][0]);
        ga[i][1] = MFMA(bf, cf[1], ga[i][1]);
      }
    }
#pragma unroll
    for (int i = 0; i < 8; ++i)
#pragma unroll
      for (int jj = 0; jj < 2; ++jj)
        *(uint2*)(Gs + (16 * (2 * wave + jj) + l15) * 136 + 16 * i + 4 * quad) = pack4(ga[i][jj]);
  }
  {
    const float Af = -__expf(p.A_log[hh]) * LOG2E, Ab = -__expf(p.A_log[16 + hh]) * LOG2E;
    const float d0f = dtb[(size_t)(tok0 + 2 * lane) * 32 + hh], d1f = dtb[(size_t)(tok0 + 2 * lane + 1) * 32 + hh];
    const float d0b = dtb[(size_t)(tok0 + 2 * lane) * 32 + 16 + hh], d1b = dtb[(size_t)(tok0 + 2 * lane + 1) * 32 + 16 + hh];
    const float a0 = d0f * Af, a1 = d1f * Af, c0 = d0b * Ab, c1 = d1b * Ab;
    float inf_ = a0 + a1, inb = c0 + c1;
#pragma unroll
    for (int o = 1; o < 64; o <<= 1) {
      float t1 = __shfl_up(inf_, o), t2 = __shfl_up(inb, o);
      if (lane >= o) { inf_ += t1; inb += t2; }
    }
    const float totb = __shfl(inb, 63);
    const float exf = inf_ - (a0 + a1), exb = inb - (c0 + c1);
    *(float2*)(wv + 2 * lane) = make_float2(exf + a0, inf_);
    *(float2*)(wv + 128 + 2 * lane) = make_float2(totb - exb, totb - (exb + c0));
    *(float2*)(wv + 256 + 2 * lane) = make_float2(d0f, d1f);
    *(float2*)(wv + 384 + 2 * lane) = make_float2(d0b, d1b);
  }
  __syncthreads();
  const float Dh = p.Dskip[hh];
  const u16* XT = (const u16*)p.out + 16 * MIB + (size_t)(b * 1024 + hh * 64) * 2048 + c * 128;
  const u16* hf = (const u16*)(p.ws + O_HPREV) + ((size_t)(((b * 16 + c) * 16 + hh) * 2) << 13);
  const u16* hb = hf + 8192;
  const u16* Z = (const u16*)p.out;
  u16* mix = (u16*)(p.ws + O_MIX);
  #pragma unroll 1
  for (int jh = 0; jh < 2; ++jh) {
    f32x4 y[4][4];
    {
      float efv[4], ebv[4];
#pragma unroll
      for (int j = 0; j < 4; ++j) {
        const int l = 64 * jh + 16 * j + l15;
        efv[j] = ex2(wv[l]); ebv[j] = ex2(wv[128 + l]);
      }
#pragma unroll
      for (int i = 0; i < 4; ++i)
#pragma unroll
        for (int j = 0; j < 4; ++j) y[i][j] = (f32x4){0.f, 0.f, 0.f, 0.f};
#pragma unroll 2
      for (int ks = 0; ks < 4; ++ks) {
        bf16x8 cF[4], cB[4];
#pragma unroll
        for (int j = 0; j < 4; ++j) {
          const uint4 raw = *(const uint4*)(Cn + (size_t)(64 * jh + 16 * j + l15) * 512 + 32 * ks + 8 * quad);
          float f[8];
          unpack8(raw, f);
          cF[j] = as_bf8(make_uint4(pack2(f[0] * efv[j], f[1] * efv[j]), pack2(f[2] * efv[j], f[3] * efv[j]), pack2(f[4] * efv[j], f[5] * efv[j]), pack2(f[6] * efv[j], f[7] * efv[j])));
          cB[j] = as_bf8(make_uint4(pack2(f[0] * ebv[j], f[1] * ebv[j]), pack2(f[2] * ebv[j], f[3] * ebv[j]), pack2(f[4] * ebv[j], f[5] * ebv[j]), pack2(f[6] * ebv[j], f[7] * ebv[j])));
        }
#pragma unroll
        for (int i = 0; i < 4; ++i) {
          bf16x8 f1 = as_bf8(*(const uint4*)(hf + (16 * i + l15) * 128 + 32 * ks + 8 * quad));
          bf16x8 f2 = as_bf8(*(const uint4*)(hb + (16 * i + l15) * 128 + 32 * ks + 8 * quad));
#pragma unroll
          for (int j = 0; j < 4; ++j) { y[i][j] = MFMA(f1, cF[j], y[i][j]); y[i][j] = MFMA(f2, cB[j], y[i][j]); }
        }
      }
    }
#pragma unroll 2
    for (int ks = 0; ks < 4; ++ks) {
      const int sb = 32 * ks + 8 * quad;
      float afs[8], rbs[8], d0s[8], d1s[8];
      *(float4*)(afs) = *(const float4*)(wv + sb); *(float4*)(afs + 4) = *(const float4*)(wv + sb + 4);
      *(float4*)(rbs) = *(const float4*)(wv + 128 + sb); *(float4*)(rbs + 4) = *(const float4*)(wv + 128 + sb + 4);
      *(float4*)(d0s) = *(const float4*)(wv + 256 + sb); *(float4*)(d0s + 4) = *(const float4*)(wv + 256 + sb + 4);
      *(float4*)(d1s) = *(const float4*)(wv + 384 + sb); *(float4*)(d1s + 4) = *(const float4*)(wv + 384 + sb + 4);
      bf16x8 xf[4];
#pragma unroll
      for (int i = 0; i < 4; ++i) xf[i] = as_bf8(*(const uint4*)(XT + (size_t)(16 * i + l15) * 2048 + sb));
#pragma unroll
      for (int j = 0; j < 4; ++j) {
        const int l = 64 * jh + 16 * j + l15;
        const float afl = wv[l], rbl = wv[128 + l];
        float gv[8], m[8];
        unpack8(*(const uint4*)(Gs + l * 136 + sb), gv);
#pragma unroll
        for (int e = 0; e < 8; ++e) {
          const int s = sb + e;
          float ff = (s <= l) ? ex2(afl - afs[e]) * d0s[e] : 0.f;
          float fb = (s >= l) ? ex2(rbl - rbs[e]) * d1s[e] : 0.f;
          m[e] = gv[e] * (ff + fb) + ((s == l) ? Dh : 0.f);
        }
        bf16x8 mf = as_bf8(make_uint4(pack2(m[0], m[1]), pack2(m[2], m[3]), pack2(m[4], m[5]), pack2(m[6], m[7])));
#pragma unroll
        for (int i = 0; i < 4; ++i) y[i][j] = MFMA(xf[i], mf, y[i][j]);
      }
    }
#pragma unroll
    for (int j = 0; j < 4; ++j) {
      const int tok = tok0 + 64 * jh + 16 * j + l15;
      float part = 0.f;
#pragma unroll
      for (int i = 0; i < 4; ++i) {
        uint2 zr = *(const uint2*)(Z + (size_t)tok * 1024 + hh * 64 + 16 * i + 4 * quad);
        float z0 = bflo(zr.x), z1 = bfhi(zr.x), z2 = bflo(zr.y), z3 = bfhi(zr.y);
        y[i][j][0] *= silu(z0); y[i][j][1] *= silu(z1); y[i][j][2] *= silu(z2); y[i][j][3] *= silu(z3);
        part += y[i][j][0] * y[i][j][0] + y[i][j][1] * y[i][j][1] + y[i][j][2] * y[i][j][2] + y[i][j][3] * y[i][j][3];
      }
      part = xor16_32_sum(part);
      if (quad == 0) red[wave * 64 + 16 * j + l15] = part;
    }
    __syncthreads();
#pragma unroll
    for (int j = 0; j < 4; ++j) {
      const int tok = tok0 + 64 * jh + 16 * j + l15;
      const int q = 16 * j + l15;
      const float tot = red[q] + red[64 + q] + red[128 + q] + red[192 + q];
      const float rs = rsqrtf(tot * (1.f / 256.f) + EPS);
#pragma unroll
      for (int i = 0; i < 4; ++i) {
        float4 g4 = *(const float4*)(p.out_norm + hh * 64 + 16 * i + 4 * quad);
        f32x4 o;
        o[0] = y[i][j][0] * rs * g4.x; o[1] = y[i][j][1] * rs * g4.y; o[2] = y[i][j][2] * rs * g4.z; o[3] = y[i][j][3] * rs * g4.w;
        *(uint2*)(mix + (size_t)tok * 1536 + 512 + hh * 64 + 16 * i + 4 * quad) = pack4(o);
      }
    }
    __syncthreads();
  }
}

__device__ void gqa_tile8(const Params& p, char* smem, int tile) {
  const int tid = otid(), lane = tid & 63, wave = __builtin_amdgcn_readfirstlane(tid >> 6), l15 = lane & 15, quad = lane >> 4;
  const int rep = tile & 3, qb = (tile >> 2) & 3, kvh = (tile >> 4) & 3, b = tile >> 6;
  const int h = kvh * 4 + rep;
  const u16* Q1 = (const u16*)(p.ws + O_Q1);
  const u16* K1 = (const u16*)(p.ws + O_K1) + (size_t)(b * 2048) * 256 + kvh * 64;
  const u16* VT = (const u16*)(p.ws + O_VT1) + (size_t)((b * 4 + kvh) * 64) * 2048;
  u16* AO = (u16*)(p.ws + O_AO);
  const int tq0 = b * 2048 + qb * 512 + 64 * wave;
  bf16x8 qf[4][2];
#pragma unroll
  for (int j = 0; j < 4; ++j)
#pragma unroll
    for (int ks = 0; ks < 2; ++ks)
      qf[j][ks] = as_bf8(*(const uint4*)(Q1 + (size_t)(tq0 + 16 * j + l15) * 1024 + h * 64 + 32 * ks + 8 * quad));
  PG8_LAS unsigned char* lds = (PG8_LAS unsigned char*)smem;
  const int kr0 = 16 * wave + (lane >> 3), kr1 = kr0 + 8;
  const char* ksrc0 = (const char*)(K1 + (size_t)kr0 * 256) + ((((lane & 7) ^ ((kr0 >> 1) & 7))) << 4);
  const char* ksrc1 = (const char*)(K1 + (size_t)kr1 * 256) + ((((lane & 7) ^ ((kr1 >> 1) & 7))) << 4);
  const int vr0 = 8 * wave + (lane >> 4), vr1 = vr0 + 4;
  const char* vsrc0 = (const char*)(VT + (size_t)vr0 * 2048) + ((((lane & 15) ^ (vr0 & 15))) << 4);
  const char* vsrc1 = (const char*)(VT + (size_t)vr1 * 2048) + ((((lane & 15) ^ (vr1 & 15))) << 4);
  float shift;
  {
    float gq = fabsf(p.gqa_q_norm[lane]), gk = fabsf(p.gqa_k_norm[lane]);
#pragma unroll
    for (int o_ = 32; o_ >= 1; o_ >>= 1) { gq = fmaxf(gq, __shfl_xor(gq, o_)); gk = fmaxf(gk, __shfl_xor(gk, o_)); }
    shift = 8.f * gq * gk * LOG2E;
  }
  f32x4 o[4][4];
#pragma unroll
  for (int i = 0; i < 4; ++i)
#pragma unroll
    for (int j = 0; j < 4; ++j) o[i][j] = (f32x4){0.f, 0.f, 0.f, 0.f};
  f32x4 osum[4];
#pragma unroll
  for (int j = 0; j < 4; ++j) osum[j] = (f32x4){0.f, 0.f, 0.f, 0.f};
  const bf16x8 ones = {0x3F80, 0x3F80, 0x3F80, 0x3F80, 0x3F80, 0x3F80, 0x3F80, 0x3F80};
  const f32x4 sinit = {-shift, -shift, -shift, -shift};
#define GQ_ISSUE(t) do { const int _st = (t) & 3; \
    __builtin_amdgcn_global_load_lds((const unsigned*)(ksrc0 + (size_t)(t) * (128 * 512)), (PG8_LAS unsigned*)(lds + _st * 32768 + wave * 2048), 16, 0, 0); \
    __builtin_amdgcn_global_load_lds((const unsigned*)(ksrc1 + (size_t)(t) * (128 * 512)), (PG8_LAS unsigned*)(lds + _st * 32768 + wave * 2048 + 1024), 16, 0, 0); \
    __builtin_amdgcn_global_load_lds((const unsigned*)(vsrc0 + (t) * 256), (PG8_LAS unsigned*)(lds + _st * 32768 + 16384 + wave * 2048), 16, 0, 0); \
    __builtin_amdgcn_global_load_lds((const unsigned*)(vsrc1 + (t) * 256), (PG8_LAS unsigned*)(lds + _st * 32768 + 16384 + wave * 2048 + 1024), 16, 0, 0); } while (0)
#define GQ_BODY(st, hk, jb) do { \
    PG8_LAS const unsigned char* sK = lds + (st) * 32768; PG8_LAS const unsigned char* sV = sK + 16384; \
    f32x4 s[4][2]; \
    _Pragma("unroll") for (int i = 0; i < 4; ++i) { s[i][0] = sinit; s[i][1] = sinit; } \
    _Pragma("unroll") for (int ks = 0; ks < 2; ++ks) \
      _Pragma("unroll") for (int i = 0; i < 4; ++i) { \
        const int kr = 64 * (hk) + 16 * i + l15; \
        bf16x8 kf = *(PG8_LAS const bf16x8*)(sK + kr * 128 + (((4 * ks + quad) ^ ((kr >> 1) & 7)) << 4)); \
        s[i][0] = MFMA(kf, qf[(jb)][ks], s[i][0]); s[i][1] = MFMA(kf, qf[(jb) + 1][ks], s[i][1]); } \
    bf16x8 pf[2][2]; \
    _Pragma("unroll") for (int j = 0; j < 2; ++j) { \
      _Pragma("unroll") for (int i = 0; i < 4; ++i) \
        _Pragma("unroll") for (int r = 0; r < 4; ++r) s[i][j][r] = ex2(s[i][j][r]); \
      pf[j][0] = cat_bf8(pack4(s[0][j]), pack4(s[1][j])); pf[j][1] = cat_bf8(pack4(s[2][j]), pack4(s[3][j])); } \
    _Pragma("unroll") for (int ks2 = 0; ks2 < 2; ++ks2) \
      _Pragma("unroll") for (int i2 = 0; i2 < 4; ++i2) { \
        const int vd = 16 * i2 + l15; \
        bf16x8 vf = *(PG8_LAS const bf16x8*)(sV + vd * 256 + (((8 * (hk) + 4 * ks2 + quad) ^ (vd & 15)) << 4)); \
        o[i2][(jb)] = MFMA(vf, pf[0][ks2], o[i2][(jb)]); o[i2][(jb) + 1] = MFMA(vf, pf[1][ks2], o[i2][(jb) + 1]); } \
    _Pragma("unroll") for (int ks2 = 0; ks2 < 2; ++ks2) { osum[(jb)] = MFMA(ones, pf[0][ks2], osum[(jb)]); osum[(jb) + 1] = MFMA(ones, pf[1][ks2], osum[(jb) + 1]); } \
    __builtin_amdgcn_sched_barrier(0); \
  } while (0)
  __syncthreads();
  GQ_ISSUE(0); GQ_ISSUE(1);
  for (int kt = 0; kt < 16; ++kt) {
    if (kt + 2 < 16) GQ_ISSUE(kt + 2);
    if (kt < 14) asm volatile("s_waitcnt vmcnt(8)" ::: "memory");
    else if (kt == 14) asm volatile("s_waitcnt vmcnt(4)" ::: "memory");
    else asm volatile("s_waitcnt vmcnt(0)" ::: "memory");
    asm volatile("" ::: "memory"); __builtin_amdgcn_s_barrier(); asm volatile("" ::: "memory");
    const int st = kt & 3;
    GQ_BODY(st, 0, 0); GQ_BODY(st, 0, 2); GQ_BODY(st, 1, 0); GQ_BODY(st, 1, 2);
  }
#undef GQ_ISSUE
#undef GQ_BODY
#pragma unroll
  for (int j = 0; j < 4; ++j) {
    const float inv = 1.f / osum[j][0];
    const int tq = tq0 + 16 * j + l15;
#pragma unroll
    for (int i2 = 0; i2 < 4; ++i2) *(uint2*)(AO + (size_t)tq * 1024 + h * 64 + 16 * i2 + 4 * quad) = pack4(o[i2][j] * inv);
  }
}

#ifndef ONLY_PHASE
#define ONLY_PHASE -1
#endif
__device__ void run_phase(const Params& p, char* smem, int ph) {
  if (ONLY_PHASE >= 0 && ph != ONLY_PHASE) return;
  char* ws = p.ws;
  asm volatile("" : "+s"(ws));
  float* ssq = (float*)(ws + O_SSQ);
  u16* xb = (u16*)(ws + O_XB);
  const int half = __builtin_amdgcn_readfirstlane(threadIdx_x_raw() >> 8);
  char* sh = smem + half * 65536;
  const int G = gridDim.x, bid = blockIdx.x;
  const int vb = bid * 2 + half, nvb = G * 2;
  const bool is_gemm = (ph == 1) || (ph >= 5 && ph != 9);
  if (is_gemm) {
    const int nsub = (ph == 1 || ph == 8) ? 2 : 1;
    for (int sub = 0; sub < nsub; ++sub) {
      pg8::Gemm g{}; EpiAny E{}; E.ws = ws; E.zout = (u16*)p.out; E.perm = true; int c = bid;
      E.qn = (ph >= 8) ? p.gqa_q_norm : p.na_q_norm; E.kn = (ph >= 8) ? p.gqa_k_norm : p.na_k_norm;
      const bool l1 = ph >= 8;
      const u16* W13 = (const u16*)(ws + (l1 ? O_W13_1 : O_W13_0));
      const u16* W2 = (const u16*)(ws + (l1 ? O_W2_1 : O_W2_0));
      if (ph == 1 || ph == 8) {
        const float* sq = l1 ? ssq + 2 * T : nullptr;
        if (sub == 0) { g = pg8::Gemm{xb, (const u16*)(ws + (l1 ? O_WQKV1 : O_WIN0)), T, l1 ? 1280 : 4352, 1024}; E.kind = l1 ? EK_QK1 : EK_QK0; E.ssq_in = sq; }
        else { g = pg8::Gemm{(const u16*)(ws + (l1 ? O_WV1 : O_WV0)), xb, l1 ? 256 : 512, T, 1024}; E.kind = EK_VT; E.ssq_in = sq;
               E.o16 = (u16*)(ws + (l1 ? O_VT1 : O_VT0)); E.nh = l1 ? 4 : 8; c = (bid + G - 64) % G; }
      } else if (ph == 5 || ph == 10) {
        g = pg8::Gemm{(const u16*)(ws + (l1 ? O_AO : O_MIX)), (const u16*)(ws + (l1 ? O_WOUT1 : O_WOUT0)), T, 1024, l1 ? 1024 : 1536};
        E.kind = EK_RES; E.perm = false; E.res_in = l1 ? nullptr : p.x; E.res_out = nullptr; E.xb_out = xb; E.ssq_out = ssq + (l1 ? 3 * T : T);
      } else if (ph == 6 || ph == 11) {
        g = pg8::Gemm{xb, W13, T, 5632, 1024}; E.kind = EK_SWIGLU; E.ssq_in = ssq + (l1 ? 3 * T : T); E.o16 = (u16*)(ws + O_H);
      } else {
        g = pg8::Gemm{(const u16*)(ws + O_H), W2, T, 1024, 2816};
        E.kind = EK_RES; E.perm = false; E.res_in = nullptr; E.res_out = l1 ? p.out : nullptr; E.xb_out = xb; E.ssq_out = l1 ? nullptr : ssq + 2 * T;
      }
      pg8::StaticOrder S; S.init(g.M, g.N, G, c);
      pg8::gemm_phase(( PG8_LAS unsigned char*)smem, g, S, E);
      if (ph == 6 && G == 256 && bid >= 128) {
        const int tid = otid();
        phase_prep_l1(p, ws, (bid - 128) * 8 + (tid >> 6), 128 * 8, tid & 63);
      }
    }
    return;
  }
  switch (ph) {
    case 0: phase_prep(p); break;
    case 2: {
      PSUB(4) for (int t = vb; t < 2048; t += nvb) na_tile(p, t);
      PSUB(5) for (int t = vb; t < 1024; t += nvb) conv_tile(p, t);
      float* dtb = (float*)(ws + O_DTB);
      for (int idx = bid * 512 + otid(); idx < T * 32; idx += G * 512) {
        float v = dtb[idx] + p.dt_bias[idx & 31];
        dtb[idx] = (v > 20.f) ? v : log1pf(expf(v));
      }
    } break;
    case 3: {
      for (int t0 = 0; t0 < 256; t0 += G) {
        int item = min(t0 + bid, 255);
        if (G == 256) {
          const int xcd = bid & 7, j = bid >> 3, grp = xcd * 4 + (j >> 3), idx8 = j & 7;
          item = (idx8 & 1) + 2 * ((grp & 3) * 4 + (idx8 >> 1)) + 32 * (grp >> 2);
        }
        scan_item8(p, smem, item);
      }
      if (G != 256) { const int tid = otid(); phase_prep_l1(p, ws, bid * 8 + (tid >> 6), G * 8, tid & 63); }
    } break;
    case 4:
      for (int t0 = 0; t0 < 512; t0 += nvb) ssd_out_tile(p, sh, min(t0 + vb, 511));
      break;
    case 9:
      if (G == 256) {
        const int xcd = bid & 7, j = bid >> 3;
        for (int r = 0; r < 2; ++r) gqa_tile8(p, smem, (r * 16 + xcd * 2 + (j >> 4)) * 16 + (j & 15));
      } else {
        for (int t0 = 0; t0 < 512; t0 += G) gqa_tile8(p, smem, min(t0 + bid, 511));
      }
      break;
    default: break;
  }
}

#define XB_TMO      128
#define XB_XCNT(j)  (256  + 64 * (j))
#define XB_XSUB(j)  (1280 + 64 * (j))
#define XB_XGEN(j)  (2304 + 64 * (j))
#define XB_TOP      3328
#define XB_TOPGEN   3392
#define XCD_BAR_WORDS 3456
#define XB_SPIN_CAP (1u << 18)
#define LAS __attribute__((address_space(3)))
DI unsigned xb_ld(unsigned* p) { return __hip_atomic_load(p, __ATOMIC_RELAXED, __HIP_MEMORY_SCOPE_AGENT); }
DI unsigned xb_add(unsigned* p, unsigned v) { return __hip_atomic_fetch_add(p, v, __ATOMIC_RELAXED, __HIP_MEMORY_SCOPE_AGENT); }
DI unsigned xb_xcc_id() { return (unsigned)__builtin_amdgcn_s_getreg((3 << 11) | 20) & 0xFu; }
#define XB_SPIN(cond, bar) do { unsigned _sp = 0; while (cond) { __builtin_amdgcn_s_sleep(1); \
    if ((++_sp & 255u) == 0u) { if (xb_ld(&(bar)[XB_TMO])) break; if (_sp > XB_SPIN_CAP) { atomicAdd(&(bar)[XB_TMO], 1u); break; } } } } while (0)
struct XcdBarrier { unsigned* bar; unsigned x; volatile LAS unsigned* st; };
DI XcdBarrier xcd_barrier_post(unsigned* bar, volatile LAS unsigned* st) {
  XcdBarrier b; b.bar = bar; b.x = xb_xcc_id(); b.st = st;
  if (threadIdx_x_raw() == 0) (void)xb_add(&bar[XB_XCNT(b.x)], 1u);
  return b;
}
DI void xcd_barrier_complete(unsigned* bar, unsigned x, unsigned& nloc, unsigned& nx) {
  const unsigned G = gridDim.x * gridDim.y * gridDim.z;
  unsigned sum, cnt, mine, sp = 0u;
  for (;;) {
    sum = 0u; cnt = 0u; mine = 0u;
#pragma unroll
    for (unsigned j = 0; j < 16; ++j) { const unsigned c = xb_ld(&bar[XB_XCNT(j)]); sum += c; cnt += (c > 0u) ? 1u : 0u; mine = (j == x) ? c : mine; }
    if (sum == G) break;
    __builtin_amdgcn_s_sleep(1);
    if ((++sp & 255u) == 0u) { if (xb_ld(&bar[XB_TMO])) break; if (sp > XB_SPIN_CAP) { atomicAdd(&bar[XB_TMO], 1u); break; } }
  }
  nloc = mine > 0u ? mine : 1u; nx = cnt > 0u ? cnt : 1u;
}
DI void xcd_barrier(const XcdBarrier& b) {
  asm volatile("s_waitcnt vmcnt(0)" ::: "memory");
  __syncthreads();
  if (threadIdx_x_raw() == 0) {
    unsigned* bar = b.bar;
    asm volatile("" : "+s"(bar));
    __builtin_amdgcn_s_waitcnt(0);
    unsigned nloc = b.st[0], nx = b.st[1];
    if (nloc == 0u) { xcd_barrier_complete(bar, b.x, nloc, nx); b.st[0] = nloc; b.st[1] = nx; }
    const unsigned old = xb_add(&bar[XB_XSUB(b.x)], 1u);
    const unsigned gen = old / nloc;
    if (old + 1u == (gen + 1u) * nloc) {
      __builtin_amdgcn_fence(__ATOMIC_RELEASE, "agent");
      asm volatile("s_waitcnt vmcnt(0)" ::: "memory");
      const unsigned og = xb_add(&bar[XB_TOP], 1u);
      const unsigned tg = og / nx;
      if (og + 1u == (tg + 1u) * nx) xb_add(&bar[XB_TOPGEN], 1u);
      else XB_SPIN(xb_ld(&bar[XB_TOPGEN]) == tg, bar);
      __builtin_amdgcn_fence(__ATOMIC_ACQUIRE, "agent");
      xb_add(&bar[XB_XGEN(b.x)], 1u);
      asm volatile("s_waitcnt vmcnt(0)" ::: "memory");
    } else {
      XB_SPIN(xb_ld(&bar[XB_XGEN(b.x)]) == gen, bar);
      __builtin_amdgcn_fence(__ATOMIC_ACQUIRE, "agent");
      asm volatile("s_waitcnt vmcnt(0)" ::: "memory");
    }
  }
  __syncthreads();
}

__global__ void __launch_bounds__(512, 2) mega(Params p) {
  extern __shared__ __attribute__((aligned(16))) char smem[];
  __shared__ uint4 xb_words;
  cg::grid_group grid = cg::this_grid();
  if (threadIdx_x_raw() == 0) xb_words = make_uint4(0u, 0u, 0u, 0u);
  __syncthreads();
  XcdBarrier xb = xcd_barrier_post((unsigned*)(p.ws + O_BAR), (volatile LAS unsigned*)&xb_words);
  if (p.ph0 < 0) grid.sync();
  for (int ph = p.ph0; ph < p.ph1; ++ph) {
    int nrep = 1;
#if PROBE_REP_MASK
    if ((PROBE_REP_MASK >> ph) & 1) nrep = 2;
#endif
    for (int r = 0; r < nrep; ++r) {
      run_phase(p, smem, ph);
      if (r + 1 < nrep || ph + 1 < p.ph1) xcd_barrier(xb);
    }
  }
#if PROBE_EXTRA_SYNCS
  for (int i = 0; i < PROBE_EXTRA_SYNCS; ++i) xcd_barrier(xb);
#endif
}

extern "C" void kernel_launch(void* const* d_in, const int* in_sizes, int n_in, void* d_out, int out_size, void* d_ws,
                              size_t ws_size, hipStream_t stream) {
  static int grid_blocks = 0;
  if (!grid_blocks) {
    (void)hipFuncSetAttribute((const void*)mega, hipFuncAttributeMaxDynamicSharedMemorySize, SMEM_BYTES);
    int dev = 0, cus = 0, per_cu = 0;
    (void)hipGetDevice(&dev);
    (void)hipDeviceGetAttribute(&cus, hipDeviceAttributeMultiprocessorCount, dev);
    (void)hipOccupancyMaxActiveBlocksPerMultiprocessor(&per_cu, mega, 512, SMEM_BYTES);
    if (per_cu < 1) per_cu = 1;
    grid_blocks = cus;
  }
  Params p{};
  const float** pp = (const float**)&p;
  for (int i = 0; i < 21; ++i) pp[i] = (const float*)d_in[i];
  p.out = (float*)d_out;
  p.ws = (char*)d_ws;
  (void)hipMemsetAsync((char*)d_ws + O_BAR, 0, XCD_BAR_WORDS * 4, stream);
#if MULTI_LAUNCH
  for (int ph = 0; ph < NPHASE; ++ph) {
    p.ph0 = ph; p.ph1 = ph + 1;
    hipLaunchKernelGGL(mega, dim3(grid_blocks), dim3(512), SMEM_BYTES, stream, p);
  }
#else
  p.ph0 = 0; p.ph1 = NPHASE;
  void* args[] = {&p};
  hipError_t e = hipLaunchCooperativeKernel((const void*)mega, dim3(grid_blocks), dim3(512), args, SMEM_BYTES, stream);
  if (e != hipSuccess) fprintf(stderr, "cooperative launch failed: %s (grid %d)\n", hipGetErrorString(e), grid_blocks);
#endif
}
```

```cpp
#include <hip/hip_runtime.h>
#include <hip/hip_bf16.h>
#include <hip/hip_cooperative_groups.h>
#include <cstdio>
namespace cg = cooperative_groups;

#define PROBE_REP_MASK 0
#define PROBE_EXTRA_SYNCS 0
#define PROBE_SUB 0
#define PSUB(k) for (int _r = 0; _r < ((PROBE_SUB == (k)) ? 2 : 1); ++_r)
#ifndef MULTI_LAUNCH
#define MULTI_LAUNCH 0
#endif

typedef __attribute__((ext_vector_type(8))) short bf16x8;
typedef __attribute__((ext_vector_type(4))) float f32x4;
typedef __attribute__((ext_vector_type(2))) float f32x2;
typedef __attribute__((ext_vector_type(2))) __bf16 bf16v2;
typedef unsigned short u16;
typedef unsigned u32x4v __attribute__((ext_vector_type(4)));

#define DI __device__ __forceinline__
#define MFMA(a, b, c) __builtin_amdgcn_mfma_f32_16x16x32_bf16((a), (b), (c), 0, 0, 0)

constexpr int T = 16384;
constexpr float EPS = 1e-6f;
constexpr float LOG2E = 1.4426950408889634f;
constexpr int NPHASE = 13;
constexpr int SMEM_BYTES = 131072 + 8192;

constexpr size_t MIB = 1u << 20;
constexpr size_t O_WIN0 = 0;
constexpr size_t O_WV0 = O_WIN0 + 4352ull * 1024 * 2;
constexpr size_t O_WOUT0 = O_WV0 + 512ull * 1024 * 2;
constexpr size_t O_W13_0 = O_WOUT0 + 1024ull * 1536 * 2;
constexpr size_t O_W2_0 = O_W13_0 + 5632ull * 1024 * 2;
constexpr size_t O_ROPE = 31 * MIB;
constexpr size_t O_DTB = O_ROPE + 524288;
constexpr size_t O_SSQ = O_DTB + 2097152;
constexpr size_t O_BAR = O_SSQ + 262144;
constexpr size_t O_XB = 34 * MIB;
constexpr size_t O_BN = O_XB;
constexpr size_t O_BT = O_XB + 16 * MIB;
constexpr size_t O_Q0 = 66 * MIB;
constexpr size_t O_K0 = 82 * MIB;
constexpr size_t O_VT0 = 98 * MIB;
constexpr size_t O_WQKV1 = 66 * MIB;
constexpr size_t O_WV1 = O_WQKV1 + 1280ull * 1024 * 2;
constexpr size_t O_WOUT1 = O_WV1 + 256ull * 1024 * 2;
constexpr size_t O_W13_1 = O_WOUT1 + 1024ull * 1024 * 2;
constexpr size_t O_W2_1 = O_W13_1 + 5632ull * 1024 * 2;
constexpr size_t O_BIG = 114 * MIB;
constexpr size_t O_XBC = O_BIG;
constexpr size_t O_HPREV = O_BIG;
constexpr size_t O_CN = O_BIG + 64 * MIB;
constexpr size_t O_MIX = O_BIG + 80 * MIB;
constexpr size_t O_H = O_BIG;
constexpr size_t O_Q1 = O_BIG;
constexpr size_t O_K1 = O_BIG + 32 * MIB;
constexpr size_t O_VT1 = O_BIG + 40 * MIB;
constexpr size_t O_AO = O_BIG + 48 * MIB;

struct Params {
  const float *x, *even_mix_norm, *even_w_in, *na_q_norm, *na_k_norm, *na_rel_bias, *conv_w, *conv_b, *dt_bias, *A_log,
      *Dskip, *out_norm, *even_w_out, *odd_mix_norm, *odd_w_qkv, *gqa_q_norm, *gqa_k_norm, *odd_w_out, *ffn_norm,
      *ffn_w13, *ffn_w2;
  float* out;
  char* ws;
  int ph0, ph1;
};

__device__ __forceinline__ int threadIdx_x_raw() { return (int)__builtin_amdgcn_workitem_id_x(); }
DI unsigned pack2(float a, float b) {
  f32x2 v = {a, b};
  bf16v2 r = __builtin_convertvector(v, bf16v2);
  return __builtin_bit_cast(unsigned, r);
}
DI uint2 pack4(f32x4 v) { return make_uint2(pack2(v[0], v[1]), pack2(v[2], v[3])); }
DI u16 f2bf(float a) { return (u16)(pack2(a, 0.f) & 0xffffu); }
DI float bflo(unsigned u) { return __uint_as_float(u << 16); }
DI float bfhi(unsigned u) { return __uint_as_float(u & 0xffff0000u); }
DI float bf2f(u16 h) { return __uint_as_float(((unsigned)h) << 16); }
DI bf16x8 as_bf8(uint4 v) { return __builtin_bit_cast(bf16x8, v); }
DI bf16x8 cat_bf8(uint2 a, uint2 b) { return as_bf8(make_uint4(a.x, a.y, b.x, b.y)); }
DI int vtid() { int t = threadIdx_x_raw() & 255; asm volatile("" : "+v"(t)); return t; }
DI int otid() { int t = threadIdx_x_raw(); asm volatile("" : "+v"(t)); return t; }
DI float silu(float x) { return x * __builtin_amdgcn_rcpf(1.f + __builtin_amdgcn_exp2f(-1.4426950408889634f * x)); }
DI float ex2(float x) { return __builtin_amdgcn_exp2f(x); }
DI float xor16_32_sum(float v) { v += __shfl_xor(v, 16); v += __shfl_xor(v, 32); return v; }
DI float xor16_32_max(float v) { v = fmaxf(v, __shfl_xor(v, 16)); v = fmaxf(v, __shfl_xor(v, 32)); return v; }
DI void wave_sync_lds() { __builtin_amdgcn_fence(__ATOMIC_ACQ_REL, "wavefront"); __builtin_amdgcn_wave_barrier(); }
DI void unpack8(uint4 u, float* f) {
  f[0] = bflo(u.x); f[1] = bfhi(u.x); f[2] = bflo(u.y); f[3] = bfhi(u.y);
  f[4] = bflo(u.z); f[5] = bfhi(u.z); f[6] = bflo(u.w); f[7] = bfhi(u.w);
}

struct WDesc { const float* W; int ldn, K, rows; u16* dst; const float* gain; int mode, coloff; };
DI int wt_srccol(int mode, int R, int coloff) {
  if (mode == 0) return coloff + R;
  const int pn = R >> 8, c = R & 255, bj = c >> 7, j = c & 127;
  if (mode == 1) return bj * 2816 + pn * 128 + j;
  const int wc = j >> 5, e = j & 31;
  if (mode == 2) {
    if (pn < 4) return (pn >> 1) * 512 + ((pn & 1) * 4 + wc) * 64 + bj * 32 + e;
    if (pn < 8) return 1536 + (R - 1024);
    if (pn < 16) return 2560 + (R - 2048);
    return (R - 4096 < 32) ? 4608 + (R - 4096) : -1;
  }
  if (pn < 4) return (pn * 4 + wc) * 64 + bj * 32 + e;
  return 1024 + wc * 64 + bj * 32 + e;
}
__device__ void wt_item(const WDesc& d, int item, int lane) {
  const int nr = d.rows >> 6, nn = item % nr, kk = item / nr;
  const int R = nn * 64 + lane;
  const int sc = wt_srccol(d.mode, R, d.coloff);
  typedef __attribute__((address_space(1))) const float gfloat_c;
  typedef __attribute__((address_space(1))) u32x4v gu32x4;
  gfloat_c* src = (gfloat_c*)(d.W + (sc >= 0 ? sc : 0));
  gfloat_c* gain = (gfloat_c*)d.gain;
  u16* dst = d.dst + (size_t)R * d.K + kk * 64;
#pragma unroll 2
  for (int k8 = 0; k8 < 8; ++k8) {
    float v[8];
#pragma unroll
    for (int e = 0; e < 8; ++e) {
      const int k = kk * 64 + k8 * 8 + e;
      float x = src[(size_t)k * d.ldn];
      if (d.gain) x *= gain[k];
      v[e] = (sc >= 0) ? x : 0.f;
    }
    const u32x4v pk = {pack2(v[0], v[1]), pack2(v[2], v[3]), pack2(v[4], v[5]), pack2(v[6], v[7])};
    *(gu32x4*)(dst + k8 * 8) = pk;
  }
}
DI WDesc wt_desc(const Params& p, char* ws, int set, int i) {
  if (set == 0) {
    switch (i) {
      case 0: return WDesc{p.even_w_in, 4640, 1024, 4352, (u16*)(ws + O_WIN0), p.even_mix_norm, 2, 0};
      case 1: return WDesc{p.even_w_in, 4640, 1024, 512, (u16*)(ws + O_WV0), p.even_mix_norm, 0, 1024};
      case 2: return WDesc{p.even_w_out, 1024, 1536, 1024, (u16*)(ws + O_WOUT0), nullptr, 0, 0};
      case 3: return WDesc{p.ffn_w13, 5632, 1024, 5632, (u16*)(ws + O_W13_0), p.ffn_norm, 1, 0};
      default: return WDesc{p.ffn_w2, 1024, 2816, 1024, (u16*)(ws + O_W2_0), nullptr, 0, 0};
    }
  }
  switch (i) {
    case 0: return WDesc{p.odd_w_qkv, 1536, 1024, 1280, (u16*)(ws + O_WQKV1), p.odd_mix_norm, 3, 0};
    case 1: return WDesc{p.odd_w_qkv, 1536, 1024, 256, (u16*)(ws + O_WV1), p.odd_mix_norm, 0, 1280};
    case 2: return WDesc{p.odd_w_out, 1024, 1024, 1024, (u16*)(ws + O_WOUT1), nullptr, 0, 0};
    case 3: return WDesc{p.ffn_w13 + (size_t)1024 * 5632, 5632, 1024, 5632, (u16*)(ws + O_W13_1), p.ffn_norm + 1024, 1, 0};
    default: return WDesc{p.ffn_w2 + (size_t)2816 * 1024, 1024, 2816, 1024, (u16*)(ws + O_W2_1), nullptr, 0, 0};
  }
}
__device__ void wt_run(const Params& p, char* ws, int set, int gw, int nw, int lane) {
  const int c0 = set ? 320 : 1088, c1 = c0 + (set ? 64 : 128), c2 = c1 + (set ? 256 : 384), c3 = c2 + 1408, total = c3 + 704;
  for (int it = gw; it < total; it += nw) {
    const int i = it < c0 ? 0 : it < c1 ? 1 : it < c2 ? 2 : it < c3 ? 3 : 4;
    const int base = i == 0 ? 0 : i == 1 ? c0 : i == 2 ? c1 : i == 3 ? c2 : c3;
    const WDesc d = wt_desc(p, ws, set, i);
    wt_item(d, it - base, lane);
  }
}

__device__ void phase_prep(const Params& p) {
  size_t wz = 0;
  asm volatile("" : "+s"(wz));
  char* ws = p.ws + wz;
  const int tid = otid(), lane = tid & 63;
  const int gw = blockIdx.x * 8 + (tid >> 6), nw = gridDim.x * 8;
  PSUB(1) wt_run(p, ws, 0, gw, nw, lane);
  PSUB(2) for (int row0 = gw * 4; row0 < T; row0 += nw * 4) {
    float4 v[4][4];
#pragma unroll
    for (int rr = 0; rr < 4; ++rr)
#pragma unroll
      for (int i = 0; i < 4; ++i) v[rr][i] = *(const float4*)(p.x + (size_t)(row0 + rr) * 1024 + i * 256 + lane * 4);
#pragma unroll
    for (int rr = 0; rr < 4; ++rr) {
      u16* xb = (u16*)(ws + O_XB) + (size_t)(row0 + rr) * 1024;
      float ss = 0.f;
#pragma unroll
      for (int i = 0; i < 4; ++i) { const float4 a = v[rr][i]; ss += a.x * a.x + a.y * a.y + a.z * a.z + a.w * a.w; }
#pragma unroll
      for (int o = 32; o >= 1; o >>= 1) ss += __shfl_xor(ss, o);
      const float rs = rsqrtf(ss * (1.f / 1024.f) + EPS);
#pragma unroll
      for (int i = 0; i < 4; ++i) {
        const float4 a = v[rr][i];
        *(uint2*)(xb + i * 256 + lane * 4) = make_uint2(pack2(a.x * rs, a.y * rs), pack2(a.z * rs, a.w * rs));
      }
      if (lane == 0) {
        float* ssq = (float*)(ws + O_SSQ);
        const int row = row0 + rr;
        ssq[row] = ss; ssq[T + row] = 0.f; ssq[2 * T + row] = 0.f; ssq[3 * T + row] = 0.f;
      }
    }
  }
  PSUB(3) for (int idx = blockIdx.x * 512 + tid; idx < 65536; idx += gridDim.x * 512) {
    int s = idx >> 5, pp = idx & 31;
    float pos = (pp < 16) ? (float)(s >> 6) : (float)(s & 63);
    float freq = __builtin_amdgcn_exp2f(-(float)(pp & 15) * (13.287712379549449f / 16.f));
    float sn, cs;
    sincosf(pos * freq, &sn, &cs);
    ((float2*)(ws + O_ROPE))[idx] = make_float2(cs, sn);
  }
}
__device__ void phase_prep_l1(const Params& p, char* ws, int gw, int nw, int lane) { wt_run(p, ws, 1, gw, nw, lane); }
namespace pg8 {
#define PG8_LAS __attribute__((address_space(3)))
typedef unsigned short bf16_t;
constexpr int BM = 256, BK = 64, HALF = 128, HTB = HALF * BK * 2, STAGE_BYTES = 8 * HTB, NXCD = 8, WGM = 8;
DI int lds_byte(int r, int c) { const int st = (r >> 4) * 2 + (c >> 5), rr = r & 15, cc = c & 31, ob = rr * 64 + cc * 2; return st * 1024 + (ob ^ (((ob >> 9) & 1) << 5)); }
DI void stage_rc(int b, int& R, int& C) { const int st = b / 1024, sb = b % 1024, swz = sb ^ (((sb >> 9) & 1) << 5); R = (st >> 1) * 16 + swz / 64; C = (st & 1) * 32 + (swz % 64) / 2; }
DI int perm32(int rho) { const int n = rho >> 4, i = rho & 15; return 8 * (i >> 2) + 4 * n + (i & 3); }
struct Unit { int pm, pn; };
struct Gemm { const bf16_t* A; const bf16_t* Bt; int M, N, K; };
struct StaticOrder {
  int nM, nN, nwg, G, c;
  DI void init(int M, int N, int G_, int c_) { nM = M / BM; nN = N / BM; nwg = nM * nN; G = G_; c = c_; }
  DI bool next(int i, Unit& u) const {
    const long L = (long)i * G + c; if (L >= nwg) return false;
    int wgid = (int)L; { const int q = nwg / NXCD, r = nwg % NXCD, xcd = wgid % NXCD, off = wgid / NXCD; wgid = (xcd < r ? xcd * (q + 1) : r * (q + 1) + (xcd - r) * q) + off; }
    const int nig = WGM * nN, gid = wgid / nig, fm = gid * WGM, gsz = (nM - fm) < WGM ? (nM - fm) : WGM;
    u.pm = fm + ((wgid % nig) % gsz); u.pn = (wgid % nig) / gsz; return true;
  }
};
template <class Epi>
DI void gemm_phase(PG8_LAS unsigned char* lds, const Gemm g, const StaticOrder& S, const Epi& E) {
  const int tid = otid(), wid = __builtin_amdgcn_readfirstlane(tid >> 6), lane = tid & 63, wr = wid >> 2, wc = wid & 3, fr = lane & 15, fq = lane >> 4;
  const int K = g.K, nt = K / BK;
  unsigned voffA[2], voffB[2];
#pragma unroll
  for (int i = 0; i < 2; ++i) { int R, C; stage_rc(tid * 16 + i * 8192, R, C); const int Rb = E.perm ? ((R & ~31) + perm32(R & 31)) : R;
    voffA[i] = (unsigned)(R * K + C) * 2u; voffB[i] = (unsigned)(Rb * K + C) * 2u; }
  const size_t kstep = (size_t)(BK * 2);
  const size_t hstep = (size_t)HALF * K * 2;
  const size_t tstep = 2 * hstep;
  const unsigned ldsw = (unsigned)wid * 1024u;
  const int aoff = lds_byte(wr * 64 + fr, fq * 8), boff = lds_byte(wc * 32 + fr, fq * 8);
#define PG8_SA(b, h) (((b) * 2 + (h)) * HTB)
#define PG8_SB(b, h) ((4 + (b) * 2 + (h)) * HTB)
#define PG8_STAGE(bufoff, gbase, voff) do { _Pragma("unroll") for (int _i = 0; _i < 2; ++_i) \
    __builtin_amdgcn_global_load_lds((const unsigned*)((const char*)(gbase) + (voff)[_i]), (PG8_LAS unsigned*)(lds + (bufoff) + ldsw + _i * 8192), 16, 0, 0); } while (0)
#define PG8_LDA(dst, b, h) do { _Pragma("unroll") for (int m = 0; m < 4; ++m) _Pragma("unroll") for (int k = 0; k < 2; ++k) dst[m][k] = *(const PG8_LAS bf16x8*)(lds + PG8_SA(b, h) + aoff + m * 2048 + k * 1024); } while (0)
#define PG8_LDB(dst, b, h) do { _Pragma("unroll") for (int n = 0; n < 2; ++n) _Pragma("unroll") for (int k = 0; k < 2; ++k) dst[n][k] = *(const PG8_LAS bf16x8*)(lds + PG8_SB(b, h) + boff + n * 2048 + k * 1024); } while (0)
#define PG8_MMA(ai, bj, At, Bt) do { __builtin_amdgcn_s_setprio(1); _Pragma("unroll") for (int m = 0; m < 4; ++m) _Pragma("unroll") for (int n = 0; n < 2; ++n) _Pragma("unroll") for (int k = 0; k < 2; ++k) \
    acc[ai][bj][m][n] = __builtin_amdgcn_mfma_f32_16x16x32_bf16(Bt[n][k], At[m][k], acc[ai][bj][m][n], 0, 0, 0); __builtin_amdgcn_s_setprio(0); } while (0)
#define PG8_WAIT_V(n) asm volatile("s_waitcnt vmcnt(" #n ")" ::: "memory")
#define PG8_WAIT_L(n) asm volatile("s_waitcnt lgkmcnt(" #n ")" ::: "memory")
#define PG8_BAR __builtin_amdgcn_s_barrier()
#define PG8_SCHED __builtin_amdgcn_sched_barrier(0)
  Unit cur, nxt; int ui = 0;
  if (!S.next(0, cur)) return;
  if (E.ssq_in) {
    PG8_LAS float* rtab = (PG8_LAS float*)(lds + 131072);
    Unit uu;
    for (int q = 0; q < 8 && S.next(q, uu); ++q)
      if (tid < 256) rtab[q * 256 + tid] = rsqrtf(E.ssq_in[(E.kind == 4 ? uu.pn : uu.pm) * 256 + tid] * (1.f / 1024.f) + EPS);
    __syncthreads();
  }
  f32x4 acc[2][2][4][2];
#pragma unroll
  for (int a = 0; a < 2; ++a)
#pragma unroll
    for (int b = 0; b < 2; ++b)
#pragma unroll
      for (int m = 0; m < 4; ++m)
#pragma unroll
        for (int n = 0; n < 2; ++n) acc[a][b][m][n] = (f32x4){0.f, 0.f, 0.f, 0.f};
  bf16x8 At[4][2], B0[2][2], B1[2][2];
  const char* cA = (const char*)g.A + (size_t)cur.pm * tstep; const char* cB = (const char*)g.Bt + (size_t)cur.pn * tstep;
  PG8_STAGE(PG8_SB(0, 0), cB, voffB); PG8_STAGE(PG8_SA(0, 0), cA, voffA); PG8_STAGE(PG8_SB(0, 1), cB + hstep, voffB); PG8_STAGE(PG8_SA(0, 1), cA + hstep, voffA);
  if (wr == 1) PG8_BAR;
  PG8_WAIT_V(4); PG8_BAR;
  PG8_STAGE(PG8_SB(1, 0), cB + kstep, voffB); PG8_STAGE(PG8_SA(1, 0), cA + kstep, voffA); PG8_STAGE(PG8_SB(1, 1), cB + hstep + kstep, voffB);
  PG8_WAIT_V(6); PG8_BAR;
  for (;;) {
    const bool has_next = S.next(ui + 1, nxt);
    const char* nA = has_next ? (const char*)g.A + (size_t)nxt.pm * tstep : cA; const char* nB = has_next ? (const char*)g.Bt + (size_t)nxt.pn * tstep : cB;
    for (int t = 0; t < nt; t += 2) {
      const bool last = (t == nt - 2);
      const char* a1 = cA + (size_t)(t + 1) * kstep;
      const char* a2 = last ? nA : cA + (size_t)(t + 2) * kstep; const char* b2 = last ? nB : cB + (size_t)(t + 2) * kstep;
      const char* a3 = a2 + kstep; const char* b3 = b2 + kstep;
      PG8_LDB(B0, 0, 0); PG8_SCHED; PG8_LDA(At, 0, 0); PG8_STAGE(PG8_SA(1, 1), a1 + hstep, voffA);
      PG8_WAIT_L(8); PG8_BAR; PG8_WAIT_L(0); PG8_MMA(0, 0, At, B0); PG8_BAR; PG8_SCHED;
      PG8_LDB(B1, 0, 1); PG8_STAGE(PG8_SB(0, 0), b2, voffB);
      PG8_BAR; PG8_WAIT_L(0); PG8_MMA(0, 1, At, B1); PG8_BAR;
      PG8_LDA(At, 0, 1); PG8_STAGE(PG8_SA(0, 0), a2, voffA);
      PG8_BAR; PG8_WAIT_L(0); PG8_MMA(1, 0, At, B0); PG8_BAR; PG8_SCHED;
      PG8_STAGE(PG8_SB(0, 1), b2 + hstep, voffB);
      PG8_WAIT_V(6); PG8_BAR; PG8_MMA(1, 1, At, B1); PG8_BAR;
      PG8_LDB(B0, 1, 0); PG8_SCHED; PG8_LDA(At, 1, 0); PG8_STAGE(PG8_SA(0, 1), a2 + hstep, voffA);
      PG8_WAIT_L(8); PG8_BAR; PG8_WAIT_L(0); PG8_MMA(0, 0, At, B0); PG8_BAR; PG8_SCHED;
      PG8_LDB(B1, 1, 1); PG8_STAGE(PG8_SB(1, 0), b3, voffB);
      PG8_BAR; PG8_WAIT_L(0); PG8_MMA(0, 1, At, B1); PG8_BAR;
      PG8_LDA(At, 1, 1); PG8_STAGE(PG8_SA(1, 0), a3, voffA);
      PG8_BAR; PG8_WAIT_L(0); PG8_MMA(1, 0, At, B0); PG8_BAR; PG8_SCHED;
      PG8_STAGE(PG8_SB(1, 1), b3 + hstep, voffB);
      PG8_WAIT_V(6); PG8_BAR; PG8_MMA(1, 1, At, B1); PG8_BAR;
    }
    E(acc, cur, wr, wc, fr, fq, (const PG8_LAS float*)(lds + 131072) + ui * 256);
    if (!has_next) break;
#pragma unroll
    for (int a = 0; a < 2; ++a)
#pragma unroll
      for (int b = 0; b < 2; ++b)
#pragma unroll
        for (int m = 0; m < 4; ++m)
#pragma unroll
          for (int n = 0; n < 2; ++n) acc[a][b][m][n] = (f32x4){0.f, 0.f, 0.f, 0.f};
    cur = nxt; cA = nA; cB = nB; ++ui;
  }
  PG8_WAIT_V(0);
  if (wr == 0) PG8_BAR;
  PG8_BAR;
#undef PG8_SA
#undef PG8_SB
#undef PG8_STAGE
#undef PG8_LDA
#undef PG8_LDB
#undef PG8_MMA
#undef PG8_WAIT_V
#undef PG8_WAIT_L
#undef PG8_BAR
#undef PG8_SCHED
}
}

typedef f32x4 AccT[2][2][4][2];
DI uint4 pack8(f32x4 a, f32x4 b) { return make_uint4(pack2(a[0], a[1]), pack2(a[2], a[3]), pack2(b[0], b[1]), pack2(b[2], b[3])); }

struct EpiRes {
  static constexpr bool PERM = false;
  const float* res_f32; u16* xb; float* out_f32; float* ssq_out;
  DI void operator()(const AccT& acc, const pg8::Unit& u, int wr, int wc, int fr, int fq, const PG8_LAS float* rtab) const {
    const int row0 = u.pm * 256 + wr * 64 + fr, col0 = u.pn * 256 + wc * 32 + 4 * fq;
#pragma unroll
    for (int ai = 0; ai < 2; ++ai)
#pragma unroll
      for (int m = 0; m < 4; ++m) {
        const size_t r = row0 + ai * 128 + m * 16;
        float part = 0.f;
#pragma unroll
        for (int bj = 0; bj < 2; ++bj)
#pragma unroll
          for (int n = 0; n < 2; ++n) {
            const int c = col0 + bj * 128 + n * 16;
            float4 r4;
            if (res_f32) r4 = *(const float4*)(res_f32 + r * 1024 + c);
            else { uint2 rr = *(const uint2*)(xb + r * 1024 + c); r4 = make_float4(bflo(rr.x), bfhi(rr.x), bflo(rr.y), bfhi(rr.y)); }
            f32x4 a = acc[ai][bj][m][n];
            float4 v = make_float4(r4.x + a[0], r4.y + a[1], r4.z + a[2], r4.w + a[3]);
            if (out_f32) *(float4*)(out_f32 + r * 1024 + c) = v;
            else *(uint2*)(xb + r * 1024 + c) = make_uint2(pack2(v.x, v.y), pack2(v.z, v.w));
            part += v.x * v.x + v.y * v.y + v.z * v.z + v.w * v.w;
          }
        if (ssq_out) {
          part = xor16_32_sum(part);
          if (fq == 0) atomicAdd(ssq_out + r, part);
        }
      }
  }
};

struct EpiSwiglu {
  static constexpr bool PERM = true;
  const float* ssq_in; u16* h_out;
  DI void operator()(const AccT& acc, const pg8::Unit& u, int wr, int wc, int fr, int fq, const PG8_LAS float* rtab) const {
    const int row0 = u.pm * 256 + wr * 64 + fr;
#pragma unroll
    for (int ai = 0; ai < 2; ++ai)
#pragma unroll
      for (int m = 0; m < 4; ++m) {
        const size_t r = row0 + ai * 128 + m * 16;
        const float rs = rtab[ai * 128 + wr * 64 + m * 16 + fr];
        f32x4 h0, h1;
#pragma unroll
        for (int e = 0; e < 4; ++e) {
          h0[e] = silu(acc[ai][0][m][0][e] * rs) * (acc[ai][1][m][0][e] * rs);
          h1[e] = silu(acc[ai][0][m][1][e] * rs) * (acc[ai][1][m][1][e] * rs);
        }
        *(uint4*)(h_out + r * 2816 + u.pn * 128 + wc * 32 + 8 * fq) = pack8(h0, h1);
      }
  }
};

template <int L1>
struct EpiQK {
  static constexpr bool PERM = true;
  char* ws; u16* zout; const float* qn; const float* kn; const float* ssq_in;
  DI void operator()(const AccT& acc, const pg8::Unit& u, int wr, int wc, int fr, int fq, const PG8_LAS float* rtab) const {
    const int pn = u.pn;
    const int row0 = u.pm * 256 + wr * 64 + fr;
    const bool headnorm = L1 ? true : (pn < 4);
    const bool is_q = L1 ? (pn < 4) : (pn < 2);
#pragma unroll
    for (int ai = 0; ai < 2; ++ai)
#pragma unroll
      for (int m = 0; m < 4; ++m) {
        const size_t r = row0 + ai * 128 + m * 16;
        const float rs = L1 ? rtab[ai * 128 + wr * 64 + m * 16 + fr] : 1.f;
        f32x4 v[2][2];
#pragma unroll
        for (int bj = 0; bj < 2; ++bj)
#pragma unroll
          for (int n = 0; n < 2; ++n) v[bj][n] = acc[ai][bj][m][n] * rs;
        if (headnorm) {
          float ss = 0.f;
#pragma unroll
          for (int bj = 0; bj < 2; ++bj)
#pragma unroll
            for (int n = 0; n < 2; ++n)
              ss += v[bj][n][0] * v[bj][n][0] + v[bj][n][1] * v[bj][n][1] + v[bj][n][2] * v[bj][n][2] + v[bj][n][3] * v[bj][n][3];
          ss = xor16_32_sum(ss);
          const float hn = rsqrtf(ss * (1.f / 64.f) + EPS) * (is_q ? 0.125f * LOG2E : 1.f);
          const float* gn = is_q ? qn : kn;
#pragma unroll
          for (int bj = 0; bj < 2; ++bj)
#pragma unroll
            for (int n = 0; n < 2; ++n) {
              float4 g4 = *(const float4*)(gn + bj * 32 + 8 * fq + 4 * n);
              v[bj][n][0] *= hn * g4.x; v[bj][n][1] *= hn * g4.y; v[bj][n][2] *= hn * g4.z; v[bj][n][3] *= hn * g4.w;
            }
          u16* dst;
          if (L1) {
            const int s = (int)(r & 2047);
            const float4* rt = (const float4*)(ws + O_ROPE) + (size_t)s * 16;
#pragma unroll
            for (int bj = 0; bj < 2; ++bj)
#pragma unroll
              for (int n = 0; n < 2; ++n) {
                float4 cs = rt[bj * 8 + 2 * fq + n];
                float a0 = v[bj][n][0], a1 = v[bj][n][1], b0 = v[bj][n][2], b1 = v[bj][n][3];
                v[bj][n][0] = a0 * cs.x - a1 * cs.y; v[bj][n][1] = a0 * cs.y + a1 * cs.x;
                v[bj][n][2] = b0 * cs.z - b1 * cs.w; v[bj][n][3] = b0 * cs.w + b1 * cs.z;
              }
            dst = is_q ? (u16*)(ws + O_Q1) + r * 1024 + (pn * 4 + wc) * 64 : (u16*)(ws + O_K1) + r * 256 + wc * 64;
          } else {
            dst = (is_q ? (u16*)(ws + O_Q0) : (u16*)(ws + O_K0)) + r * 512 + ((pn & 1) * 4 + wc) * 64;
          }
#pragma unroll
          for (int bj = 0; bj < 2; ++bj) *(uint4*)(dst + bj * 32 + 8 * fq) = pack8(v[bj][0], v[bj][1]);
        } else if (pn < 8) {
          u16* dst = zout + r * 1024 + (pn - 4) * 256 + wc * 32 + 8 * fq;
#pragma unroll
          for (int bj = 0; bj < 2; ++bj) *(uint4*)(dst + bj * 128) = pack8(v[bj][0], v[bj][1]);
        } else if (pn < 16) {
          u16* dst = (u16*)(ws + O_XBC) + r * 2048 + (pn - 8) * 256 + wc * 32 + 8 * fq;
#pragma unroll
          for (int bj = 0; bj < 2; ++bj) *(uint4*)(dst + bj * 128) = pack8(v[bj][0], v[bj][1]);
        } else if (wc == 0) {
          float* dst = (float*)(ws + O_DTB) + r * 32 + 8 * fq;
          *(float4*)(dst) = make_float4(v[0][0][0], v[0][0][1], v[0][0][2], v[0][0][3]);
          *(float4*)(dst + 4) = make_float4(v[0][1][0], v[0][1][1], v[0][1][2], v[0][1][3]);
        }
      }
  }
};

struct EpiVT {
  static constexpr bool PERM = true;
  const float* ssq_in; u16* vt; int nh;
  DI void operator()(const AccT& acc, const pg8::Unit& u, int wr, int wc, int fr, int fq, const PG8_LAS float* rtab) const {
#pragma unroll
    for (int bj = 0; bj < 2; ++bj) {
      const int tok0 = u.pn * 256 + bj * 128 + wc * 32 + 8 * fq;
      f32x4 r0 = {1.f, 1.f, 1.f, 1.f}, r1 = r0;
      if (ssq_in) {
        const int lo = bj * 128 + wc * 32 + 8 * fq;
        r0 = *(const PG8_LAS f32x4*)(rtab + lo); r1 = *(const PG8_LAS f32x4*)(rtab + lo + 4);
      }
      const int b = tok0 >> 11, s = tok0 & 2047;
#pragma unroll
      for (int ai = 0; ai < 2; ++ai)
#pragma unroll
        for (int m = 0; m < 4; ++m) {
          const int f = u.pm * 256 + ai * 128 + wr * 64 + m * 16 + fr;
          const int hd = f >> 6, d = f & 63;
          u16* dstp = vt + ((size_t)((b * nh + hd) * 64 + d)) * 2048;
          const uint4 pk = pack8(acc[ai][bj][m][0] * r0, acc[ai][bj][m][1] * r1);
          if (nh == 4) {
            const int c = (s >> 3) & 3, pos0 = (s & ~31) + 16 * (c & 1) + 4 * (c >> 1);
            *(uint2*)(dstp + pos0) = make_uint2(pk.x, pk.y);
            *(uint2*)(dstp + pos0 + 8) = make_uint2(pk.z, pk.w);
          } else {
            *(uint4*)(dstp + s) = pk;
          }
        }
    }
  }
};
enum { EK_RES = 0, EK_SWIGLU = 1, EK_QK0 = 2, EK_QK1 = 3, EK_VT = 4 };
struct EpiAny {
  int kind; bool perm;
  char* ws; u16* zout; const float* qn; const float* kn; const float* ssq_in; float* ssq_out; const float* res_in; float* res_out; u16* xb_out; u16* o16; int nh;
  DI void operator()(const AccT& acc, const pg8::Unit& u, int wr, int wc, int fr, int fq, const PG8_LAS float* rtab) const {
    switch (kind) {
      case EK_RES: { EpiRes e{res_in, xb_out, res_out, ssq_out}; e(acc, u, wr, wc, fr, fq, rtab); } break;
      case EK_SWIGLU: { EpiSwiglu e{ssq_in, o16}; e(acc, u, wr, wc, fr, fq, rtab); } break;
      case EK_QK0: { EpiQK<0> e{ws, zout, qn, kn, ssq_in}; e(acc, u, wr, wc, fr, fq, rtab); } break;
      case EK_QK1: { EpiQK<1> e{ws, zout, qn, kn, ssq_in}; e(acc, u, wr, wc, fr, fq, rtab); } break;
      default: { EpiVT e{ssq_in, o16, nh}; e(acc, u, wr, wc, fr, fq, rtab); } break;
    }
  }
};

__device__ void na_tile(const Params& p, int tile) {
  const int tid = vtid(), lane = tid & 63, wave = tid >> 6, l15 = lane & 15, quad = lane >> 4;
  const int h = tile & 7, r = (tile >> 3) & 31, b = tile >> 8;
  const int c0 = min(max(16 * wave - 8, 0), 32);
  const int rs = min(max(r - 4, 0), 24);
  const u16* Q0 = (const u16*)(p.ws + O_Q0);
  const u16* K0 = (const u16*)(p.ws + O_K0) + (size_t)(b * 2048 + rs * 64 + c0 + 8 * (l15 >> 2) + (l15 & 3)) * 512 + h * 64 + 8 * quad;
  const u16* VT = (const u16*)(p.ws + O_VT0) + (size_t)((b * 8 + h) * 64 + l15) * 2048 + rs * 64 + c0 + 8 * quad;
  u16* mix = (u16*)(p.ws + O_MIX);
  const int tq = b * 2048 + r * 64 + 16 * wave + l15;
  bf16x8 qf[2];
#pragma unroll
  for (int ks = 0; ks < 2; ++ks) qf[ks] = as_bf8(*(const uint4*)(Q0 + (size_t)tq * 512 + h * 64 + 32 * ks + 8 * quad));
  const int cq = 16 * wave + l15;
  const int cs = min(max(cq - 8, 0), 48);
  const float* rpb = p.na_rel_bias + h * 465 + (rs - r + 7) * 31;
  const int d0 = c0 + 8 * quad - cq;
  const int w0 = d0 + cq - cs;
  f32x4 s[16];
  uint4 kb[2][4];
#pragma unroll
  for (int q4 = 0; q4 < 4; ++q4) kb[0][q4] = *(const uint4*)(K0 + (size_t)(4 * (q4 >> 1)) * 512 + 32 * (q4 & 1));
#pragma unroll
  for (int jr = 0; jr < 8; ++jr) {
    if (jr + 1 < 8) {
#pragma unroll
      for (int q4 = 0; q4 < 4; ++q4)
        kb[(jr + 1) & 1][q4] = *(const uint4*)(K0 + (size_t)((jr + 1) * 64 + 4 * (q4 >> 1)) * 512 + 32 * (q4 & 1));
    }
    float bias[8];
#pragma unroll
    for (int e = 0; e < 8; ++e) bias[e] = rpb[jr * 31 + min(max(d0 + 4 * (e >> 2) + (e & 3), -15), 15) + 15];
#pragma unroll
    for (int tt = 0; tt < 2; ++tt) {
      f32x4 a = {0.f, 0.f, 0.f, 0.f};
      a = MFMA(as_bf8(kb[jr & 1][2 * tt]), qf[0], a);
      a = MFMA(as_bf8(kb[jr & 1][2 * tt + 1]), qf[1], a);
#pragma unroll
      for (int rr = 0; rr < 4; ++rr) a[rr] = ((unsigned)(w0 + 4 * tt + rr) < 16u) ? (a[rr] + bias[tt * 4 + rr] * LOG2E) : -INFINITY;
      s[jr * 2 + tt] = a;
    }
  }
  float mx = -INFINITY;
#pragma unroll
  for (int u = 0; u < 16; ++u) mx = fmaxf(mx, fmaxf(fmaxf(s[u][0], s[u][1]), fmaxf(s[u][2], s[u][3])));
  mx = xor16_32_max(mx);
  uint4 vbuf[3][4];
#define NA_VLOAD(jr, dst) do { \
    _Pragma("unroll") for (int i2 = 0; i2 < 4; ++i2) dst[i2] = *(const uint4*)(VT + (size_t)(16 * i2) * 2048 + (jr) * 64); } while (0)
  NA_VLOAD(0, vbuf[0]);
  NA_VLOAD(1, vbuf[1]);
  float sum = 0.f;
#pragma unroll
  for (int u = 0; u < 16; ++u)
#pragma unroll
    for (int rr = 0; rr < 4; ++rr) { float pv = ex2(s[u][rr] - mx); s[u][rr] = pv; sum += pv; }
  sum = xor16_32_sum(sum);
  f32x4 o[4];
#pragma unroll
  for (int i2 = 0; i2 < 4; ++i2) o[i2] = (f32x4){0.f, 0.f, 0.f, 0.f};
#pragma unroll
  for (int jr = 0; jr < 8; ++jr) {
    if (jr + 2 < 8) NA_VLOAD(jr + 2, vbuf[(jr + 2) % 3]);
    bf16x8 pf = cat_bf8(pack4(s[2 * jr]), pack4(s[2 * jr + 1]));
#pragma unroll
    for (int i2 = 0; i2 < 4; ++i2) o[i2] = MFMA(as_bf8(vbuf[jr % 3][i2]), pf, o[i2]);
  }
#undef NA_VLOAD
  const float inv = 1.f / sum;
#pragma unroll
  for (int i2 = 0; i2 < 4; ++i2) *(uint2*)(mix + (size_t)tq * 1536 + h * 64 + 16 * i2 + 4 * quad) = pack4(o[i2] * inv);
}

__device__ void conv_tile(const Params& p, int tile) {
  const int tb = tile >> 2, cb = tile & 3;
  const int ch = cb * 512 + 2 * vtid();
  const int b = tb >> 5, s0 = (tb & 31) * 64;
  float w[4][2], bias[2];
#pragma unroll
  for (int k = 0; k < 4; ++k) { const float2 t = *(const float2*)(p.conv_w + k * 2048 + ch); w[k][0] = t.x; w[k][1] = t.y; }
  { const float2 t = *(const float2*)(p.conv_b + ch); bias[0] = t.x; bias[1] = t.y; }
  const u16* src = (const u16*)(p.ws + O_XBC) + (size_t)(b * 2048) * 2048 + ch;
  unsigned um2 = (s0 >= 2) ? *(const unsigned*)(src + (size_t)(s0 - 2) * 2048) : 0u;
  unsigned um1 = (s0 >= 1) ? *(const unsigned*)(src + (size_t)(s0 - 1) * 2048) : 0u;
  unsigned u0 = *(const unsigned*)(src + (size_t)s0 * 2048);
  u16* XT = (u16*)p.out + 16 * MIB;
  for (int sg = 0; sg < 8; ++sg) {
    unsigned nx[8];
#pragma unroll
    for (int e = 0; e < 8; ++e) { const int s = s0 + sg * 8 + e; nx[e] = (s + 1 < 2048) ? *(const unsigned*)(src + (size_t)(s + 1) * 2048) : 0u; }
    float y[2][8];
#pragma unroll
    for (int e = 0; e < 8; ++e) {
      const unsigned up1 = nx[e];
      y[0][e] = silu(w[0][0] * bflo(um2) + w[1][0] * bflo(um1) + w[2][0] * bflo(u0) + w[3][0] * bflo(up1) + bias[0]);
      y[1][e] = silu(w[0][1] * bfhi(um2) + w[1][1] * bfhi(um1) + w[2][1] * bfhi(u0) + w[3][1] * bfhi(up1) + bias[1]);
      um2 = um1; um1 = u0; u0 = up1;
    }
    const int sb = s0 + sg * 8;
    if (cb < 3) {
      u16* dstT = (cb < 2) ? XT + (size_t)(b * 1024 + ch) * 2048 + sb : (u16*)(p.ws + O_BT) + (size_t)(b * 512 + (ch - 1024)) * 2048 + sb;
#pragma unroll
      for (int c2 = 0; c2 < 2; ++c2)
        *(uint4*)(dstT + (size_t)c2 * 2048) = make_uint4(pack2(y[c2][0], y[c2][1]), pack2(y[c2][2], y[c2][3]), pack2(y[c2][4], y[c2][5]), pack2(y[c2][6], y[c2][7]));
    }
    if (cb >= 2) {
      u16* nat = (cb == 2) ? (u16*)(p.ws + O_BN) + (size_t)(b * 2048 + sb) * 512 + (ch - 1024)
                           : (u16*)(p.ws + O_CN) + (size_t)(b * 2048 + sb) * 512 + (ch - 1536);
#pragma unroll
      for (int e = 0; e < 8; ++e) *(unsigned*)(nat + e * 512) = pack2(y[0][e], y[1][e]);
    }
  }
}

__device__ void scan_item8(const Params& p, char* smem, int item) {
  const int tid = otid(), lane = tid & 63, wave = __builtin_amdgcn_readfirstlane(tid >> 6), l15 = lane & 15, quad = lane >> 4;
  const int dir = item & 1, h = (item >> 1) & 15, b = item >> 5, g = h >> 2;
  const float Ah = -__expf(p.A_log[dir * 16 + h]) * LOG2E;
  PG8_LAS float* wall = (PG8_LAS float*)((PG8_LAS unsigned char*)smem + 65536);
  PG8_LAS float* cdall = wall + 2048;
  const float* dtb = (const float*)(p.ws + O_DTB);
#pragma unroll
  for (int cc = 0; cc < 2; ++cc) {
    const int c = 2 * wave + cc;
    const int tokb = b * 2048 + c * 128;
    const float d0 = dtb[(size_t)(tokb + 2 * lane) * 32 + dir * 16 + h];
    const float d1 = dtb[(size_t)(tokb + 2 * lane + 1) * 32 + dir * 16 + h];
    const float a0 = d0 * Ah, a1 = d1 * Ah, ps = a0 + a1;
    float incl = ps;
#pragma unroll
    for (int o = 1; o < 64; o <<= 1) { float tv = __shfl_up(incl, o); if (lane >= o) incl += tv; }
    const float total = __shfl(incl, 63);
    const float excl = incl - ps;
    float w0, w1;
    if (dir == 0) { w0 = ex2(total - (excl + a0)) * d0; w1 = ex2(total - incl) * d1; }
    else { w0 = ex2(excl) * d0; w1 = ex2(excl + a0) * d1; }
    wall[c * 128 + 2 * lane] = w0; wall[c * 128 + 2 * lane + 1] = w1;
    if (lane == 0) cdall[c] = ex2(total);
  }
  __syncthreads();
  const int drow = 8 * wave + (lane >> 4);
  const u16* XTg = (const u16*)p.out + 16 * MIB + (size_t)(b * 1024 + h * 64) * 2048;
  const char* xsrc0 = (const char*)(XTg + (size_t)drow * 2048) + (((lane & 15) ^ (drow & 15)) << 4);
  const char* xsrc1 = (const char*)(XTg + (size_t)(drow + 4) * 2048) + (((lane & 15) ^ ((drow + 4) & 15)) << 4);
  PG8_LAS unsigned char* lds = (PG8_LAS unsigned char*)smem;
  const u16* BT = (const u16*)(p.ws + O_BT) + (size_t)(b * 512 + g * 128 + 16 * wave + l15) * 2048 + 8 * quad;
  u16* HP = (u16*)(p.ws + O_HPREV);
  f32x4 acc[4];
#pragma unroll
  for (int j = 0; j < 4; ++j) acc[j] = (f32x4){0.f, 0.f, 0.f, 0.f};
  u32x4v bA[4], bB[4], bC[4], bD[4];
#define SC_ISSUE(Bf, st, c) do { \
    __builtin_amdgcn_global_load_lds((const unsigned*)(xsrc0 + (c) * 256), (PG8_LAS unsigned*)(lds + (st) * 16384 + wave * 2048), 16, 0, 0); \
    __builtin_amdgcn_global_load_lds((const unsigned*)(xsrc1 + (c) * 256), (PG8_LAS unsigned*)(lds + (st) * 16384 + wave * 2048 + 1024), 16, 0, 0); \
    { const u16* _bp = BT + (c) * 128; \
      asm volatile("global_load_dwordx4 %0, %4, off\n\tglobal_load_dwordx4 %1, %4, off offset:64\n\tglobal_load_dwordx4 %2, %4, off offset:128\n\tglobal_load_dwordx4 %3, %4, off offset:192" \
                   : "=&v"(Bf[0]), "=&v"(Bf[1]), "=&v"(Bf[2]), "=&v"(Bf[3]) : "v"(_bp) : "memory"); } } while (0)
#define SC_STEP(Bf, st, c) do { \
    u16* hp = HP + ((size_t)(((b * 16 + (c)) * 16 + h) * 2 + dir) << 13); \
    _Pragma("unroll") for (int j = 0; j < 4; ++j) *(uint2*)(hp + (16 * j + l15) * 128 + 16 * wave + 4 * quad) = pack4(acc[j]); \
    const float cd = cdall[(c)]; \
    _Pragma("unroll") for (int j = 0; j < 4; ++j) acc[j] *= cd; \
    _Pragma("unroll") for (int ks = 0; ks < 4; ++ks) { \
      const f32x4 wav = *(const PG8_LAS f32x4*)(wall + (c) * 128 + 32 * ks + 8 * quad); \
      const f32x4 wbv = *(const PG8_LAS f32x4*)(wall + (c) * 128 + 32 * ks + 8 * quad + 4); \
      const float4 wa = make_float4(wav[0], wav[1], wav[2], wav[3]), wb = make_float4(wbv[0], wbv[1], wbv[2], wbv[3]); \
      _Pragma("unroll") for (int j = 0; j < 4; ++j) { \
        const u32x4v rawv = *(const PG8_LAS u32x4v*)(lds + (st) * 16384 + (16 * j + l15) * 256 + (((4 * ks + quad) ^ l15) << 4)); \
        const uint4 raw = make_uint4(rawv[0], rawv[1], rawv[2], rawv[3]); uint4 sc; \
        sc.x = pack2(bflo(raw.x) * wa.x, bfhi(raw.x) * wa.y); sc.y = pack2(bflo(raw.y) * wa.z, bfhi(raw.y) * wa.w); \
        sc.z = pack2(bflo(raw.z) * wb.x, bfhi(raw.z) * wb.y); sc.w = pack2(bflo(raw.w) * wb.z, bfhi(raw.w) * wb.w); \
        acc[j] = MFMA(__builtin_bit_cast(bf16x8, Bf[ks]), as_bf8(sc), acc[j]); } } } while (0)
#define SC_CH(s) (dir ? 15 - (s) : (s))
  SC_ISSUE(bA, 0, SC_CH(0)); SC_ISSUE(bB, 1, SC_CH(1)); SC_ISSUE(bC, 2, SC_CH(2));
#define SC_BAR() do { asm volatile("" ::: "memory"); __builtin_amdgcn_s_barrier(); asm volatile("" ::: "memory"); } while (0)
#define SC_WAIT(nlast, Bf) do { if (s4 == 12) asm volatile("s_waitcnt vmcnt(" #nlast ")" : "+v"(Bf[0]), "+v"(Bf[1]), "+v"(Bf[2]), "+v"(Bf[3]) :: "memory"); \
    else asm volatile("s_waitcnt vmcnt(18)" : "+v"(Bf[0]), "+v"(Bf[1]), "+v"(Bf[2]), "+v"(Bf[3]) :: "memory"); } while (0)
  for (int s4 = 0; s4 < 16; s4 += 4) {
    SC_ISSUE(bD, 3, SC_CH(s4 + 3));
    SC_WAIT(18, bA); SC_BAR();
    SC_STEP(bA, 0, SC_CH(s4));
    SC_BAR();
    if (s4 + 4 < 16) SC_ISSUE(bA, 0, SC_CH(s4 + 4));
    SC_WAIT(12, bB); SC_BAR();
    SC_STEP(bB, 1, SC_CH(s4 + 1));
    SC_BAR();
    if (s4 + 5 < 16) SC_ISSUE(bB, 1, SC_CH(s4 + 5));
    SC_WAIT(6, bC); SC_BAR();
    SC_STEP(bC, 2, SC_CH(s4 + 2));
    SC_BAR();
    if (s4 + 6 < 16) SC_ISSUE(bC, 2, SC_CH(s4 + 6));
    SC_WAIT(0, bD); SC_BAR();
    SC_STEP(bD, 3, SC_CH(s4 + 3));
    SC_BAR();
  }
#undef SC_BAR
#undef SC_WAIT
#undef SC_ISSUE
#undef SC_STEP
#undef SC_CH
  asm volatile("s_waitcnt vmcnt(0)" ::: "memory");
  __syncthreads();
}

__device__ void ssd_out_tile(const Params& p, char* smem, int tile) {
  const int tid = vtid(), lane = tid & 63, wave = tid >> 6, l15 = lane & 15, quad = lane >> 4;
  const int g = tile & 3, c = (tile >> 2) & 15, b = tile >> 6;
  const int hh = g * 4 + wave;
  u16* Gs = (u16*)smem;
  float* wv = (float*)(smem + 34816) + wave * 512;
  float* red = (float*)(smem + 34816 + 8192);
  const int tok0 = b * 2048 + c * 128;
  const u16* Cn = (const u16*)(p.ws + O_CN) + (size_t)tok0 * 512 + g * 128;
  const u16* Bn = (const u16*)(p.ws + O_BN) + (size_t)tok0 * 512 + g * 128;
  const float* dtb = (const float*)(p.ws + O_DTB);
  {
    f32x4 ga[8][2];
#pragma unroll
    for (int i = 0; i < 8; ++i) { ga[i][0] = (f32x4){0.f, 0.f, 0.f, 0.f}; ga[i][1] = ga[i][0]; }
#pragma unroll 2
    for (int ks = 0; ks < 4; ++ks) {
      bf16x8 cf[2];
#pragma unroll
      for (int jj = 0; jj < 2; ++jj)
        cf[jj] = as_bf8(*(const uint4*)(Cn + (size_t)(16 * (2 * wave + jj) + l15) * 512 + 32 * ks + 8 * quad));
#pragma unroll
      for (int i = 0; i < 8; ++i) {
        bf16x8 bf = as_bf8(*(const uint4*)(Bn + (size_t)(16 * i + l15) * 512 + 32 * ks + 8 * quad));
        ga[i][0] = MFMA(bf, cf[0], ga[i][0]);
        ga[i][1] = MFMA(bf, cf[1], ga[i][1]);
      }
    }
#pragma unroll
    for (int i = 0; i < 8; ++i)
#pragma unroll
      for (int jj = 0; jj < 2; ++jj)
        *(uint2*)(Gs + (16 * (2 * wave + jj) + l15) * 136 + 16 * i + 4 * quad) = pack4(ga[i][jj]);
  }
  {
    const float Af = -__expf(p.A_log[hh]) * LOG2E, Ab = -__expf(p.A_log[16 + hh]) * LOG2E;
    const float d0f = dtb[(size_t)(tok0 + 2 * lane) * 32 + hh], d1f = dtb[(size_t)(tok0 + 2 * lane + 1) * 32 + hh];
    const float d0b = dtb[(size_t)(tok0 + 2 * lane) * 32 + 16 + hh], d1b = dtb[(size_t)(tok0 + 2 * lane + 1) * 32 + 16 + hh];
    const float a0 = d0f * Af, a1 = d1f * Af, c0 = d0b * Ab, c1 = d1b * Ab;
    float inf_ = a0 + a1, inb = c0 + c1;
#pragma unroll
    for (int o = 1; o < 64; o <<= 1) {
      float t1 = __shfl_up(inf_, o), t2 = __shfl_up(inb, o);
      if (lane >= o) { inf_ += t1; inb += t2; }
    }
    const float totb = __shfl(inb, 63);
    const float exf = inf_ - (a0 + a1), exb = inb - (c0 + c1);
    *(float2*)(wv + 2 * lane) = make_float2(exf + a0, inf_);
    *(float2*)(wv + 128 + 2 * lane) = make_float2(totb - exb, totb - (exb + c0));
    *(float2*)(wv + 256 + 2 * lane) = make_float2(d0f, d1f);
    *(float2*)(wv + 384 + 2 * lane) = make_float2(d0b, d1b);
  }
  __syncthreads();
  const float Dh = p.Dskip[hh];
  const u16* XT = (const u16*)p.out + 16 * MIB + (size_t)(b * 1024 + hh * 64) * 2048 + c * 128;
  const u16* hf = (const u16*)(p.ws + O_HPREV) + ((size_t)(((b * 16 + c) * 16 + hh) * 2) << 13);
  const u16* hb = hf + 8192;
  const u16* Z = (const u16*)p.out;
  u16* mix = (u16*)(p.ws + O_MIX);
  #pragma unroll 1
  for (int jh = 0; jh < 2; ++jh) {
    f32x4 y[4][4];
    {
      float efv[4], ebv[4];
#pragma unroll
      for (int j = 0; j < 4; ++j) {
        const int l = 64 * jh + 16 * j + l15;
        efv[j] = ex2(wv[l]); ebv[j] = ex2(wv[128 + l]);
      }
#pragma unroll
      for (int i = 0; i < 4; ++i)
#pragma unroll
        for (int j = 0; j < 4; ++j) y[i][j] = (f32x4){0.f, 0.f, 0.f, 0.f};
#pragma unroll 2
      for (int ks = 0; ks < 4; ++ks) {
        bf16x8 cF[4], cB[4];
#pragma unroll
        for (int j = 0; j < 4; ++j) {
          const uint4 raw = *(const uint4*)(Cn + (size_t)(64 * jh + 16 * j + l15) * 512 + 32 * ks + 8 * quad);
          float f[8];
          unpack8(raw, f);
          cF[j] = as_bf8(make_uint4(pack2(f[0] * efv[j], f[1] * efv[j]), pack2(f[2] * efv[j], f[3] * efv[j]), pack2(f[4] * efv[j], f[5] * efv[j]), pack2(f[6] * efv[j], f[7] * efv[j])));
          cB[j] = as_bf8(make_uint4(pack2(f[0] * ebv[j], f[1] * ebv[j]), pack2(f[2] * ebv[j], f[3] * ebv[j]), pack2(f[4] * ebv[j], f[5] * ebv[j]), pack2(f[6] * ebv[j], f[7] * ebv[j])));
        }
#pragma unroll
        for (int i = 0; i < 4; ++i) {
          bf16x8 f1 = as_bf8(*(const uint4*)(hf + (16 * i + l15) * 128 + 32 * ks + 8 * quad));
          bf16x8 f2 = as_bf8(*(const uint4*)(hb + (16 * i + l15) * 128 + 32 * ks + 8 * quad));
#pragma unroll
          for (int j = 0; j < 4; ++j) { y[i][j] = MFMA(f1, cF[j], y[i][j]); y[i][j] = MFMA(f2, cB[j], y[i][j]); }
        }
      }
    }
#pragma unroll 2
    for (int ks = 0; ks < 4; ++ks) {
      const int sb = 32 * ks + 8 * quad;
      float afs[8], rbs[8], d0s[8], d1s[8];
      *(float4*)(afs) = *(const float4*)(wv + sb); *(float4*)(afs + 4) = *(const float4*)(wv + sb + 4);
      *(float4*)(rbs) = *(const float4*)(wv + 128 + sb); *(float4*)(rbs + 4) = *(const float4*)(wv + 128 + sb + 4);
      *(float4*)(d0s) = *(const float4*)(wv + 256 + sb); *(float4*)(d0s + 4) = *(const float4*)(wv + 256 + sb + 4);
      *(float4*)(d1s) = *(const float4*)(wv + 384 + sb); *(float4*)(d1s + 4) = *(const float4*)(wv + 384 + sb + 4);
      bf16x8 xf[4];
#pragma unroll
      for (int i = 0; i < 4; ++i) xf[i] = as_bf8(*(const uint4*)(XT + (size_t)(16 * i + l15) * 2048 + sb));
#pragma unroll
      for (int j = 0; j < 4; ++j) {
        const int l = 64 * jh + 16 * j + l15;
        const float afl = wv[l], rbl = wv[128 + l];
        float gv[8], m[8];
        unpack8(*(const uint4*)(Gs + l * 136 + sb), gv);
#pragma unroll
        for (int e = 0; e < 8; ++e) {
          const int s = sb + e;
          float ff = (s <= l) ? ex2(afl - afs[e]) * d0s[e] : 0.f;
          float fb = (s >= l) ? ex2(rbl - rbs[e]) * d1s[e] : 0.f;
          m[e] = gv[e] * (ff + fb) + ((s == l) ? Dh : 0.f);
        }
        bf16x8 mf = as_bf8(make_uint4(pack2(m[0], m[1]), pack2(m[2], m[3]), pack2(m[4], m[5]), pack2(m[6], m[7])));
#pragma unroll
        for (int i = 0; i < 4; ++i) y[i][j] = MFMA(xf[i], mf, y[i][j]);
      }
    }
#pragma unroll
    for (int j = 0; j < 4; ++j) {
      const int tok = tok0 + 64 * jh + 16 * j + l15;
      float part = 0.f;
#pragma unroll
      for (int i = 0; i < 4; ++i) {
        uint2 zr = *(const uint2*)(Z + (size_t)tok * 1024 + hh * 64 + 16 * i + 4 * quad);
        float z0 = bflo(zr.x), z1 = bfhi(zr.x), z2 = bflo(zr.y), z3 = bfhi(zr.y);
        y[i][j][0] *= silu(z0); y[i][j][1] *= silu(z1); y[i][j][2] *= silu(z2); y[i][j][3] *= silu(z3);
        part += y[i][j][0] * y[i][j][0] + y[i][j][1] * y[i][j][1] + y[i][j][2] * y[i][j][2] + y[i][j][3] * y[i][j][3];
      }
      part = xor16_32_sum(part);
      if (quad == 0) red[wave * 64 + 16 * j + l15] = part;
    }
    __syncthreads();
#pragma unroll
    for (int j = 0; j < 4; ++j) {
      const int tok = tok0 + 64 * jh + 16 * j + l15;
      const int q = 16 * j + l15;
      const float tot = red[q] + red[64 + q] + red[128 + q] + red[192 + q];
      const float rs = rsqrtf(tot * (1.f / 256.f) + EPS);
#pragma unroll
      for (int i = 0; i < 4; ++i) {
        float4 g4 = *(const float4*)(p.out_norm + hh * 64 + 16 * i + 4 * quad);
        f32x4 o;
        o[0] = y[i][j][0] * rs * g4.x; o[1] = y[i][j][1] * rs * g4.y; o[2] = y[i][j][2] * rs * g4.z; o[3] = y[i][j][3] * rs * g4.w;
        *(uint2*)(mix + (size_t)tok * 1536 + 512 + hh * 64 + 16 * i + 4 * quad) = pack4(o);
      }
    }
    __syncthreads();
  }
}

__device__ void gqa_tile8(const Params& p, char* smem, int tile) {
  const int tid = otid(), lane = tid & 63, wave = __builtin_amdgcn_readfirstlane(tid >> 6), l15 = lane & 15, quad = lane >> 4;
  const int rep = tile & 3, qb = (tile >> 2) & 3, kvh = (tile >> 4) & 3, b = tile >> 6;
  const int h = kvh * 4 + rep;
  const u16* Q1 = (const u16*)(p.ws + O_Q1);
  const u16* K1 = (const u16*)(p.ws + O_K1) + (size_t)(b * 2048) * 256 + kvh * 64;
  const u16* VT = (const u16*)(p.ws + O_VT1) + (size_t)((b * 4 + kvh) * 64) * 2048;
  u16* AO = (u16*)(p.ws + O_AO);
  const int tq0 = b * 2048 + qb * 512 + 64 * wave;
  bf16x8 qf[4][2];
#pragma unroll
  for (int j = 0; j < 4; ++j)
#pragma unroll
    for (int ks = 0; ks < 2; ++ks)
      qf[j][ks] = as_bf8(*(const uint4*)(Q1 + (size_t)(tq0 + 16 * j + l15) * 1024 + h * 64 + 32 * ks + 8 * quad));
  PG8_LAS unsigned char* lds = (PG8_LAS unsigned char*)smem;
  const int kr0 = 16 * wave + (lane >> 3), kr1 = kr0 + 8;
  const char* ksrc0 = (const char*)(K1 + (size_t)kr0 * 256) + ((((lane & 7) ^ ((kr0 >> 1) & 7))) << 4);
  const char* ksrc1 = (const char*)(K1 + (size_t)kr1 * 256) + ((((lane & 7) ^ ((kr1 >> 1) & 7))) << 4);
  const int vr0 = 8 * wave + (lane >> 4), vr1 = vr0 + 4;
  const char* vsrc0 = (const char*)(VT + (size_t)vr0 * 2048) + ((((lane & 15) ^ (vr0 & 15))) << 4);
  const char* vsrc1 = (const char*)(VT + (size_t)vr1 * 2048) + ((((lane & 15) ^ (vr1 & 15))) << 4);
  float shift;
  {
    float gq = fabsf(p.gqa_q_norm[lane]), gk = fabsf(p.gqa_k_norm[lane]);
#pragma unroll
    for (int o_ = 32; o_ >= 1; o_ >>= 1) { gq = fmaxf(gq, __shfl_xor(gq, o_)); gk = fmaxf(gk, __shfl_xor(gk, o_)); }
    shift = 8.f * gq * gk * LOG2E;
  }
  f32x4 o[4][4];
#pragma unroll
  for (int i = 0; i < 4; ++i)
#pragma unroll
    for (int j = 0; j < 4; ++j) o[i][j] = (f32x4){0.f, 0.f, 0.f, 0.f};
  f32x4 osum[4];
#pragma unroll
  for (int j = 0; j < 4; ++j) osum[j] = (f32x4){0.f, 0.f, 0.f, 0.f};
  const bf16x8 ones = {0x3F80, 0x3F80, 0x3F80, 0x3F80, 0x3F80, 0x3F80, 0x3F80, 0x3F80};
  const f32x4 sinit = {-shift, -shift, -shift, -shift};
#define GQ_ISSUE(t) do { const int _st = (t) & 3; \
    __builtin_amdgcn_global_load_lds((const unsigned*)(ksrc0 + (size_t)(t) * (128 * 512)), (PG8_LAS unsigned*)(lds + _st * 32768 + wave * 2048), 16, 0, 0); \
    __builtin_amdgcn_global_load_lds((const unsigned*)(ksrc1 + (size_t)(t) * (128 * 512)), (PG8_LAS unsigned*)(lds + _st * 32768 + wave * 2048 + 1024), 16, 0, 0); \
    __builtin_amdgcn_global_load_lds((const unsigned*)(vsrc0 + (t) * 256), (PG8_LAS unsigned*)(lds + _st * 32768 + 16384 + wave * 2048), 16, 0, 0); \
    __builtin_amdgcn_global_load_lds((const unsigned*)(vsrc1 + (t) * 256), (PG8_LAS unsigned*)(lds + _st * 32768 + 16384 + wave * 2048 + 1024), 16, 0, 0); } while (0)
#define GQ_BODY(st, hk, jb) do { \
    PG8_LAS const unsigned char* sK = lds + (st) * 32768; PG8_LAS const unsigned char* sV = sK + 16384; \
    f32x4 s[4][2]; \
    _Pragma("unroll") for (int i = 0; i < 4; ++i) { s[i][0] = sinit; s[i][1] = sinit; } \
    _Pragma("unroll") for (int ks = 0; ks < 2; ++ks) \
      _Pragma("unroll") for (int i = 0; i < 4; ++i) { \
        const int kr = 64 * (hk) + 16 * i + l15; \
        bf16x8 kf = *(PG8_LAS const bf16x8*)(sK + kr * 128 + (((4 * ks + quad) ^ ((kr >> 1) & 7)) << 4)); \
        s[i][0] = MFMA(kf, qf[(jb)][ks], s[i][0]); s[i][1] = MFMA(kf, qf[(jb) + 1][ks], s[i][1]); } \
    bf16x8 pf[2][2]; \
    _Pragma("unroll") for (int j = 0; j < 2; ++j) { \
      _Pragma("unroll") for (int i = 0; i < 4; ++i) \
        _Pragma("unroll") for (int r = 0; r < 4; ++r) s[i][j][r] = ex2(s[i][j][r]); \
      pf[j][0] = cat_bf8(pack4(s[0][j]), pack4(s[1][j])); pf[j][1] = cat_bf8(pack4(s[2][j]), pack4(s[3][j])); } \
    _Pragma("unroll") for (int ks2 = 0; ks2 < 2; ++ks2) \
      _Pragma("unroll") for (int i2 = 0; i2 < 4; ++i2) { \
        const int vd = 16 * i2 + l15; \
        bf16x8 vf = *(PG8_LAS const bf16x8*)(sV + vd * 256 + (((8 * (hk) + 4 * ks2 + quad) ^ (vd & 15)) << 4)); \
        o[i2][(jb)] = MFMA(vf, pf[0][ks2], o[i2][(jb)]); o[i2][(jb) + 1] = MFMA(vf, pf[1][ks2], o[i2][(jb) + 1]); } \
    _Pragma("unroll") for (int ks2 = 0; ks2 < 2; ++ks2) { osum[(jb)] = MFMA(ones, pf[0][ks2], osum[(jb)]); osum[(jb) + 1] = MFMA(ones, pf[1][ks2], osum[(jb) + 1]); } \
    __builtin_amdgcn_sched_barrier(0); \
  } while (0)
  __syncthreads();
  GQ_ISSUE(0); GQ_ISSUE(1);
  for (int kt = 0; kt < 16; ++kt) {
    if (kt + 2 < 16) GQ_ISSUE(kt + 2);
    if (kt < 14) asm volatile("s_waitcnt vmcnt(8)" ::: "memory");
    else if (kt == 14) asm volatile("s_waitcnt vmcnt(4)" ::: "memory");
    else asm volatile("s_waitcnt vmcnt(0)" ::: "memory");
    asm volatile("" ::: "memory"); __builtin_amdgcn_s_barrier(); asm volatile("" ::: "memory");
    const int st = kt & 3;
    GQ_BODY(st, 0, 0); GQ_BODY(st, 0, 2); GQ_BODY(st, 1, 0); GQ_BODY(st, 1, 2);
  }
#undef GQ_ISSUE
#undef GQ_BODY
#pragma unroll
  for (int j = 0; j < 4; ++j) {
    const float inv = 1.f / osum[j][0];
    const int tq = tq0 + 16 * j + l15;
#pragma unroll
    for (int i2 = 0; i2 < 4; ++i2) *(uint2*)(AO + (size_t)tq * 1024 + h * 64 + 16 * i2 + 4 * quad) = pack4(o[i2][j] * inv);
  }
}

#ifndef ONLY_PHASE
#define ONLY_PHASE -1
#endif
__device__ void run_phase(const Params& p, char* smem, int ph) {
  if (ONLY_PHASE >= 0 && ph != ONLY_PHASE) return;
  size_t wz = 0;
  asm volatile("" : "+s"(wz));
  char* ws = p.ws + wz;
  float* ssq = (float*)(ws + O_SSQ);
  u16* xb = (u16*)(ws + O_XB);
  const int half = __builtin_amdgcn_readfirstlane(threadIdx_x_raw() >> 8);
  char* sh = smem + half * 65536;
  const int G = gridDim.x, bid = blockIdx.x;
  const int vb = bid * 2 + half, nvb = G * 2;
  const bool is_gemm = (ph == 1) || (ph >= 5 && ph != 9);
  if (is_gemm) {
    const int nsub = (ph == 1 || ph == 8) ? 2 : 1;
    for (int sub = 0; sub < nsub; ++sub) {
      pg8::Gemm g{}; EpiAny E{}; E.ws = ws; E.zout = (u16*)p.out; E.perm = true; int c = bid;
      E.qn = (ph >= 8) ? p.gqa_q_norm : p.na_q_norm; E.kn = (ph >= 8) ? p.gqa_k_norm : p.na_k_norm;
      const bool l1 = ph >= 8;
      const u16* W13 = (const u16*)(ws + (l1 ? O_W13_1 : O_W13_0));
      const u16* W2 = (const u16*)(ws + (l1 ? O_W2_1 : O_W2_0));
      if (ph == 1 || ph == 8) {
        const float* sq = l1 ? ssq + 2 * T : nullptr;
        if (sub == 0) { g = pg8::Gemm{xb, (const u16*)(ws + (l1 ? O_WQKV1 : O_WIN0)), T, l1 ? 1280 : 4352, 1024}; E.kind = l1 ? EK_QK1 : EK_QK0; E.ssq_in = sq; }
        else { g = pg8::Gemm{(const u16*)(ws + (l1 ? O_WV1 : O_WV0)), xb, l1 ? 256 : 512, T, 1024}; E.kind = EK_VT; E.ssq_in = sq;
               E.o16 = (u16*)(ws + (l1 ? O_VT1 : O_VT0)); E.nh = l1 ? 4 : 8; c = (bid + G - 64) % G; }
      } else if (ph == 5 || ph == 10) {
        g = pg8::Gemm{(const u16*)(ws + (l1 ? O_AO : O_MIX)), (const u16*)(ws + (l1 ? O_WOUT1 : O_WOUT0)), T, 1024, l1 ? 1024 : 1536};
        E.kind = EK_RES; E.perm = false; E.res_in = l1 ? nullptr : p.x; E.res_out = nullptr; E.xb_out = xb; E.ssq_out = ssq + (l1 ? 3 * T : T);
      } else if (ph == 6 || ph == 11) {
        g = pg8::Gemm{xb, W13, T, 5632, 1024}; E.kind = EK_SWIGLU; E.ssq_in = ssq + (l1 ? 3 * T : T); E.o16 = (u16*)(ws + O_H);
      } else {
        g = pg8::Gemm{(const u16*)(ws + O_H), W2, T, 1024, 2816};
        E.kind = EK_RES; E.perm = false; E.res_in = nullptr; E.res_out = l1 ? p.out : nullptr; E.xb_out = xb; E.ssq_out = l1 ? nullptr : ssq + 2 * T;
      }
      pg8::StaticOrder S; S.init(g.M, g.N, G, c);
      pg8::gemm_phase(( PG8_LAS unsigned char*)smem, g, S, E);
      if (ph == 6 && G == 256 && bid >= 128) {
        const int tid = otid();
        phase_prep_l1(p, ws, (bid - 128) * 8 + (tid >> 6), 128 * 8, tid & 63);
      }
    }
    return;
  }
  switch (ph) {
    case 0: phase_prep(p); break;
    case 2: {
      PSUB(4) for (int t = vb; t < 2048; t += nvb) na_tile(p, t);
      PSUB(5) for (int t = vb; t < 1024; t += nvb) conv_tile(p, t);
      float* dtb = (float*)(ws + O_DTB);
      for (int idx = bid * 512 + otid(); idx < T * 32; idx += G * 512) {
        float v = dtb[idx] + p.dt_bias[idx & 31];
        const float ev = __builtin_amdgcn_exp2f(v * LOG2E);
        const float sp = (ev < 1e-3f) ? ev * (1.f - 0.5f * ev + 0.33333333f * ev * ev) : __builtin_amdgcn_logf(1.f + ev) * 0.6931471805599453f;
        dtb[idx] = (v > 20.f) ? v : sp;
      }
    } break;
    case 3: {
      for (int t0 = 0; t0 < 256; t0 += G) {
        int item = min(t0 + bid, 255);
        if (G == 256) {
          const int xcd = bid & 7, j = bid >> 3, grp = xcd * 4 + (j >> 3), idx8 = j & 7;
          item = (idx8 & 1) + 2 * ((grp & 3) * 4 + (idx8 >> 1)) + 32 * (grp >> 2);
        }
        scan_item8(p, smem, item);
      }
      if (G != 256) { const int tid = otid(); phase_prep_l1(p, ws, bid * 8 + (tid >> 6), G * 8, tid & 63); }
    } break;
    case 4:
      for (int t0 = 0; t0 < 512; t0 += nvb) ssd_out_tile(p, sh, min(t0 + vb, 511));
      break;
    case 9:
      if (G == 256) {
        const int xcd = bid & 7, j = bid >> 3;
        for (int r = 0; r < 2; ++r) gqa_tile8(p, smem, (r * 16 + xcd * 2 + (j >> 4)) * 16 + (j & 15));
      } else {
        for (int t0 = 0; t0 < 512; t0 += G) gqa_tile8(p, smem, min(t0 + bid, 511));
      }
      break;
    default: break;
  }
}

#define XB_TMO      128
#define XB_XCNT(j)  (256  + 64 * (j))
#define XB_XSUB(j)  (1280 + 64 * (j))
#define XB_XGEN(j)  (2304 + 64 * (j))
#define XB_TOP      3328
#define XB_TOPGEN   3392
#define XCD_BAR_WORDS 3456
#define XB_SPIN_CAP (1u << 18)
#define LAS __attribute__((address_space(3)))
DI unsigned xb_ld(unsigned* p) { return __hip_atomic_load(p, __ATOMIC_RELAXED, __HIP_MEMORY_SCOPE_AGENT); }
DI unsigned xb_add(unsigned* p, unsigned v) { return __hip_atomic_fetch_add(p, v, __ATOMIC_RELAXED, __HIP_MEMORY_SCOPE_AGENT); }
DI unsigned xb_xcc_id() { return (unsigned)__builtin_amdgcn_s_getreg((3 << 11) | 20) & 0xFu; }
#define XB_SPIN(cond, bar) do { unsigned _sp = 0; while (cond) { __builtin_amdgcn_s_sleep(1); \
    if ((++_sp & 255u) == 0u) { if (xb_ld(&(bar)[XB_TMO])) break; if (_sp > XB_SPIN_CAP) { atomicAdd(&(bar)[XB_TMO], 1u); break; } } } } while (0)
struct XcdBarrier { unsigned* bar; unsigned x; volatile LAS unsigned* st; };
DI XcdBarrier xcd_barrier_post(unsigned* bar, volatile LAS unsigned* st) {
  XcdBarrier b; b.bar = bar; b.x = xb_xcc_id(); b.st = st;
  if (threadIdx_x_raw() == 0) (void)xb_add(&bar[XB_XCNT(b.x)], 1u);
  return b;
}
DI void xcd_barrier_complete(unsigned* bar, unsigned x, unsigned& nloc, unsigned& nx) {
  const unsigned G = gridDim.x * gridDim.y * gridDim.z;
  unsigned sum, cnt, mine, sp = 0u;
  for (;;) {
    sum = 0u; cnt = 0u; mine = 0u;
#pragma unroll
    for (unsigned j = 0; j < 16; ++j) { const unsigned c = xb_ld(&bar[XB_XCNT(j)]); sum += c; cnt += (c > 0u) ? 1u : 0u; mine = (j == x) ? c : mine; }
    if (sum == G) break;
    __builtin_amdgcn_s_sleep(1);
    if ((++sp & 255u) == 0u) { if (xb_ld(&bar[XB_TMO])) break; if (sp > XB_SPIN_CAP) { atomicAdd(&bar[XB_TMO], 1u); break; } }
  }
  nloc = mine > 0u ? mine : 1u; nx = cnt > 0u ? cnt : 1u;
}
DI void xcd_barrier(const XcdBarrier& b) {
  asm volatile("s_waitcnt vmcnt(0)" ::: "memory");
  __syncthreads();
  if (threadIdx_x_raw() == 0) {
    unsigned* bar = b.bar;
    asm volatile("" : "+s"(bar));
    __builtin_amdgcn_s_waitcnt(0);
    unsigned nloc = b.st[0], nx = b.st[1];
    if (nloc == 0u) { xcd_barrier_complete(bar, b.x, nloc, nx); b.st[0] = nloc; b.st[1] = nx; }
    const unsigned old = xb_add(&bar[XB_XSUB(b.x)], 1u);
    const unsigned gen = old / nloc;
    if (old + 1u == (gen + 1u) * nloc) {
      __builtin_amdgcn_fence(__ATOMIC_RELEASE, "agent");
      asm volatile("s_waitcnt vmcnt(0)" ::: "memory");
      const unsigned og = xb_add(&bar[XB_TOP], 1u);
      const unsigned tg = og / nx;
      if (og + 1u == (tg + 1u) * nx) xb_add(&bar[XB_TOPGEN], 1u);
      else XB_SPIN(xb_ld(&bar[XB_TOPGEN]) == tg, bar);
      __builtin_amdgcn_fence(__ATOMIC_ACQUIRE, "agent");
      xb_add(&bar[XB_XGEN(b.x)], 1u);
      asm volatile("s_waitcnt vmcnt(0)" ::: "memory");
    } else {
      XB_SPIN(xb_ld(&bar[XB_XGEN(b.x)]) == gen, bar);
      __builtin_amdgcn_fence(__ATOMIC_ACQUIRE, "agent");
      asm volatile("s_waitcnt vmcnt(0)" ::: "memory");
    }
  }
  __syncthreads();
}

__global__ void __launch_bounds__(512, 2) mega(Params p) {
  extern __shared__ __attribute__((aligned(16))) char smem[];
  __shared__ uint4 xb_words;
  cg::grid_group grid = cg::this_grid();
  if (threadIdx_x_raw() == 0) xb_words = make_uint4(0u, 0u, 0u, 0u);
  __syncthreads();
  XcdBarrier xb = xcd_barrier_post((unsigned*)(p.ws + O_BAR), (volatile LAS unsigned*)&xb_words);
  if (p.ph0 < 0) grid.sync();
  for (int ph = p.ph0; ph < p.ph1; ++ph) {
    int nrep = 1;
#if PROBE_REP_MASK
    if ((PROBE_REP_MASK >> ph) & 1) nrep = 2;
#endif
    for (int r = 0; r < nrep; ++r) {
      run_phase(p, smem, ph);
      if (r + 1 < nrep || ph + 1 < p.ph1) xcd_barrier(xb);
    }
  }
#if PROBE_EXTRA_SYNCS
  for (int i = 0; i < PROBE_EXTRA_SYNCS; ++i) xcd_barrier(xb);
#endif
}

extern "C" void kernel_launch(void* const* d_in, const int* in_sizes, int n_in, void* d_out, int out_size, void* d_ws,
                              size_t ws_size, hipStream_t stream) {
  static int grid_blocks = 0;
  if (!grid_blocks) {
    (void)hipFuncSetAttribute((const void*)mega, hipFuncAttributeMaxDynamicSharedMemorySize, SMEM_BYTES);
    int dev = 0, cus = 0, per_cu = 0;
    (void)hipGetDevice(&dev);
    (void)hipDeviceGetAttribute(&cus, hipDeviceAttributeMultiprocessorCount, dev);
    (void)hipOccupancyMaxActiveBlocksPerMultiprocessor(&per_cu, mega, 512, SMEM_BYTES);
    if (per_cu < 1) per_cu = 1;
    grid_blocks = cus;
  }
  Params p{};
  const float** pp = (const float**)&p;
  for (int i = 0; i < 21; ++i) pp[i] = (const float*)d_in[i];
  p.out = (float*)d_out;
  p.ws = (char*)d_ws;
  (void)hipMemsetAsync((char*)d_ws + O_BAR, 0, XCD_BAR_WORDS * 4, stream);
#if MULTI_LAUNCH
  for (int ph = 0; ph < NPHASE; ++ph) {
    p.ph0 = ph; p.ph1 = ph + 1;
    hipLaunchKernelGGL(mega, dim3(grid_blocks), dim3(512), SMEM_BYTES, stream, p);
  }
#else
  p.ph0 = 0; p.ph1 = NPHASE;
  void* args[] = {&p};
  hipError_t e = hipLaunchCooperativeKernel((const void*)mega, dim3(grid_blocks), dim3(512), args, SMEM_BYTES, stream);
  if (e != hipSuccess) fprintf(stderr, "cooperative launch failed: %s (grid %d)\n", hipGetErrorString(e), grid_blocks);
#endif
}
```

```cpp
#include <hip/hip_runtime.h>
#include <hip/hip_bf16.h>
#include <hip/hip_cooperative_groups.h>
#include <cstdio>
namespace cg = cooperative_groups;

#define PROBE_REP_MASK 0
#define PROBE_EXTRA_SYNCS 0
#define PROBE_SUB 0
#define PSUB(k) for (int _r = 0; _r < ((PROBE_SUB == (k)) ? 2 : 1); ++_r)
#ifndef MULTI_LAUNCH
#define MULTI_LAUNCH 0
#endif

typedef __attribute__((ext_vector_type(8))) short bf16x8;
typedef __attribute__((ext_vector_type(4))) float f32x4;
typedef __attribute__((ext_vector_type(2))) float f32x2;
typedef __attribute__((ext_vector_type(2))) __bf16 bf16v2;
typedef unsigned short u16;
typedef unsigned u32x4v __attribute__((ext_vector_type(4)));

#define DI __device__ __forceinline__
#define MFMA(a, b, c) __builtin_amdgcn_mfma_f32_16x16x32_bf16((a), (b), (c), 0, 0, 0)

constexpr int T = 16384;
constexpr float EPS = 1e-6f;
constexpr float LOG2E = 1.4426950408889634f;
constexpr int NPHASE = 13;
constexpr int SMEM_BYTES = 131072 + 8192;

constexpr size_t MIB = 1u << 20;
constexpr size_t O_WIN0 = 0;
constexpr size_t O_WV0 = O_WIN0 + 4352ull * 1024 * 2;
constexpr size_t O_WOUT0 = O_WV0 + 512ull * 1024 * 2;
constexpr size_t O_W13_0 = O_WOUT0 + 1024ull * 1536 * 2;
constexpr size_t O_W2_0 = O_W13_0 + 5632ull * 1024 * 2;
constexpr size_t O_ROPE = 31 * MIB;
constexpr size_t O_DTB = O_ROPE + 524288;
constexpr size_t O_SSQ = O_DTB + 2097152;
constexpr size_t O_BAR = O_SSQ + 262144;
constexpr size_t O_XB = 34 * MIB;
constexpr size_t O_BN = O_XB;
constexpr size_t O_BT = O_XB + 16 * MIB;
constexpr size_t O_Q0 = 66 * MIB;
constexpr size_t O_K0 = 82 * MIB;
constexpr size_t O_VT0 = 98 * MIB;
constexpr size_t O_WQKV1 = 66 * MIB;
constexpr size_t O_WV1 = O_WQKV1 + 1280ull * 1024 * 2;
constexpr size_t O_WOUT1 = O_WV1 + 256ull * 1024 * 2;
constexpr size_t O_W13_1 = O_WOUT1 + 1024ull * 1024 * 2;
constexpr size_t O_W2_1 = O_W13_1 + 5632ull * 1024 * 2;
constexpr size_t O_BIG = 114 * MIB;
constexpr size_t O_XBC = O_BIG;
constexpr size_t O_HPREV = O_BIG;
constexpr size_t O_CN = O_BIG + 64 * MIB;
constexpr size_t O_MIX = O_BIG + 80 * MIB;
constexpr size_t O_H = O_BIG;
constexpr size_t O_Q1 = O_BIG;
constexpr size_t O_K1 = O_BIG + 32 * MIB;
constexpr size_t O_VT1 = O_BIG + 40 * MIB;
constexpr size_t O_AO = O_BIG + 48 * MIB;

struct Params {
  const float *x, *even_mix_norm, *even_w_in, *na_q_norm, *na_k_norm, *na_rel_bias, *conv_w, *conv_b, *dt_bias, *A_log,
      *Dskip, *out_norm, *even_w_out, *odd_mix_norm, *odd_w_qkv, *gqa_q_norm, *gqa_k_norm, *odd_w_out, *ffn_norm,
      *ffn_w13, *ffn_w2;
  float* out;
  char* ws;
  int ph0, ph1;
};

__device__ __forceinline__ int threadIdx_x_raw() { return (int)__builtin_amdgcn_workitem_id_x(); }
DI unsigned pack2(float a, float b) {
  f32x2 v = {a, b};
  bf16v2 r = __builtin_convertvector(v, bf16v2);
  return __builtin_bit_cast(unsigned, r);
}
DI uint2 pack4(f32x4 v) { return make_uint2(pack2(v[0], v[1]), pack2(v[2], v[3])); }
DI u16 f2bf(float a) { return (u16)(pack2(a, 0.f) & 0xffffu); }
DI float bflo(unsigned u) { return __uint_as_float(u << 16); }
DI float bfhi(unsigned u) { return __uint_as_float(u & 0xffff0000u); }
DI float bf2f(u16 h) { return __uint_as_float(((unsigned)h) << 16); }
DI bf16x8 as_bf8(uint4 v) { return __builtin_bit_cast(bf16x8, v); }
DI bf16x8 cat_bf8(uint2 a, uint2 b) { return as_bf8(make_uint4(a.x, a.y, b.x, b.y)); }
DI int vtid() { int t = threadIdx_x_raw() & 255; asm volatile("" : "+v"(t)); return t; }
DI int otid() { int t = threadIdx_x_raw(); asm volatile("" : "+v"(t)); return t; }
DI float silu(float x) { return x * __builtin_amdgcn_rcpf(1.f + __builtin_amdgcn_exp2f(-1.4426950408889634f * x)); }
DI float ex2(float x) { return __builtin_amdgcn_exp2f(x); }
DI float xor16_32_sum(float v) { v += __shfl_xor(v, 16); v += __shfl_xor(v, 32); return v; }
DI float xor16_32_max(float v) { v = fmaxf(v, __shfl_xor(v, 16)); v = fmaxf(v, __shfl_xor(v, 32)); return v; }
DI void wave_sync_lds() { __builtin_amdgcn_fence(__ATOMIC_ACQ_REL, "wavefront"); __builtin_amdgcn_wave_barrier(); }
DI void unpack8(uint4 u, float* f) {
  f[0] = bflo(u.x); f[1] = bfhi(u.x); f[2] = bflo(u.y); f[3] = bfhi(u.y);
  f[4] = bflo(u.z); f[5] = bfhi(u.z); f[6] = bflo(u.w); f[7] = bfhi(u.w);
}

struct WDesc { const float* W; int ldn, K, rows; u16* dst; const float* gain; int mode, coloff; };
DI int wt_srccol(int mode, int R, int coloff) {
  if (mode == 0) return coloff + R;
  const int pn = R >> 8, c = R & 255, bj = c >> 7, j = c & 127;
  if (mode == 1) return bj * 2816 + pn * 128 + j;
  const int wc = j >> 5, e = j & 31;
  if (mode == 2) {
    if (pn < 4) return (pn >> 1) * 512 + ((pn & 1) * 4 + wc) * 64 + bj * 32 + e;
    if (pn < 8) return 1536 + (R - 1024);
    if (pn < 16) return 2560 + (R - 2048);
    return (R - 4096 < 32) ? 4608 + (R - 4096) : -1;
  }
  if (pn < 4) return (pn * 4 + wc) * 64 + bj * 32 + e;
  return 1024 + wc * 64 + bj * 32 + e;
}
__device__ void wt_item(const WDesc& d, int item, int lane) {
  const int nr = d.rows >> 6, nn = item % nr, kk = item / nr;
  const int R = nn * 64 + lane;
  const int sc = wt_srccol(d.mode, R, d.coloff);
  typedef __attribute__((address_space(1))) const float gfloat_c;
  typedef __attribute__((address_space(1))) u32x4v gu32x4;
  gfloat_c* src = (gfloat_c*)(d.W + (sc >= 0 ? sc : 0));
  gfloat_c* gain = (gfloat_c*)d.gain;
  u16* dst = d.dst + (size_t)R * d.K + kk * 64;
#pragma unroll 2
  for (int k8 = 0; k8 < 8; ++k8) {
    float v[8];
#pragma unroll
    for (int e = 0; e < 8; ++e) {
      const int k = kk * 64 + k8 * 8 + e;
      float x = src[(size_t)k * d.ldn];
      if (d.gain) x *= gain[k];
      v[e] = (sc >= 0) ? x : 0.f;
    }
    const u32x4v pk = {pack2(v[0], v[1]), pack2(v[2], v[3]), pack2(v[4], v[5]), pack2(v[6], v[7])};
    *(gu32x4*)(dst + k8 * 8) = pk;
  }
}
DI WDesc wt_desc(const Params& p, char* ws, int set, int i) {
  if (set == 0) {
    switch (i) {
      case 0: return WDesc{p.even_w_in, 4640, 1024, 4352, (u16*)(ws + O_WIN0), p.even_mix_norm, 2, 0};
      case 1: return WDesc{p.even_w_in, 4640, 1024, 512, (u16*)(ws + O_WV0), p.even_mix_norm, 0, 1024};
      case 2: return WDesc{p.even_w_out, 1024, 1536, 1024, (u16*)(ws + O_WOUT0), nullptr, 0, 0};
      case 3: return WDesc{p.ffn_w13, 5632, 1024, 5632, (u16*)(ws + O_W13_0), p.ffn_norm, 1, 0};
      default: return WDesc{p.ffn_w2, 1024, 2816, 1024, (u16*)(ws + O_W2_0), nullptr, 0, 0};
    }
  }
  switch (i) {
    case 0: return WDesc{p.odd_w_qkv, 1536, 1024, 1280, (u16*)(ws + O_WQKV1), p.odd_mix_norm, 3, 0};
    case 1: return WDesc{p.odd_w_qkv, 1536, 1024, 256, (u16*)(ws + O_WV1), p.odd_mix_norm, 0, 1280};
    case 2: return WDesc{p.odd_w_out, 1024, 1024, 1024, (u16*)(ws + O_WOUT1), nullptr, 0, 0};
    case 3: return WDesc{p.ffn_w13 + (size_t)1024 * 5632, 5632, 1024, 5632, (u16*)(ws + O_W13_1), p.ffn_norm + 1024, 1, 0};
    default: return WDesc{p.ffn_w2 + (size_t)2816 * 1024, 1024, 2816, 1024, (u16*)(ws + O_W2_1), nullptr, 0, 0};
  }
}
__device__ void wt_run(const Params& p, char* ws, int set, int gw, int nw, int lane) {
  const int c0 = set ? 320 : 1088, c1 = c0 + (set ? 64 : 128), c2 = c1 + (set ? 256 : 384), c3 = c2 + 1408, total = c3 + 704;
  for (int it = gw; it < total; it += nw) {
    const int i = it < c0 ? 0 : it < c1 ? 1 : it < c2 ? 2 : it < c3 ? 3 : 4;
    const int base = i == 0 ? 0 : i == 1 ? c0 : i == 2 ? c1 : i == 3 ? c2 : c3;
    const WDesc d = wt_desc(p, ws, set, i);
    wt_item(d, it - base, lane);
  }
}

__device__ void phase_prep(const Params& p) {
  size_t wz = 0;
  asm volatile("" : "+s"(wz));
  char* ws = p.ws + wz;
  const int tid = otid(), lane = tid & 63;
  const int gw = blockIdx.x * 8 + (tid >> 6), nw = gridDim.x * 8;
  PSUB(1) wt_run(p, ws, 0, gw, nw, lane);
  PSUB(2) for (int row0 = gw * 4; row0 < T; row0 += nw * 4) {
    float4 v[4][4];
#pragma unroll
    for (int rr = 0; rr < 4; ++rr)
#pragma unroll
      for (int i = 0; i < 4; ++i) v[rr][i] = *(const float4*)(p.x + (size_t)(row0 + rr) * 1024 + i * 256 + lane * 4);
#pragma unroll
    for (int rr = 0; rr < 4; ++rr) {
      u16* xb = (u16*)(ws + O_XB) + (size_t)(row0 + rr) * 1024;
      float ss = 0.f;
#pragma unroll
      for (int i = 0; i < 4; ++i) { const float4 a = v[rr][i]; ss += a.x * a.x + a.y * a.y + a.z * a.z + a.w * a.w; }
#pragma unroll
      for (int o = 32; o >= 1; o >>= 1) ss += __shfl_xor(ss, o);
      const float rs = rsqrtf(ss * (1.f / 1024.f) + EPS);
#pragma unroll
      for (int i = 0; i < 4; ++i) {
        const float4 a = v[rr][i];
        *(uint2*)(xb + i * 256 + lane * 4) = make_uint2(pack2(a.x * rs, a.y * rs), pack2(a.z * rs, a.w * rs));
      }
      if (lane == 0) {
        float* ssq = (float*)(ws + O_SSQ);
        const int row = row0 + rr;
        ssq[row] = ss; ssq[T + row] = 0.f; ssq[2 * T + row] = 0.f; ssq[3 * T + row] = 0.f;
      }
    }
  }
  PSUB(3) for (int idx = blockIdx.x * 512 + tid; idx < 65536; idx += gridDim.x * 512) {
    int s = idx >> 5, pp = idx & 31;
    float pos = (pp < 16) ? (float)(s >> 6) : (float)(s & 63);
    float freq = __builtin_amdgcn_exp2f(-(float)(pp & 15) * (13.287712379549449f / 16.f));
    float sn, cs;
    sincosf(pos * freq, &sn, &cs);
    ((float2*)(ws + O_ROPE))[idx] = make_float2(cs, sn);
  }
}
__device__ void phase_prep_l1(const Params& p, char* ws, int gw, int nw, int lane) { wt_run(p, ws, 1, gw, nw, lane); }
namespace pg8 {
#define PG8_LAS __attribute__((address_space(3)))
typedef unsigned short bf16_t;
constexpr int BM = 256, BK = 64, HALF = 128, HTB = HALF * BK * 2, STAGE_BYTES = 8 * HTB, NXCD = 8, WGM = 8;
DI int lds_byte(int r, int c) { const int st = (r >> 4) * 2 + (c >> 5), rr = r & 15, cc = c & 31, ob = rr * 64 + cc * 2; return st * 1024 + (ob ^ (((ob >> 9) & 1) << 5)); }
DI void stage_rc(int b, int& R, int& C) { const int st = b / 1024, sb = b % 1024, swz = sb ^ (((sb >> 9) & 1) << 5); R = (st >> 1) * 16 + swz / 64; C = (st & 1) * 32 + (swz % 64) / 2; }
DI int perm32(int rho) { const int n = rho >> 4, i = rho & 15; return 8 * (i >> 2) + 4 * n + (i & 3); }
struct Unit { int pm, pn; };
struct Gemm { const bf16_t* A; const bf16_t* Bt; int M, N, K; };
struct StaticOrder {
  int nM, nN, nwg, G, c;
  DI void init(int M, int N, int G_, int c_) { nM = M / BM; nN = N / BM; nwg = nM * nN; G = G_; c = c_; }
  DI bool next(int i, Unit& u) const {
    const long L = (long)i * G + c; if (L >= nwg) return false;
    int wgid = (int)L; { const int q = nwg / NXCD, r = nwg % NXCD, xcd = wgid % NXCD, off = wgid / NXCD; wgid = (xcd < r ? xcd * (q + 1) : r * (q + 1) + (xcd - r) * q) + off; }
    const int nig = WGM * nN, gid = wgid / nig, fm = gid * WGM, gsz = (nM - fm) < WGM ? (nM - fm) : WGM;
    u.pm = fm + ((wgid % nig) % gsz); u.pn = (wgid % nig) / gsz; return true;
  }
};
template <class Epi>
DI void gemm_phase(PG8_LAS unsigned char* lds, const Gemm g, const StaticOrder& S, const Epi& E) {
  const int tid = otid(), wid = __builtin_amdgcn_readfirstlane(tid >> 6), lane = tid & 63, wr = wid >> 2, wc = wid & 3, fr = lane & 15, fq = lane >> 4;
  const int K = g.K, nt = K / BK;
  unsigned voffA[2], voffB[2];
#pragma unroll
  for (int i = 0; i < 2; ++i) { int R, C; stage_rc(tid * 16 + i * 8192, R, C); const int Rb = E.perm ? ((R & ~31) + perm32(R & 31)) : R;
    voffA[i] = (unsigned)(R * K + C) * 2u; voffB[i] = (unsigned)(Rb * K + C) * 2u; }
  const size_t kstep = (size_t)(BK * 2);
  const size_t hstep = (size_t)HALF * K * 2;
  const size_t tstep = 2 * hstep;
  const unsigned ldsw = (unsigned)wid * 1024u;
  const int aoff = lds_byte(wr * 64 + fr, fq * 8), boff = lds_byte(wc * 32 + fr, fq * 8);
#define PG8_SA(b, h) (((b) * 2 + (h)) * HTB)
#define PG8_SB(b, h) ((4 + (b) * 2 + (h)) * HTB)
#define PG8_STAGE(bufoff, gbase, voff) do { _Pragma("unroll") for (int _i = 0; _i < 2; ++_i) \
    __builtin_amdgcn_global_load_lds((const unsigned*)((const char*)(gbase) + (voff)[_i]), (PG8_LAS unsigned*)(lds + (bufoff) + ldsw + _i * 8192), 16, 0, 0); } while (0)
#define PG8_LDA(dst, b, h) do { _Pragma("unroll") for (int m = 0; m < 4; ++m) _Pragma("unroll") for (int k = 0; k < 2; ++k) dst[m][k] = *(const PG8_LAS bf16x8*)(lds + PG8_SA(b, h) + aoff + m * 2048 + k * 1024); } while (0)
#define PG8_LDB(dst, b, h) do { _Pragma("unroll") for (int n = 0; n < 2; ++n) _Pragma("unroll") for (int k = 0; k < 2; ++k) dst[n][k] = *(const PG8_LAS bf16x8*)(lds + PG8_SB(b, h) + boff + n * 2048 + k * 1024); } while (0)
#define PG8_MMA(ai, bj, At, Bt) do { __builtin_amdgcn_s_setprio(1); _Pragma("unroll") for (int m = 0; m < 4; ++m) _Pragma("unroll") for (int n = 0; n < 2; ++n) _Pragma("unroll") for (int k = 0; k < 2; ++k) \
    acc[ai][bj][m][n] = __builtin_amdgcn_mfma_f32_16x16x32_bf16(Bt[n][k], At[m][k], acc[ai][bj][m][n], 0, 0, 0); __builtin_amdgcn_s_setprio(0); } while (0)
#define PG8_WAIT_V(n) asm volatile("s_waitcnt vmcnt(" #n ")" ::: "memory")
#define PG8_WAIT_L(n) asm volatile("s_waitcnt lgkmcnt(" #n ")" ::: "memory")
#define PG8_BAR __builtin_amdgcn_s_barrier()
#define PG8_SCHED __builtin_amdgcn_sched_barrier(0)
  Unit cur, nxt; int ui = 0;
  if (!S.next(0, cur)) return;
  if (E.ssq_in) {
    PG8_LAS float* rtab = (PG8_LAS float*)(lds + 131072);
    Unit uu;
    for (int q = 0; q < 8 && S.next(q, uu); ++q)
      if (tid < 256) rtab[q * 256 + tid] = rsqrtf(E.ssq_in[(E.kind == 4 ? uu.pn : uu.pm) * 256 + tid] * (1.f / 1024.f) + EPS);
    __syncthreads();
  }
  f32x4 acc[2][2][4][2];
#pragma unroll
  for (int a = 0; a < 2; ++a)
#pragma unroll
    for (int b = 0; b < 2; ++b)
#pragma unroll
      for (int m = 0; m < 4; ++m)
#pragma unroll
        for (int n = 0; n < 2; ++n) acc[a][b][m][n] = (f32x4){0.f, 0.f, 0.f, 0.f};
  bf16x8 At[4][2], B0[2][2], B1[2][2];
  const char* cA = (const char*)g.A + (size_t)cur.pm * tstep; const char* cB = (const char*)g.Bt + (size_t)cur.pn * tstep;
  PG8_STAGE(PG8_SB(0, 0), cB, voffB); PG8_STAGE(PG8_SA(0, 0), cA, voffA); PG8_STAGE(PG8_SB(0, 1), cB + hstep, voffB); PG8_STAGE(PG8_SA(0, 1), cA + hstep, voffA);
  if (wr == 1) PG8_BAR;
  PG8_WAIT_V(4); PG8_BAR;
  PG8_STAGE(PG8_SB(1, 0), cB + kstep, voffB); PG8_STAGE(PG8_SA(1, 0), cA + kstep, voffA); PG8_STAGE(PG8_SB(1, 1), cB + hstep + kstep, voffB);
  PG8_WAIT_V(6); PG8_BAR;
  for (;;) {
    const bool has_next = S.next(ui + 1, nxt);
    const char* nA = has_next ? (const char*)g.A + (size_t)nxt.pm * tstep : cA; const char* nB = has_next ? (const char*)g.Bt + (size_t)nxt.pn * tstep : cB;
    for (int t = 0; t < nt; t += 2) {
      const bool last = (t == nt - 2);
      const char* a1 = cA + (size_t)(t + 1) * kstep;
      const char* a2 = last ? nA : cA + (size_t)(t + 2) * kstep; const char* b2 = last ? nB : cB + (size_t)(t + 2) * kstep;
      const char* a3 = a2 + kstep; const char* b3 = b2 + kstep;
      PG8_LDB(B0, 0, 0); PG8_SCHED; PG8_LDA(At, 0, 0); PG8_STAGE(PG8_SA(1, 1), a1 + hstep, voffA);
      PG8_WAIT_L(8); PG8_BAR; PG8_WAIT_L(0); PG8_MMA(0, 0, At, B0); PG8_BAR; PG8_SCHED;
      PG8_LDB(B1, 0, 1); PG8_STAGE(PG8_SB(0, 0), b2, voffB);
      PG8_BAR; PG8_WAIT_L(0); PG8_MMA(0, 1, At, B1); PG8_BAR;
      PG8_LDA(At, 0, 1); PG8_STAGE(PG8_SA(0, 0), a2, voffA);
      PG8_BAR; PG8_WAIT_L(0); PG8_MMA(1, 0, At, B0); PG8_BAR; PG8_SCHED;
      PG8_STAGE(PG8_SB(0, 1), b2 + hstep, voffB);
      PG8_WAIT_V(6); PG8_BAR; PG8_MMA(1, 1, At, B1); PG8_BAR;
      PG8_LDB(B0, 1, 0); PG8_SCHED; PG8_LDA(At, 1, 0); PG8_STAGE(PG8_SA(0, 1), a2 + hstep, voffA);
      PG8_WAIT_L(8); PG8_BAR; PG8_WAIT_L(0); PG8_MMA(0, 0, At, B0); PG8_BAR; PG8_SCHED;
      PG8_LDB(B1, 1, 1); PG8_STAGE(PG8_SB(1, 0), b3, voffB);
      PG8_BAR; PG8_WAIT_L(0); PG8_MMA(0, 1, At, B1); PG8_BAR;
      PG8_LDA(At, 1, 1); PG8_STAGE(PG8_SA(1, 0), a3, voffA);
      PG8_BAR; PG8_WAIT_L(0); PG8_MMA(1, 0, At, B0); PG8_BAR; PG8_SCHED;
      PG8_STAGE(PG8_SB(1, 1), b3 + hstep, voffB);
      PG8_WAIT_V(6); PG8_BAR; PG8_MMA(1, 1, At, B1); PG8_BAR;
    }
    E(acc, cur, wr, wc, fr, fq, (const PG8_LAS float*)(lds + 131072) + ui * 256);
    if (!has_next) break;
#pragma unroll
    for (int a = 0; a < 2; ++a)
#pragma unroll
      for (int b = 0; b < 2; ++b)
#pragma unroll
        for (int m = 0; m < 4; ++m)
#pragma unroll
          for (int n = 0; n < 2; ++n) acc[a][b][m][n] = (f32x4){0.f, 0.f, 0.f, 0.f};
    cur = nxt; cA = nA; cB = nB; ++ui;
  }
  PG8_WAIT_V(0);
  if (wr == 0) PG8_BAR;
  PG8_BAR;
#undef PG8_SA
#undef PG8_SB
#undef PG8_STAGE
#undef PG8_LDA
#undef PG8_LDB
#undef PG8_MMA
#undef PG8_WAIT_V
#undef PG8_WAIT_L
#undef PG8_BAR
#undef PG8_SCHED
}
}

typedef f32x4 AccT[2][2][4][2];
DI uint4 pack8(f32x4 a, f32x4 b) { return make_uint4(pack2(a[0], a[1]), pack2(a[2], a[3]), pack2(b[0], b[1]), pack2(b[2], b[3])); }

struct EpiRes {
  static constexpr bool PERM = false;
  const float* res_f32; u16* xb; float* out_f32; float* ssq_out;
  DI void operator()(const AccT& acc, const pg8::Unit& u, int wr, int wc, int fr, int fq, const PG8_LAS float* rtab) const {
    const int row0 = u.pm * 256 + wr * 64 + fr, col0 = u.pn * 256 + wc * 32 + 4 * fq;
#pragma unroll
    for (int ai = 0; ai < 2; ++ai)
#pragma unroll
      for (int m = 0; m < 4; ++m) {
        const size_t r = row0 + ai * 128 + m * 16;
        float part = 0.f;
#pragma unroll
        for (int bj = 0; bj < 2; ++bj)
#pragma unroll
          for (int n = 0; n < 2; ++n) {
            const int c = col0 + bj * 128 + n * 16;
            float4 r4;
            if (res_f32) r4 = *(const float4*)(res_f32 + r * 1024 + c);
            else { uint2 rr = *(const uint2*)(xb + r * 1024 + c); r4 = make_float4(bflo(rr.x), bfhi(rr.x), bflo(rr.y), bfhi(rr.y)); }
            f32x4 a = acc[ai][bj][m][n];
            float4 v = make_float4(r4.x + a[0], r4.y + a[1], r4.z + a[2], r4.w + a[3]);
            if (out_f32) *(float4*)(out_f32 + r * 1024 + c) = v;
            else *(uint2*)(xb + r * 1024 + c) = make_uint2(pack2(v.x, v.y), pack2(v.z, v.w));
            part += v.x * v.x + v.y * v.y + v.z * v.z + v.w * v.w;
          }
        if (ssq_out) {
          part = xor16_32_sum(part);
          if (fq == 0) atomicAdd(ssq_out + r, part);
        }
      }
  }
};

struct EpiSwiglu {
  static constexpr bool PERM = true;
  const float* ssq_in; u16* h_out;
  DI void operator()(const AccT& acc, const pg8::Unit& u, int wr, int wc, int fr, int fq, const PG8_LAS float* rtab) const {
    const int row0 = u.pm * 256 + wr * 64 + fr;
#pragma unroll
    for (int ai = 0; ai < 2; ++ai)
#pragma unroll
      for (int m = 0; m < 4; ++m) {
        const size_t r = row0 + ai * 128 + m * 16;
        const float rs = rtab[ai * 128 + wr * 64 + m * 16 + fr];
        f32x4 h0, h1;
#pragma unroll
        for (int e = 0; e < 4; ++e) {
          h0[e] = silu(acc[ai][0][m][0][e] * rs) * (acc[ai][1][m][0][e] * rs);
          h1[e] = silu(acc[ai][0][m][1][e] * rs) * (acc[ai][1][m][1][e] * rs);
        }
        *(uint4*)(h_out + r * 2816 + u.pn * 128 + wc * 32 + 8 * fq) = pack8(h0, h1);
      }
  }
};

template <int L1>
struct EpiQK {
  static constexpr bool PERM = true;
  char* ws; u16* zout; const float* qn; const float* kn; const float* ssq_in;
  DI void operator()(const AccT& acc, const pg8::Unit& u, int wr, int wc, int fr, int fq, const PG8_LAS float* rtab) const {
    const int pn = u.pn;
    const int row0 = u.pm * 256 + wr * 64 + fr;
    const bool headnorm = L1 ? true : (pn < 4);
    const bool is_q = L1 ? (pn < 4) : (pn < 2);
#pragma unroll
    for (int ai = 0; ai < 2; ++ai)
#pragma unroll
      for (int m = 0; m < 4; ++m) {
        const size_t r = row0 + ai * 128 + m * 16;
        const float rs = L1 ? rtab[ai * 128 + wr * 64 + m * 16 + fr] : 1.f;
        f32x4 v[2][2];
#pragma unroll
        for (int bj = 0; bj < 2; ++bj)
#pragma unroll
          for (int n = 0; n < 2; ++n) v[bj][n] = acc[ai][bj][m][n] * rs;
        if (headnorm) {
          float ss = 0.f;
#pragma unroll
          for (int bj = 0; bj < 2; ++bj)
#pragma unroll
            for (int n = 0; n < 2; ++n)
              ss += v[bj][n][0] * v[bj][n][0] + v[bj][n][1] * v[bj][n][1] + v[bj][n][2] * v[bj][n][2] + v[bj][n][3] * v[bj][n][3];
          ss = xor16_32_sum(ss);
          const float hn = rsqrtf(ss * (1.f / 64.f) + EPS) * (is_q ? 0.125f * LOG2E : 1.f);
          const float* gn = is_q ? qn : kn;
#pragma unroll
          for (int bj = 0; bj < 2; ++bj)
#pragma unroll
            for (int n = 0; n < 2; ++n) {
              float4 g4 = *(const float4*)(gn + bj * 32 + 8 * fq + 4 * n);
              v[bj][n][0] *= hn * g4.x; v[bj][n][1] *= hn * g4.y; v[bj][n][2] *= hn * g4.z; v[bj][n][3] *= hn * g4.w;
            }
          u16* dst;
          if (L1) {
            const int s = (int)(r & 2047);
            const float4* rt = (const float4*)(ws + O_ROPE) + (size_t)s * 16;
#pragma unroll
            for (int bj = 0; bj < 2; ++bj)
#pragma unroll
              for (int n = 0; n < 2; ++n) {
                float4 cs = rt[bj * 8 + 2 * fq + n];
                float a0 = v[bj][n][0], a1 = v[bj][n][1], b0 = v[bj][n][2], b1 = v[bj][n][3];
                v[bj][n][0] = a0 * cs.x - a1 * cs.y; v[bj][n][1] = a0 * cs.y + a1 * cs.x;
                v[bj][n][2] = b0 * cs.z - b1 * cs.w; v[bj][n][3] = b0 * cs.w + b1 * cs.z;
              }
            dst = is_q ? (u16*)(ws + O_Q1) + r * 1024 + (pn * 4 + wc) * 64 : (u16*)(ws + O_K1) + r * 256 + wc * 64;
          } else {
            dst = (is_q ? (u16*)(ws + O_Q0) : (u16*)(ws + O_K0)) + r * 512 + ((pn & 1) * 4 + wc) * 64;
          }
#pragma unroll
          for (int bj = 0; bj < 2; ++bj) *(uint4*)(dst + bj * 32 + 8 * fq) = pack8(v[bj][0], v[bj][1]);
        } else if (pn < 8) {
          u16* dst = zout + r * 1024 + (pn - 4) * 256 + wc * 32 + 8 * fq;
#pragma unroll
          for (int bj = 0; bj < 2; ++bj) *(uint4*)(dst + bj * 128) = pack8(v[bj][0], v[bj][1]);
        } else if (pn < 16) {
          u16* dst = (u16*)(ws + O_XBC) + r * 2048 + (pn - 8) * 256 + wc * 32 + 8 * fq;
#pragma unroll
          for (int bj = 0; bj < 2; ++bj) *(uint4*)(dst + bj * 128) = pack8(v[bj][0], v[bj][1]);
        } else if (wc == 0) {
          float* dst = (float*)(ws + O_DTB) + r * 32 + 8 * fq;
          *(float4*)(dst) = make_float4(v[0][0][0], v[0][0][1], v[0][0][2], v[0][0][3]);
          *(float4*)(dst + 4) = make_float4(v[0][1][0], v[0][1][1], v[0][1][2], v[0][1][3]);
        }
      }
  }
};

struct EpiVT {
  static constexpr bool PERM = true;
  const float* ssq_in; u16* vt; int nh;
  DI void operator()(const AccT& acc, const pg8::Unit& u, int wr, int wc, int fr, int fq, const PG8_LAS float* rtab) const {
#pragma unroll
    for (int bj = 0; bj < 2; ++bj) {
      const int tok0 = u.pn * 256 + bj * 128 + wc * 32 + 8 * fq;
      f32x4 r0 = {1.f, 1.f, 1.f, 1.f}, r1 = r0;
      if (ssq_in) {
        const int lo = bj * 128 + wc * 32 + 8 * fq;
        r0 = *(const PG8_LAS f32x4*)(rtab + lo); r1 = *(const PG8_LAS f32x4*)(rtab + lo + 4);
      }
      const int b = tok0 >> 11, s = tok0 & 2047;
#pragma unroll
      for (int ai = 0; ai < 2; ++ai)
#pragma unroll
        for (int m = 0; m < 4; ++m) {
          const int f = u.pm * 256 + ai * 128 + wr * 64 + m * 16 + fr;
          const int hd = f >> 6, d = f & 63;
          u16* dstp = vt + ((size_t)((b * nh + hd) * 64 + d)) * 2048;
          const uint4 pk = pack8(acc[ai][bj][m][0] * r0, acc[ai][bj][m][1] * r1);
          if (nh == 4) {
            const int c = (s >> 3) & 3, pos0 = (s & ~31) + 16 * (c & 1) + 4 * (c >> 1);
            *(uint2*)(dstp + pos0) = make_uint2(pk.x, pk.y);
            *(uint2*)(dstp + pos0 + 8) = make_uint2(pk.z, pk.w);
          } else {
            *(uint4*)(dstp + s) = pk;
          }
        }
    }
  }
};
enum { EK_RES = 0, EK_SWIGLU = 1, EK_QK0 = 2, EK_QK1 = 3, EK_VT = 4 };
struct EpiAny {
  int kind; bool perm;
  char* ws; u16* zout; const float* qn; const float* kn; const float* ssq_in; float* ssq_out; const float* res_in; float* res_out; u16* xb_out; u16* o16; int nh;
  DI void operator()(const AccT& acc, const pg8::Unit& u, int wr, int wc, int fr, int fq, const PG8_LAS float* rtab) const {
    switch (kind) {
      case EK_RES: { EpiRes e{res_in, xb_out, res_out, ssq_out}; e(acc, u, wr, wc, fr, fq, rtab); } break;
      case EK_SWIGLU: { EpiSwiglu e{ssq_in, o16}; e(acc, u, wr, wc, fr, fq, rtab); } break;
      case EK_QK0: { EpiQK<0> e{ws, zout, qn, kn, ssq_in}; e(acc, u, wr, wc, fr, fq, rtab); } break;
      case EK_QK1: { EpiQK<1> e{ws, zout, qn, kn, ssq_in}; e(acc, u, wr, wc, fr, fq, rtab); } break;
      default: { EpiVT e{ssq_in, o16, nh}; e(acc, u, wr, wc, fr, fq, rtab); } break;
    }
  }
};

__device__ void na_tile(const Params& p, int tile) {
  const int tid = vtid(), lane = tid & 63, wave = tid >> 6, l15 = lane & 15, quad = lane >> 4;
  const int h = tile & 7, r = (tile >> 3) & 31, b = tile >> 8;
  const int c0 = min(max(16 * wave - 8, 0), 32);
  const int rs = min(max(r - 4, 0), 24);
  const u16* Q0 = (const u16*)(p.ws + O_Q0);
  const u16* K0 = (const u16*)(p.ws + O_K0) + (size_t)(b * 2048 + rs * 64 + c0 + 8 * (l15 >> 2) + (l15 & 3)) * 512 + h * 64 + 8 * quad;
  const u16* VT = (const u16*)(p.ws + O_VT0) + (size_t)((b * 8 + h) * 64 + l15) * 2048 + rs * 64 + c0 + 8 * quad;
  u16* mix = (u16*)(p.ws + O_MIX);
  const int tq = b * 2048 + r * 64 + 16 * wave + l15;
  bf16x8 qf[2];
#pragma unroll
  for (int ks = 0; ks < 2; ++ks) qf[ks] = as_bf8(*(const uint4*)(Q0 + (size_t)tq * 512 + h * 64 + 32 * ks + 8 * quad));
  const int cq = 16 * wave + l15;
  const int cs = min(max(cq - 8, 0), 48);
  const float* rpb = p.na_rel_bias + h * 465 + (rs - r + 7) * 31;
  const int d0 = c0 + 8 * quad - cq;
  const int w0 = d0 + cq - cs;
  f32x4 s[16];
  uint4 kb[2][4];
#pragma unroll
  for (int q4 = 0; q4 < 4; ++q4) kb[0][q4] = *(const uint4*)(K0 + (size_t)(4 * (q4 >> 1)) * 512 + 32 * (q4 & 1));
#pragma unroll
  for (int jr = 0; jr < 8; ++jr) {
    if (jr + 1 < 8) {
#pragma unroll
      for (int q4 = 0; q4 < 4; ++q4)
        kb[(jr + 1) & 1][q4] = *(const uint4*)(K0 + (size_t)((jr + 1) * 64 + 4 * (q4 >> 1)) * 512 + 32 * (q4 & 1));
    }
    float bias[8];
#pragma unroll
    for (int e = 0; e < 8; ++e) bias[e] = rpb[jr * 31 + min(max(d0 + 4 * (e >> 2) + (e & 3), -15), 15) + 15];
#pragma unroll
    for (int tt = 0; tt < 2; ++tt) {
      f32x4 a = {0.f, 0.f, 0.f, 0.f};
      a = MFMA(as_bf8(kb[jr & 1][2 * tt]), qf[0], a);
      a = MFMA(as_bf8(kb[jr & 1][2 * tt + 1]), qf[1], a);
#pragma unroll
      for (int rr = 0; rr < 4; ++rr) a[rr] = ((unsigned)(w0 + 4 * tt + rr) < 16u) ? (a[rr] + bias[tt * 4 + rr] * LOG2E) : -INFINITY;
      s[jr * 2 + tt] = a;
    }
  }
  float mx = -INFINITY;
#pragma unroll
  for (int u = 0; u < 16; ++u) mx = fmaxf(mx, fmaxf(fmaxf(s[u][0], s[u][1]), fmaxf(s[u][2], s[u][3])));
  mx = xor16_32_max(mx);
  uint4 vbuf[3][4];
#define NA_VLOAD(jr, dst) do { \
    _Pragma("unroll") for (int i2 = 0; i2 < 4; ++i2) dst[i2] = *(const uint4*)(VT + (size_t)(16 * i2) * 2048 + (jr) * 64); } while (0)
  NA_VLOAD(0, vbuf[0]);
  NA_VLOAD(1, vbuf[1]);
  float sum = 0.f;
#pragma unroll
  for (int u = 0; u < 16; ++u)
#pragma unroll
    for (int rr = 0; rr < 4; ++rr) { float pv = ex2(s[u][rr] - mx); s[u][rr] = pv; sum += pv; }
  sum = xor16_32_sum(sum);
  f32x4 o[4];
#pragma unroll
  for (int i2 = 0; i2 < 4; ++i2) o[i2] = (f32x4){0.f, 0.f, 0.f, 0.f};
#pragma unroll
  for (int jr = 0; jr < 8; ++jr) {
    if (jr + 2 < 8) NA_VLOAD(jr + 2, vbuf[(jr + 2) % 3]);
    bf16x8 pf = cat_bf8(pack4(s[2 * jr]), pack4(s[2 * jr + 1]));
#pragma unroll
    for (int i2 = 0; i2 < 4; ++i2) o[i2] = MFMA(as_bf8(vbuf[jr % 3][i2]), pf, o[i2]);
  }
#undef NA_VLOAD
  const float inv = 1.f / sum;
#pragma unroll
  for (int i2 = 0; i2 < 4; ++i2) *(uint2*)(mix + (size_t)tq * 1536 + h * 64 + 16 * i2 + 4 * quad) = pack4(o[i2] * inv);
}

__device__ void conv_tile(const Params& p, int tile) {
  const int tb = tile >> 2, cb = tile & 3;
  const int ch = cb * 512 + 2 * vtid();
  const int b = tb >> 5, s0 = (tb & 31) * 64;
  float w[4][2], bias[2];
#pragma unroll
  for (int k = 0; k < 4; ++k) { const float2 t = *(const float2*)(p.conv_w + k * 2048 + ch); w[k][0] = t.x; w[k][1] = t.y; }
  { const float2 t = *(const float2*)(p.conv_b + ch); bias[0] = t.x; bias[1] = t.y; }
  const u16* src = (const u16*)(p.ws + O_XBC) + (size_t)(b * 2048) * 2048 + ch;
  unsigned um2 = (s0 >= 2) ? *(const unsigned*)(src + (size_t)(s0 - 2) * 2048) : 0u;
  unsigned um1 = (s0 >= 1) ? *(const unsigned*)(src + (size_t)(s0 - 1) * 2048) : 0u;
  unsigned u0 = *(const unsigned*)(src + (size_t)s0 * 2048);
  u16* XT = (u16*)p.out + 16 * MIB;
  for (int sg = 0; sg < 8; ++sg) {
    unsigned nx[8];
#pragma unroll
    for (int e = 0; e < 8; ++e) { const int s = s0 + sg * 8 + e; nx[e] = (s + 1 < 2048) ? *(const unsigned*)(src + (size_t)(s + 1) * 2048) : 0u; }
    float y[2][8];
#pragma unroll
    for (int e = 0; e < 8; ++e) {
      const unsigned up1 = nx[e];
      y[0][e] = silu(w[0][0] * bflo(um2) + w[1][0] * bflo(um1) + w[2][0] * bflo(u0) + w[3][0] * bflo(up1) + bias[0]);
      y[1][e] = silu(w[0][1] * bfhi(um2) + w[1][1] * bfhi(um1) + w[2][1] * bfhi(u0) + w[3][1] * bfhi(up1) + bias[1]);
      um2 = um1; um1 = u0; u0 = up1;
    }
    const int sb = s0 + sg * 8;
    if (cb < 3) {
      u16* dstT = (cb < 2) ? XT + (size_t)(b * 1024 + ch) * 2048 + sb : (u16*)(p.ws + O_BT) + (size_t)(b * 512 + (ch - 1024)) * 2048 + sb;
#pragma unroll
      for (int c2 = 0; c2 < 2; ++c2)
        *(uint4*)(dstT + (size_t)c2 * 2048) = make_uint4(pack2(y[c2][0], y[c2][1]), pack2(y[c2][2], y[c2][3]), pack2(y[c2][4], y[c2][5]), pack2(y[c2][6], y[c2][7]));
    }
    if (cb >= 2) {
      u16* nat = (cb == 2) ? (u16*)(p.ws + O_BN) + (size_t)(b * 2048 + sb) * 512 + (ch - 1024)
                           : (u16*)(p.ws + O_CN) + (size_t)(b * 2048 + sb) * 512 + (ch - 1536);
#pragma unroll
      for (int e = 0; e < 8; ++e) *(unsigned*)(nat + e * 512) = pack2(y[0][e], y[1][e]);
    }
  }
}

__device__ void scan_item8(const Params& p, char* smem, int item) {
  const int tid = otid(), lane = tid & 63, wave = __builtin_amdgcn_readfirstlane(tid >> 6), l15 = lane & 15, quad = lane >> 4;
  const int dir = item & 1, h = (item >> 1) & 15, b = item >> 5, g = h >> 2;
  const float Ah = -__expf(p.A_log[dir * 16 + h]) * LOG2E;
  PG8_LAS float* wall = (PG8_LAS float*)((PG8_LAS unsigned char*)smem + 65536);
  PG8_LAS float* cdall = wall + 2048;
  const float* dtb = (const float*)(p.ws + O_DTB);
#pragma unroll
  for (int cc = 0; cc < 2; ++cc) {
    const int c = 2 * wave + cc;
    const int tokb = b * 2048 + c * 128;
    const float d0 = dtb[(size_t)(tokb + 2 * lane) * 32 + dir * 16 + h];
    const float d1 = dtb[(size_t)(tokb + 2 * lane + 1) * 32 + dir * 16 + h];
    const float a0 = d0 * Ah, a1 = d1 * Ah, ps = a0 + a1;
    float incl = ps;
#pragma unroll
    for (int o = 1; o < 64; o <<= 1) { float tv = __shfl_up(incl, o); if (lane >= o) incl += tv; }
    const float total = __shfl(incl, 63);
    const float excl = incl - ps;
    float w0, w1;
    if (dir == 0) { w0 = ex2(total - (excl + a0)) * d0; w1 = ex2(total - incl) * d1; }
    else { w0 = ex2(excl) * d0; w1 = ex2(excl + a0) * d1; }
    wall[c * 128 + 2 * lane] = w0; wall[c * 128 + 2 * lane + 1] = w1;
    if (lane == 0) cdall[c] = ex2(total);
  }
  __syncthreads();
  const int drow = 8 * wave + (lane >> 4);
  const u16* XTg = (const u16*)p.out + 16 * MIB + (size_t)(b * 1024 + h * 64) * 2048;
  const char* xsrc0 = (const char*)(XTg + (size_t)drow * 2048) + (((lane & 15) ^ (drow & 15)) << 4);
  const char* xsrc1 = (const char*)(XTg + (size_t)(drow + 4) * 2048) + (((lane & 15) ^ ((drow + 4) & 15)) << 4);
  PG8_LAS unsigned char* lds = (PG8_LAS unsigned char*)smem;
  const u16* BT = (const u16*)(p.ws + O_BT) + (size_t)(b * 512 + g * 128 + 16 * wave + l15) * 2048 + 8 * quad;
  u16* HP = (u16*)(p.ws + O_HPREV);
  f32x4 acc[4];
#pragma unroll
  for (int j = 0; j < 4; ++j) acc[j] = (f32x4){0.f, 0.f, 0.f, 0.f};
  u32x4v bA[4], bB[4], bC[4], bD[4];
#define SC_ISSUE(Bf, st, c) do { \
    __builtin_amdgcn_global_load_lds((const unsigned*)(xsrc0 + (c) * 256), (PG8_LAS unsigned*)(lds + (st) * 16384 + wave * 2048), 16, 0, 0); \
    __builtin_amdgcn_global_load_lds((const unsigned*)(xsrc1 + (c) * 256), (PG8_LAS unsigned*)(lds + (st) * 16384 + wave * 2048 + 1024), 16, 0, 0); \
    { const u16* _bp = BT + (c) * 128; \
      asm volatile("global_load_dwordx4 %0, %4, off\n\tglobal_load_dwordx4 %1, %4, off offset:64\n\tglobal_load_dwordx4 %2, %4, off offset:128\n\tglobal_load_dwordx4 %3, %4, off offset:192" \
                   : "=&v"(Bf[0]), "=&v"(Bf[1]), "=&v"(Bf[2]), "=&v"(Bf[3]) : "v"(_bp) : "memory"); } } while (0)
#define SC_STEP(Bf, st, c) do { \
    u16* hp = HP + ((size_t)(((b * 16 + (c)) * 16 + h) * 2 + dir) << 13); \
    _Pragma("unroll") for (int j = 0; j < 4; ++j) *(uint2*)(hp + (16 * j + l15) * 128 + 16 * wave + 4 * quad) = pack4(acc[j]); \
    const float cd = cdall[(c)]; \
    _Pragma("unroll") for (int j = 0; j < 4; ++j) acc[j] *= cd; \
    _Pragma("unroll") for (int ks = 0; ks < 4; ++ks) { \
      const f32x4 wav = *(const PG8_LAS f32x4*)(wall + (c) * 128 + 32 * ks + 8 * quad); \
      const f32x4 wbv = *(const PG8_LAS f32x4*)(wall + (c) * 128 + 32 * ks + 8 * quad + 4); \
      const float4 wa = make_float4(wav[0], wav[1], wav[2], wav[3]), wb = make_float4(wbv[0], wbv[1], wbv[2], wbv[3]); \
      _Pragma("unroll") for (int j = 0; j < 4; ++j) { \
        const u32x4v rawv = *(const PG8_LAS u32x4v*)(lds + (st) * 16384 + (16 * j + l15) * 256 + (((4 * ks + quad) ^ l15) << 4)); \
        const uint4 raw = make_uint4(rawv[0], rawv[1], rawv[2], rawv[3]); uint4 sc; \
        sc.x = pack2(bflo(raw.x) * wa.x, bfhi(raw.x) * wa.y); sc.y = pack2(bflo(raw.y) * wa.z, bfhi(raw.y) * wa.w); \
        sc.z = pack2(bflo(raw.z) * wb.x, bfhi(raw.z) * wb.y); sc.w = pack2(bflo(raw.w) * wb.z, bfhi(raw.w) * wb.w); \
        acc[j] = MFMA(__builtin_bit_cast(bf16x8, Bf[ks]), as_bf8(sc), acc[j]); } } } while (0)
#define SC_CH(s) (dir ? 15 - (s) : (s))
  SC_ISSUE(bA, 0, SC_CH(0)); SC_ISSUE(bB, 1, SC_CH(1)); SC_ISSUE(bC, 2, SC_CH(2));
#define SC_BAR() do { asm volatile("" ::: "memory"); __builtin_amdgcn_s_barrier(); asm volatile("" ::: "memory"); } while (0)
#define SC_WAIT(nlast, Bf) do { if (s4 == 12) asm volatile("s_waitcnt vmcnt(" #nlast ")" : "+v"(Bf[0]), "+v"(Bf[1]), "+v"(Bf[2]), "+v"(Bf[3]) :: "memory"); \
    else asm volatile("s_waitcnt vmcnt(18)" : "+v"(Bf[0]), "+v"(Bf[1]), "+v"(Bf[2]), "+v"(Bf[3]) :: "memory"); } while (0)
  for (int s4 = 0; s4 < 16; s4 += 4) {
    SC_ISSUE(bD, 3, SC_CH(s4 + 3));
    SC_WAIT(18, bA); SC_BAR();
    SC_STEP(bA, 0, SC_CH(s4));
    SC_BAR();
    if (s4 + 4 < 16) SC_ISSUE(bA, 0, SC_CH(s4 + 4));
    SC_WAIT(12, bB); SC_BAR();
    SC_STEP(bB, 1, SC_CH(s4 + 1));
    SC_BAR();
    if (s4 + 5 < 16) SC_ISSUE(bB, 1, SC_CH(s4 + 5));
    SC_WAIT(6, bC); SC_BAR();
    SC_STEP(bC, 2, SC_CH(s4 + 2));
    SC_BAR();
    if (s4 + 6 < 16) SC_ISSUE(bC, 2, SC_CH(s4 + 6));
    SC_WAIT(0, bD); SC_BAR();
    SC_STEP(bD, 3, SC_CH(s4 + 3));
    SC_BAR();
  }
#undef SC_BAR
#undef SC_WAIT
#undef SC_ISSUE
#undef SC_STEP
#undef SC_CH
  asm volatile("s_waitcnt vmcnt(0)" ::: "memory");
  __syncthreads();
}

__device__ void ssd_out_tile(const Params& p, char* smem, int tile) {
  const int tid = vtid(), lane = tid & 63, wave = tid >> 6, l15 = lane & 15, quad = lane >> 4;
  const int g = tile & 3, c = (tile >> 2) & 15, b = tile >> 6;
  const int hh = g * 4 + wave;
  u16* Gs = (u16*)smem;
  float* wv = (float*)(smem + 34816) + wave * 512;
  float* red = (float*)(smem + 34816 + 8192);
  const int tok0 = b * 2048 + c * 128;
  const u16* Cn = (const u16*)(p.ws + O_CN) + (size_t)tok0 * 512 + g * 128;
  const u16* Bn = (const u16*)(p.ws + O_BN) + (size_t)tok0 * 512 + g * 128;
  const float* dtb = (const float*)(p.ws + O_DTB);
  {
    f32x4 ga[8][2];
#pragma unroll
    for (int i = 0; i < 8; ++i) { ga[i][0] = (f32x4){0.f, 0.f, 0.f, 0.f}; ga[i][1] = ga[i][0]; }
#pragma unroll 2
    for (int ks = 0; ks < 4; ++ks) {
      bf16x8 cf[2];
#pragma unroll
      for (int jj = 0; jj < 2; ++jj)
        cf[jj] = as_bf8(*(const uint4*)(Cn + (size_t)(16 * (2 * wave + jj) + l15) * 512 + 32 * ks + 8 * quad));
#pragma unroll
      for (int i = 0; i < 8; ++i) {
        bf16x8 bf = as_bf8(*(const uint4*)(Bn + (size_t)(16 * i + l15) * 512 + 32 * ks + 8 * quad));
        ga[i][0] = MFMA(bf, cf[0], ga[i][0]);
        ga[i][1] = MFMA(bf, cf[1], ga[i][1]);
      }
    }
#pragma unroll
    for (int i = 0; i < 8; ++i)
#pragma unroll
      for (int jj = 0; jj < 2; ++jj)
        *(uint2*)(Gs + (16 * (2 * wave + jj) + l15) * 136 + 16 * i + 4 * quad) = pack4(ga[i][jj]);
  }
  {
    const float Af = -__expf(p.A_log[hh]) * LOG2E, Ab = -__expf(p.A_log[16 + hh]) * LOG2E;
    const float d0f = dtb[(size_t)(tok0 + 2 * lane) * 32 + hh], d1f = dtb[(size_t)(tok0 + 2 * lane + 1) * 32 + hh];
    const float d0b = dtb[(size_t)(tok0 + 2 * lane) * 32 + 16 + hh], d1b = dtb[(size_t)(tok0 + 2 * lane + 1) * 32 + 16 + hh];
    const float a0 = d0f * Af, a1 = d1f * Af, c0 = d0b * Ab, c1 = d1b * Ab;
    float inf_ = a0 + a1, inb = c0 + c1;
#pragma unroll
    for (int o = 1; o < 64; o <<= 1) {
      float t1 = __shfl_up(inf_, o), t2 = __shfl_up(inb, o);
      if (lane >= o) { inf_ += t1; inb += t2; }
    }
    const float totb = __shfl(inb, 63);
    const float exf = inf_ - (a0 + a1), exb = inb - (c0 + c1);
    *(float2*)(wv + 2 * lane) = make_float2(exf + a0, inf_);
    *(float2*)(wv + 128 + 2 * lane) = make_float2(totb - exb, totb - (exb + c0));
    *(float2*)(wv + 256 + 2 * lane) = make_float2(d0f, d1f);
    *(float2*)(wv + 384 + 2 * lane) = make_float2(d0b, d1b);
  }
  __syncthreads();
  const float Dh = p.Dskip[hh];
  const int prow = 8 * (l15 >> 2) + (l15 & 3);
  const u16* XT = (const u16*)p.out + 16 * MIB + (size_t)(b * 1024 + hh * 64) * 2048 + c * 128;
  const u16* hf = (const u16*)(p.ws + O_HPREV) + ((size_t)(((b * 16 + c) * 16 + hh) * 2) << 13);
  const u16* hb = hf + 8192;
  const u16* Z = (const u16*)p.out;
  u16* mix = (u16*)(p.ws + O_MIX);
  #pragma unroll 1
  for (int jh = 0; jh < 2; ++jh) {
    f32x4 y[4][4];
    {
      float efv[4], ebv[4];
#pragma unroll
      for (int j = 0; j < 4; ++j) {
        const int l = 64 * jh + 16 * j + l15;
        efv[j] = ex2(wv[l]); ebv[j] = ex2(wv[128 + l]);
      }
#pragma unroll
      for (int i = 0; i < 4; ++i)
#pragma unroll
        for (int j = 0; j < 4; ++j) y[i][j] = (f32x4){0.f, 0.f, 0.f, 0.f};
#pragma unroll 2
      for (int ks = 0; ks < 4; ++ks) {
        bf16x8 cF[4], cB[4];
#pragma unroll
        for (int j = 0; j < 4; ++j) {
          const uint4 raw = *(const uint4*)(Cn + (size_t)(64 * jh + 16 * j + l15) * 512 + 32 * ks + 8 * quad);
          float f[8];
          unpack8(raw, f);
          cF[j] = as_bf8(make_uint4(pack2(f[0] * efv[j], f[1] * efv[j]), pack2(f[2] * efv[j], f[3] * efv[j]), pack2(f[4] * efv[j], f[5] * efv[j]), pack2(f[6] * efv[j], f[7] * efv[j])));
          cB[j] = as_bf8(make_uint4(pack2(f[0] * ebv[j], f[1] * ebv[j]), pack2(f[2] * ebv[j], f[3] * ebv[j]), pack2(f[4] * ebv[j], f[5] * ebv[j]), pack2(f[6] * ebv[j], f[7] * ebv[j])));
        }
#pragma unroll
        for (int i = 0; i < 4; ++i) {
          bf16x8 f1 = as_bf8(*(const uint4*)(hf + (32 * (i >> 1) + 4 * (i & 1) + prow) * 128 + 32 * ks + 8 * quad));
          bf16x8 f2 = as_bf8(*(const uint4*)(hb + (32 * (i >> 1) + 4 * (i & 1) + prow) * 128 + 32 * ks + 8 * quad));
#pragma unroll
          for (int j = 0; j < 4; ++j) { y[i][j] = MFMA(f1, cF[j], y[i][j]); y[i][j] = MFMA(f2, cB[j], y[i][j]); }
        }
      }
    }
#pragma unroll 2
    for (int ks = 0; ks < 4; ++ks) {
      const int sb = 32 * ks + 8 * quad;
      float afs[8], rbs[8], d0s[8], d1s[8];
      *(float4*)(afs) = *(const float4*)(wv + sb); *(float4*)(afs + 4) = *(const float4*)(wv + sb + 4);
      *(float4*)(rbs) = *(const float4*)(wv + 128 + sb); *(float4*)(rbs + 4) = *(const float4*)(wv + 128 + sb + 4);
      *(float4*)(d0s) = *(const float4*)(wv + 256 + sb); *(float4*)(d0s + 4) = *(const float4*)(wv + 256 + sb + 4);
      *(float4*)(d1s) = *(const float4*)(wv + 384 + sb); *(float4*)(d1s + 4) = *(const float4*)(wv + 384 + sb + 4);
      bf16x8 xf[4];
#pragma unroll
      for (int i = 0; i < 4; ++i) xf[i] = as_bf8(*(const uint4*)(XT + (size_t)(32 * (i >> 1) + 4 * (i & 1) + prow) * 2048 + sb));
#pragma unroll
      for (int j = 0; j < 4; ++j) {
        const int l = 64 * jh + 16 * j + l15;
        const float afl = wv[l], rbl = wv[128 + l];
        float gv[8], m[8];
        unpack8(*(const uint4*)(Gs + l * 136 + sb), gv);
#pragma unroll
        for (int e = 0; e < 8; ++e) {
          const int s = sb + e;
          float ff = (s <= l) ? ex2(afl - afs[e]) * d0s[e] : 0.f;
          float fb = (s >= l) ? ex2(rbl - rbs[e]) * d1s[e] : 0.f;
          m[e] = gv[e] * (ff + fb) + ((s == l) ? Dh : 0.f);
        }
        bf16x8 mf = as_bf8(make_uint4(pack2(m[0], m[1]), pack2(m[2], m[3]), pack2(m[4], m[5]), pack2(m[6], m[7])));
#pragma unroll
        for (int i = 0; i < 4; ++i) y[i][j] = MFMA(xf[i], mf, y[i][j]);
      }
    }
#pragma unroll
    for (int j = 0; j < 4; ++j) {
      const int tok = tok0 + 64 * jh + 16 * j + l15;
      float part = 0.f;
#pragma unroll
      for (int k = 0; k < 2; ++k) {
        const uint4 zr = *(const uint4*)(Z + (size_t)tok * 1024 + hh * 64 + 32 * k + 8 * quad);
        y[2 * k][j][0] *= silu(bflo(zr.x)); y[2 * k][j][1] *= silu(bfhi(zr.x)); y[2 * k][j][2] *= silu(bflo(zr.y)); y[2 * k][j][3] *= silu(bfhi(zr.y));
        part += y[2 * k][j][0] * y[2 * k][j][0] + y[2 * k][j][1] * y[2 * k][j][1] + y[2 * k][j][2] * y[2 * k][j][2] + y[2 * k][j][3] * y[2 * k][j][3];
        y[2 * k + 1][j][0] *= silu(bflo(zr.z)); y[2 * k + 1][j][1] *= silu(bfhi(zr.z)); y[2 * k + 1][j][2] *= silu(bflo(zr.w)); y[2 * k + 1][j][3] *= silu(bfhi(zr.w));
        part += y[2 * k + 1][j][0] * y[2 * k + 1][j][0] + y[2 * k + 1][j][1] * y[2 * k + 1][j][1] + y[2 * k + 1][j][2] * y[2 * k + 1][j][2] + y[2 * k + 1][j][3] * y[2 * k + 1][j][3];
      }
      part = xor16_32_sum(part);
      if (quad == 0) red[wave * 64 + 16 * j + l15] = part;
    }
    __syncthreads();
#pragma unroll
    for (int j = 0; j < 4; ++j) {
      const int tok = tok0 + 64 * jh + 16 * j + l15;
      const int q = 16 * j + l15;
      const float tot = red[q] + red[64 + q] + red[128 + q] + red[192 + q];
      const float rs = rsqrtf(tot * (1.f / 256.f) + EPS);
#pragma unroll
      for (int k = 0; k < 2; ++k) {
        const float4 ga = *(const float4*)(p.out_norm + hh * 64 + 32 * k + 8 * quad);
        const float4 gb = *(const float4*)(p.out_norm + hh * 64 + 32 * k + 8 * quad + 4);
        f32x4 oa, ob;
        oa[0] = y[2 * k][j][0] * rs * ga.x; oa[1] = y[2 * k][j][1] * rs * ga.y; oa[2] = y[2 * k][j][2] * rs * ga.z; oa[3] = y[2 * k][j][3] * rs * ga.w;
        ob[0] = y[2 * k + 1][j][0] * rs * gb.x; ob[1] = y[2 * k + 1][j][1] * rs * gb.y; ob[2] = y[2 * k + 1][j][2] * rs * gb.z; ob[3] = y[2 * k + 1][j][3] * rs * gb.w;
        *(uint4*)(mix + (size_t)tok * 1536 + 512 + hh * 64 + 32 * k + 8 * quad) = pack8(oa, ob);
      }
    }
    __syncthreads();
  }
}

__device__ void gqa_tile8(const Params& p, char* smem, int tile) {
  const int tid = otid(), lane = tid & 63, wave = __builtin_amdgcn_readfirstlane(tid >> 6), l15 = lane & 15, quad = lane >> 4;
  const int rep = tile & 3, qb = (tile >> 2) & 3, kvh = (tile >> 4) & 3, b = tile >> 6;
  const int h = kvh * 4 + rep;
  const u16* Q1 = (const u16*)(p.ws + O_Q1);
  const u16* K1 = (const u16*)(p.ws + O_K1) + (size_t)(b * 2048) * 256 + kvh * 64;
  const u16* VT = (const u16*)(p.ws + O_VT1) + (size_t)((b * 4 + kvh) * 64) * 2048;
  u16* AO = (u16*)(p.ws + O_AO);
  const int tq0 = b * 2048 + qb * 512 + 64 * wave;
  bf16x8 qf[4][2];
#pragma unroll
  for (int j = 0; j < 4; ++j)
#pragma unroll
    for (int ks = 0; ks < 2; ++ks)
      qf[j][ks] = as_bf8(*(const uint4*)(Q1 + (size_t)(tq0 + 16 * j + l15) * 1024 + h * 64 + 32 * ks + 8 * quad));
  PG8_LAS unsigned char* lds = (PG8_LAS unsigned char*)smem;
  const int kr0 = 16 * wave + (lane >> 3), kr1 = kr0 + 8;
  const char* ksrc0 = (const char*)(K1 + (size_t)kr0 * 256) + ((((lane & 7) ^ ((kr0 >> 1) & 7))) << 4);
  const char* ksrc1 = (const char*)(K1 + (size_t)kr1 * 256) + ((((lane & 7) ^ ((kr1 >> 1) & 7))) << 4);
  const int vr0 = 8 * wave + (lane >> 4), vr1 = vr0 + 4;
  const char* vsrc0 = (const char*)(VT + (size_t)vr0 * 2048) + ((((lane & 15) ^ (vr0 & 15))) << 4);
  const char* vsrc1 = (const char*)(VT + (size_t)vr1 * 2048) + ((((lane & 15) ^ (vr1 & 15))) << 4);
  float shift;
  {
    float gq = fabsf(p.gqa_q_norm[lane]), gk = fabsf(p.gqa_k_norm[lane]);
#pragma unroll
    for (int o_ = 32; o_ >= 1; o_ >>= 1) { gq = fmaxf(gq, __shfl_xor(gq, o_)); gk = fmaxf(gk, __shfl_xor(gk, o_)); }
    shift = 8.f * gq * gk * LOG2E;
  }
  f32x4 o[4][4];
#pragma unroll
  for (int i = 0; i < 4; ++i)
#pragma unroll
    for (int j = 0; j < 4; ++j) o[i][j] = (f32x4){0.f, 0.f, 0.f, 0.f};
  f32x4 osum[4];
#pragma unroll
  for (int j = 0; j < 4; ++j) osum[j] = (f32x4){0.f, 0.f, 0.f, 0.f};
  const bf16x8 ones = {0x3F80, 0x3F80, 0x3F80, 0x3F80, 0x3F80, 0x3F80, 0x3F80, 0x3F80};
  const f32x4 sinit = {-shift, -shift, -shift, -shift};
#define GQ_ISSUE(t) do { const int _st = (t) & 3; \
    __builtin_amdgcn_global_load_lds((const unsigned*)(ksrc0 + (size_t)(t) * (128 * 512)), (PG8_LAS unsigned*)(lds + _st * 32768 + wave * 2048), 16, 0, 0); \
    __builtin_amdgcn_global_load_lds((const unsigned*)(ksrc1 + (size_t)(t) * (128 * 512)), (PG8_LAS unsigned*)(lds + _st * 32768 + wave * 2048 + 1024), 16, 0, 0); \
    __builtin_amdgcn_global_load_lds((const unsigned*)(vsrc0 + (t) * 256), (PG8_LAS unsigned*)(lds + _st * 32768 + 16384 + wave * 2048), 16, 0, 0); \
    __builtin_amdgcn_global_load_lds((const unsigned*)(vsrc1 + (t) * 256), (PG8_LAS unsigned*)(lds + _st * 32768 + 16384 + wave * 2048 + 1024), 16, 0, 0); } while (0)
#define GQ_BODY(st, hk, jb) do { \
    PG8_LAS const unsigned char* sK = lds + (st) * 32768; PG8_LAS const unsigned char* sV = sK + 16384; \
    f32x4 s[4][2]; \
    _Pragma("unroll") for (int i = 0; i < 4; ++i) { s[i][0] = sinit; s[i][1] = sinit; } \
    _Pragma("unroll") for (int ks = 0; ks < 2; ++ks) \
      _Pragma("unroll") for (int i = 0; i < 4; ++i) { \
        const int kr = 64 * (hk) + 16 * i + l15; \
        bf16x8 kf = *(PG8_LAS const bf16x8*)(sK + kr * 128 + (((4 * ks + quad) ^ ((kr >> 1) & 7)) << 4)); \
        s[i][0] = MFMA(kf, qf[(jb)][ks], s[i][0]); s[i][1] = MFMA(kf, qf[(jb) + 1][ks], s[i][1]); } \
    bf16x8 pf[2][2]; \
    _Pragma("unroll") for (int j = 0; j < 2; ++j) { \
      _Pragma("unroll") for (int i = 0; i < 4; ++i) \
        _Pragma("unroll") for (int r = 0; r < 4; ++r) s[i][j][r] = ex2(s[i][j][r]); \
      pf[j][0] = cat_bf8(pack4(s[0][j]), pack4(s[1][j])); pf[j][1] = cat_bf8(pack4(s[2][j]), pack4(s[3][j])); } \
    _Pragma("unroll") for (int ks2 = 0; ks2 < 2; ++ks2) \
      _Pragma("unroll") for (int i2 = 0; i2 < 4; ++i2) { \
        const int vd = 16 * i2 + l15; \
        bf16x8 vf = *(PG8_LAS const bf16x8*)(sV + vd * 256 + (((8 * (hk) + 4 * ks2 + quad) ^ (vd & 15)) << 4)); \
        o[i2][(jb)] = MFMA(vf, pf[0][ks2], o[i2][(jb)]); o[i2][(jb) + 1] = MFMA(vf, pf[1][ks2], o[i2][(jb) + 1]); } \
    _Pragma("unroll") for (int ks2 = 0; ks2 < 2; ++ks2) { osum[(jb)] = MFMA(ones, pf[0][ks2], osum[(jb)]); osum[(jb) + 1] = MFMA(ones, pf[1][ks2], osum[(jb) + 1]); } \
    __builtin_amdgcn_sched_barrier(0); \
  } while (0)
  __syncthreads();
  GQ_ISSUE(0); GQ_ISSUE(1);
  for (int kt = 0; kt < 16; ++kt) {
    if (kt + 2 < 16) GQ_ISSUE(kt + 2);
    if (kt < 14) asm volatile("s_waitcnt vmcnt(8)" ::: "memory");
    else if (kt == 14) asm volatile("s_waitcnt vmcnt(4)" ::: "memory");
    else asm volatile("s_waitcnt vmcnt(0)" ::: "memory");
    asm volatile("" ::: "memory"); __builtin_amdgcn_s_barrier(); asm volatile("" ::: "memory");
    const int st = kt & 3;
    GQ_BODY(st, 0, 0); GQ_BODY(st, 0, 2); GQ_BODY(st, 1, 0); GQ_BODY(st, 1, 2);
  }
#undef GQ_ISSUE
#undef GQ_BODY
#pragma unroll
  for (int j = 0; j < 4; ++j) {
    const float inv = 1.f / osum[j][0];
    const int tq = tq0 + 16 * j + l15;
#pragma unroll
    for (int i2 = 0; i2 < 4; ++i2) *(uint2*)(AO + (size_t)tq * 1024 + h * 64 + 16 * i2 + 4 * quad) = pack4(o[i2][j] * inv);
  }
}

#ifndef ONLY_PHASE
#define ONLY_PHASE -1
#endif
__device__ void run_phase(const Params& p, char* smem, int ph) {
  if (ONLY_PHASE >= 0 && ph != ONLY_PHASE) return;
  size_t wz = 0;
  asm volatile("" : "+s"(wz));
  char* ws = p.ws + wz;
  float* ssq = (float*)(ws + O_SSQ);
  u16* xb = (u16*)(ws + O_XB);
  const int half = __builtin_amdgcn_readfirstlane(threadIdx_x_raw() >> 8);
  char* sh = smem + half * 65536;
  const int G = gridDim.x, bid = blockIdx.x;
  const int vb = bid * 2 + half, nvb = G * 2;
  const bool is_gemm = (ph == 1) || (ph >= 5 && ph != 9);
  if (is_gemm) {
    const int nsub = (ph == 1 || ph == 8) ? 2 : 1;
    for (int sub = 0; sub < nsub; ++sub) {
      pg8::Gemm g{}; EpiAny E{}; E.ws = ws; E.zout = (u16*)p.out; E.perm = true; int c = bid;
      E.qn = (ph >= 8) ? p.gqa_q_norm : p.na_q_norm; E.kn = (ph >= 8) ? p.gqa_k_norm : p.na_k_norm;
      const bool l1 = ph >= 8;
      const u16* W13 = (const u16*)(ws + (l1 ? O_W13_1 : O_W13_0));
      const u16* W2 = (const u16*)(ws + (l1 ? O_W2_1 : O_W2_0));
      if (ph == 1 || ph == 8) {
        const float* sq = l1 ? ssq + 2 * T : nullptr;
        if (sub == 0) { g = pg8::Gemm{xb, (const u16*)(ws + (l1 ? O_WQKV1 : O_WIN0)), T, l1 ? 1280 : 4352, 1024}; E.kind = l1 ? EK_QK1 : EK_QK0; E.ssq_in = sq; }
        else { g = pg8::Gemm{(const u16*)(ws + (l1 ? O_WV1 : O_WV0)), xb, l1 ? 256 : 512, T, 1024}; E.kind = EK_VT; E.ssq_in = sq;
               E.o16 = (u16*)(ws + (l1 ? O_VT1 : O_VT0)); E.nh = l1 ? 4 : 8; c = (bid + G - 64) % G; }
      } else if (ph == 5 || ph == 10) {
        g = pg8::Gemm{(const u16*)(ws + (l1 ? O_AO : O_MIX)), (const u16*)(ws + (l1 ? O_WOUT1 : O_WOUT0)), T, 1024, l1 ? 1024 : 1536};
        E.kind = EK_RES; E.perm = false; E.res_in = l1 ? nullptr : p.x; E.res_out = nullptr; E.xb_out = xb; E.ssq_out = ssq + (l1 ? 3 * T : T);
      } else if (ph == 6 || ph == 11) {
        g = pg8::Gemm{xb, W13, T, 5632, 1024}; E.kind = EK_SWIGLU; E.ssq_in = ssq + (l1 ? 3 * T : T); E.o16 = (u16*)(ws + O_H);
      } else {
        g = pg8::Gemm{(const u16*)(ws + O_H), W2, T, 1024, 2816};
        E.kind = EK_RES; E.perm = false; E.res_in = nullptr; E.res_out = l1 ? p.out : nullptr; E.xb_out = xb; E.ssq_out = l1 ? nullptr : ssq + 2 * T;
      }
      pg8::StaticOrder S; S.init(g.M, g.N, G, c);
      pg8::gemm_phase(( PG8_LAS unsigned char*)smem, g, S, E);
      if (ph == 6 && G == 256 && bid >= 128) {
        const int tid = otid();
        phase_prep_l1(p, ws, (bid - 128) * 8 + (tid >> 6), 128 * 8, tid & 63);
      }
    }
    return;
  }
  switch (ph) {
    case 0: phase_prep(p); break;
    case 2: {
      PSUB(4) for (int t = vb; t < 2048; t += nvb) na_tile(p, t);
      PSUB(5) for (int t = vb; t < 1024; t += nvb) conv_tile(p, t);
      float* dtb = (float*)(ws + O_DTB);
      for (int idx = bid * 512 + otid(); idx < T * 32; idx += G * 512) {
        float v = dtb[idx] + p.dt_bias[idx & 31];
        const float ev = __builtin_amdgcn_exp2f(v * LOG2E);
        const float sp = (ev < 1e-3f) ? ev * (1.f - 0.5f * ev + 0.33333333f * ev * ev) : __builtin_amdgcn_logf(1.f + ev) * 0.6931471805599453f;
        dtb[idx] = (v > 20.f) ? v : sp;
      }
    } break;
    case 3: {
      for (int t0 = 0; t0 < 256; t0 += G) {
        int item = min(t0 + bid, 255);
        if (G == 256) {
          const int xcd = bid & 7, j = bid >> 3, grp = xcd * 4 + (j >> 3), idx8 = j & 7;
          item = (idx8 & 1) + 2 * ((grp & 3) * 4 + (idx8 >> 1)) + 32 * (grp >> 2);
        }
        scan_item8(p, smem, item);
      }
      if (G != 256) { const int tid = otid(); phase_prep_l1(p, ws, bid * 8 + (tid >> 6), G * 8, tid & 63); }
    } break;
    case 4:
      for (int t0 = 0; t0 < 512; t0 += nvb) ssd_out_tile(p, sh, min(t0 + vb, 511));
      break;
    case 9:
      if (G == 256) {
        const int xcd = bid & 7, j = bid >> 3;
        for (int r = 0; r < 2; ++r) gqa_tile8(p, smem, (r * 16 + xcd * 2 + (j >> 4)) * 16 + (j & 15));
      } else {
        for (int t0 = 0; t0 < 512; t0 += G) gqa_tile8(p, smem, min(t0 + bid, 511));
      }
      break;
    default: break;
  }
}

#define XB_TMO      128
#define XB_XCNT(j)  (256  + 64 * (j))
#define XB_XSUB(j)  (1280 + 64 * (j))
#define XB_XGEN(j)  (2304 + 64 * (j))
#define XB_TOP      3328
#define XB_TOPGEN   3392
#define XCD_BAR_WORDS 3456
#define XB_SPIN_CAP (1u << 18)
#define LAS __attribute__((address_space(3)))
DI unsigned xb_ld(unsigned* p) { return __hip_atomic_load(p, __ATOMIC_RELAXED, __HIP_MEMORY_SCOPE_AGENT); }
DI unsigned xb_add(unsigned* p, unsigned v) { return __hip_atomic_fetch_add(p, v, __ATOMIC_RELAXED, __HIP_MEMORY_SCOPE_AGENT); }
DI unsigned xb_xcc_id() { return (unsigned)__builtin_amdgcn_s_getreg((3 << 11) | 20) & 0xFu; }
#define XB_SPIN(cond, bar) do { unsigned _sp = 0; while (cond) { __builtin_amdgcn_s_sleep(1); \
    if ((++_sp & 255u) == 0u) { if (xb_ld(&(bar)[XB_TMO])) break; if (_sp > XB_SPIN_CAP) { atomicAdd(&(bar)[XB_TMO], 1u); break; } } } } while (0)
struct XcdBarrier { unsigned* bar; unsigned x; volatile LAS unsigned* st; };
DI XcdBarrier xcd_barrier_post(unsigned* bar, volatile LAS unsigned* st) {
  XcdBarrier b; b.bar = bar; b.x = xb_xcc_id(); b.st = st;
  if (threadIdx_x_raw() == 0) (void)xb_add(&bar[XB_XCNT(b.x)], 1u);
  return b;
}
DI void xcd_barrier_complete(unsigned* bar, unsigned x, unsigned& nloc, unsigned& nx) {
  const unsigned G = gridDim.x * gridDim.y * gridDim.z;
  unsigned sum, cnt, mine, sp = 0u;
  for (;;) {
    sum = 0u; cnt = 0u; mine = 0u;
#pragma unroll
    for (unsigned j = 0; j < 16; ++j) { const unsigned c = xb_ld(&bar[XB_XCNT(j)]); sum += c; cnt += (c > 0u) ? 1u : 0u; mine = (j == x) ? c : mine; }
    if (sum == G) break;
    __builtin_amdgcn_s_sleep(1);
    if ((++sp & 255u) == 0u) { if (xb_ld(&bar[XB_TMO])) break; if (sp > XB_SPIN_CAP) { atomicAdd(&bar[XB_TMO], 1u); break; } }
  }
  nloc = mine > 0u ? mine : 1u; nx = cnt > 0u ? cnt : 1u;
}
DI void xcd_barrier(const XcdBarrier& b) {
  asm volatile("s_waitcnt vmcnt(0)" ::: "memory");
  __syncthreads();
  if (threadIdx_x_raw() == 0) {
    unsigned* bar = b.bar;
    asm volatile("" : "+s"(bar));
    __builtin_amdgcn_s_waitcnt(0);
    unsigned nloc = b.st[0], nx = b.st[1];
    if (nloc == 0u) { xcd_barrier_complete(bar, b.x, nloc, nx); b.st[0] = nloc; b.st[1] = nx; }
    const unsigned old = xb_add(&bar[XB_XSUB(b.x)], 1u);
    const unsigned gen = old / nloc;
    if (old + 1u == (gen + 1u) * nloc) {
      __builtin_amdgcn_fence(__ATOMIC_RELEASE, "agent");
      asm volatile("s_waitcnt vmcnt(0)" ::: "memory");
      const unsigned og = xb_add(&bar[XB_TOP], 1u);
      const unsigned tg = og / nx;
      if (og + 1u == (tg + 1u) * nx) xb_add(&bar[XB_TOPGEN], 1u);
      else XB_SPIN(xb_ld(&bar[XB_TOPGEN]) == tg, bar);
      __builtin_amdgcn_fence(__ATOMIC_ACQUIRE, "agent");
      xb_add(&bar[XB_XGEN(b.x)], 1u);
      asm volatile("s_waitcnt vmcnt(0)" ::: "memory");
    } else {
      XB_SPIN(xb_ld(&bar[XB_XGEN(b.x)]) == gen, bar);
      __builtin_amdgcn_fence(__ATOMIC_ACQUIRE, "agent");
      asm volatile("s_waitcnt vmcnt(0)" ::: "memory");
    }
  }
  __syncthreads();
}

__global__ void __launch_bounds__(512, 2) mega(Params p) {
  extern __shared__ __attribute__((aligned(16))) char smem[];
  __shared__ uint4 xb_words;
  cg::grid_group grid = cg::this_grid();
  if (threadIdx_x_raw() == 0) xb_words = make_uint4(0u, 0u, 0u, 0u);
  __syncthreads();
  XcdBarrier xb = xcd_barrier_post((unsigned*)(p.ws + O_BAR), (volatile LAS unsigned*)&xb_words);
  if (p.ph0 < 0) grid.sync();
  for (int ph = p.ph0; ph < p.ph1; ++ph) {
    int nrep = 1;
#if PROBE_REP_MASK
    if ((PROBE_REP_MASK >> ph) & 1) nrep = 2;
#endif
    for (int r = 0; r < nrep; ++r) {
      run_phase(p, smem, ph);
      if (r + 1 < nrep || ph + 1 < p.ph1) xcd_barrier(xb);
    }
  }
#if PROBE_EXTRA_SYNCS
  for (int i = 0; i < PROBE_EXTRA_SYNCS; ++i) xcd_barrier(xb);
#endif
}

extern "C" void kernel_launch(void* const* d_in, const int* in_sizes, int n_in, void* d_out, int out_size, void* d_ws,
                              size_t ws_size, hipStream_t stream) {
  static int grid_blocks = 0;
  if (!grid_blocks) {
    (void)hipFuncSetAttribute((const void*)mega, hipFuncAttributeMaxDynamicSharedMemorySize, SMEM_BYTES);
    int dev = 0, cus = 0, per_cu = 0;
    (void)hipGetDevice(&dev);
    (void)hipDeviceGetAttribute(&cus, hipDeviceAttributeMultiprocessorCount, dev);
    (void)hipOccupancyMaxActiveBlocksPerMultiprocessor(&per_cu, mega, 512, SMEM_BYTES);
    if (per_cu < 1) per_cu = 1;
    grid_blocks = cus;
  }
  Params p{};
  const float** pp = (const float**)&p;
  for (int i = 0; i < 21; ++i) pp[i] = (const float*)d_in[i];
  p.out = (float*)d_out;
  p.ws = (char*)d_ws;
  (void)hipMemsetAsync((char*)d_ws + O_BAR, 0, XCD_BAR_WORDS * 4, stream);
#if MULTI_LAUNCH
  for (int ph = 0; ph < NPHASE; ++ph) {
    p.ph0 = ph; p.ph1 = ph + 1;
    hipLaunchKernelGGL(mega, dim3(grid_blocks), dim3(512), SMEM_BYTES, stream, p);
  }
#else
  p.ph0 = 0; p.ph1 = NPHASE;
  void* args[] = {&p};
  hipError_t e = hipLaunchCooperativeKernel((const void*)mega, dim3(grid_blocks), dim3(512), args, SMEM_BYTES, stream);
  if (e != hipSuccess) fprintf(stderr, "cooperative launch failed: %s (grid %d)\n", hipGetErrorString(e), grid_blocks);
#endif
}
```

```cpp
#include <hip/hip_runtime.h>
#include <hip/hip_bf16.h>
#include <hip/hip_cooperative_groups.h>
#include <cstdio>
namespace cg = cooperative_groups;

#define PROBE_REP_MASK 0
#define PROBE_EXTRA_SYNCS 0
#define PROBE_SUB 0
#define PSUB(k) for (int _r = 0; _r < ((PROBE_SUB == (k)) ? 2 : 1); ++_r)
#ifndef MULTI_LAUNCH
#define MULTI_LAUNCH 0
#endif

typedef __attribute__((ext_vector_type(8))) short bf16x8;
typedef __attribute__((ext_vector_type(4))) float f32x4;
typedef __attribute__((ext_vector_type(2))) float f32x2;
typedef __attribute__((ext_vector_type(2))) __bf16 bf16v2;
typedef unsigned short u16;
typedef unsigned u32x4v __attribute__((ext_vector_type(4)));

#define DI __device__ __forceinline__
#define MFMA(a, b, c) __builtin_amdgcn_mfma_f32_16x16x32_bf16((a), (b), (c), 0, 0, 0)

constexpr int T = 16384;
constexpr float EPS = 1e-6f;
constexpr float LOG2E = 1.4426950408889634f;
constexpr int NPHASE = 13;
constexpr int SMEM_BYTES = 131072 + 8192;

constexpr size_t MIB = 1u << 20;
constexpr size_t O_WIN0 = 0;
constexpr size_t O_WV0 = O_WIN0 + 4352ull * 1024 * 2;
constexpr size_t O_WOUT0 = O_WV0 + 512ull * 1024 * 2;
constexpr size_t O_W13_0 = O_WOUT0 + 1024ull * 1536 * 2;
constexpr size_t O_W2_0 = O_W13_0 + 5632ull * 1024 * 2;
constexpr size_t O_ROPE = 31 * MIB;
constexpr size_t O_DTB = O_ROPE + 524288;
constexpr size_t O_SSQ = O_DTB + 2097152;
constexpr size_t O_BAR = O_SSQ + 262144;
constexpr size_t O_XB = 34 * MIB;
constexpr size_t O_BN = O_XB;
constexpr size_t O_BT = O_XB + 16 * MIB;
constexpr size_t O_Q0 = 66 * MIB;
constexpr size_t O_K0 = 82 * MIB;
constexpr size_t O_VT0 = 98 * MIB;
constexpr size_t O_WQKV1 = 66 * MIB;
constexpr size_t O_WV1 = O_WQKV1 + 1280ull * 1024 * 2;
constexpr size_t O_WOUT1 = O_WV1 + 256ull * 1024 * 2;
constexpr size_t O_W13_1 = O_WOUT1 + 1024ull * 1024 * 2;
constexpr size_t O_W2_1 = O_W13_1 + 5632ull * 1024 * 2;
constexpr size_t O_BIG = 114 * MIB;
constexpr size_t O_XBC = O_BIG;
constexpr size_t O_HPREV = O_BIG;
constexpr size_t O_CN = O_BIG + 64 * MIB;
constexpr size_t O_MIX = O_BIG + 80 * MIB;
constexpr size_t O_H = O_BIG;
constexpr size_t O_Q1 = O_BIG;
constexpr size_t O_K1 = O_BIG + 32 * MIB;
constexpr size_t O_VT1 = O_BIG + 40 * MIB;
constexpr size_t O_AO = O_BIG + 48 * MIB;

struct Params {
  const float *x, *even_mix_norm, *even_w_in, *na_q_norm, *na_k_norm, *na_rel_bias, *conv_w, *conv_b, *dt_bias, *A_log,
      *Dskip, *out_norm, *even_w_out, *odd_mix_norm, *odd_w_qkv, *gqa_q_norm, *gqa_k_norm, *odd_w_out, *ffn_norm,
      *ffn_w13, *ffn_w2;
  float* out;
  char* ws;
  int ph0, ph1;
};

__device__ __forceinline__ int threadIdx_x_raw() { return (int)__builtin_amdgcn_workitem_id_x(); }
DI unsigned pack2(float a, float b) {
  f32x2 v = {a, b};
  bf16v2 r = __builtin_convertvector(v, bf16v2);
  return __builtin_bit_cast(unsigned, r);
}
DI uint2 pack4(f32x4 v) { return make_uint2(pack2(v[0], v[1]), pack2(v[2], v[3])); }
DI u16 f2bf(float a) { return (u16)(pack2(a, 0.f) & 0xffffu); }
DI float bflo(unsigned u) { return __uint_as_float(u << 16); }
DI float bfhi(unsigned u) { return __uint_as_float(u & 0xffff0000u); }
DI float bf2f(u16 h) { return __uint_as_float(((unsigned)h) << 16); }
DI bf16x8 as_bf8(uint4 v) { return __builtin_bit_cast(bf16x8, v); }
DI bf16x8 cat_bf8(uint2 a, uint2 b) { return as_bf8(make_uint4(a.x, a.y, b.x, b.y)); }
DI int vtid() { int t = threadIdx_x_raw() & 255; asm volatile("" : "+v"(t)); return t; }
DI int otid() { int t = threadIdx_x_raw(); asm volatile("" : "+v"(t)); return t; }
DI float silu(float x) { return x * __builtin_amdgcn_rcpf(1.f + __builtin_amdgcn_exp2f(-1.4426950408889634f * x)); }
DI float ex2(float x) { return __builtin_amdgcn_exp2f(x); }
DI float xor16_32_sum(float v) { v += __shfl_xor(v, 16); v += __shfl_xor(v, 32); return v; }
DI float xor16_32_max(float v) { v = fmaxf(v, __shfl_xor(v, 16)); v = fmaxf(v, __shfl_xor(v, 32)); return v; }
DI void wave_sync_lds() { __builtin_amdgcn_fence(__ATOMIC_ACQ_REL, "wavefront"); __builtin_amdgcn_wave_barrier(); }
DI void unpack8(uint4 u, float* f) {
  f[0] = bflo(u.x); f[1] = bfhi(u.x); f[2] = bflo(u.y); f[3] = bfhi(u.y);
  f[4] = bflo(u.z); f[5] = bfhi(u.z); f[6] = bflo(u.w); f[7] = bfhi(u.w);
}

struct WDesc { const float* W; int ldn, K, rows; u16* dst; const float* gain; int mode, coloff; };
DI int wt_srccol(int mode, int R, int coloff) {
  if (mode == 0) return coloff + R;
  const int pn = R >> 8, c = R & 255, bj = c >> 7, j = c & 127;
  if (mode == 1) return bj * 2816 + pn * 128 + j;
  const int wc = j >> 5, e = j & 31;
  if (mode == 2) {
    if (pn < 4) return (pn >> 1) * 512 + ((pn & 1) * 4 + wc) * 64 + bj * 32 + e;
    if (pn < 8) return 1536 + (R - 1024);
    if (pn < 16) return 2560 + (R - 2048);
    return (R - 4096 < 32) ? 4608 + (R - 4096) : -1;
  }
  if (pn < 4) return (pn * 4 + wc) * 64 + bj * 32 + e;
  return 1024 + wc * 64 + bj * 32 + e;
}
__device__ void wt_item(const WDesc& d, int item, int lane) {
  const int nr = d.rows >> 6, nn = item % nr, kk = item / nr;
  const int R = nn * 64 + lane;
  const int sc = wt_srccol(d.mode, R, d.coloff);
  typedef __attribute__((address_space(1))) const float gfloat_c;
  typedef __attribute__((address_space(1))) u32x4v gu32x4;
  gfloat_c* src = (gfloat_c*)(d.W + (sc >= 0 ? sc : 0));
  gfloat_c* gain = (gfloat_c*)d.gain;
  u16* dst = d.dst + (size_t)R * d.K + kk * 64;
#pragma unroll
  for (int k8 = 0; k8 < 8; ++k8) {
    float v[8];
#pragma unroll
    for (int e = 0; e < 8; ++e) {
      const int k = kk * 64 + k8 * 8 + e;
      float x = src[(size_t)k * d.ldn];
      if (d.gain) x *= gain[k];
      v[e] = (sc >= 0) ? x : 0.f;
    }
    const u32x4v pk = {pack2(v[0], v[1]), pack2(v[2], v[3]), pack2(v[4], v[5]), pack2(v[6], v[7])};
    *(gu32x4*)(dst + k8 * 8) = pk;
  }
}
DI WDesc wt_desc(const Params& p, char* ws, int set, int i) {
  if (set == 0) {
    switch (i) {
      case 0: return WDesc{p.even_w_in, 4640, 1024, 4352, (u16*)(ws + O_WIN0), p.even_mix_norm, 2, 0};
      case 1: return WDesc{p.even_w_in, 4640, 1024, 512, (u16*)(ws + O_WV0), p.even_mix_norm, 0, 1024};
      case 2: return WDesc{p.even_w_out, 1024, 1536, 1024, (u16*)(ws + O_WOUT0), nullptr, 0, 0};
      case 3: return WDesc{p.ffn_w13, 5632, 1024, 5632, (u16*)(ws + O_W13_0), p.ffn_norm, 1, 0};
      default: return WDesc{p.ffn_w2, 1024, 2816, 1024, (u16*)(ws + O_W2_0), nullptr, 0, 0};
    }
  }
  switch (i) {
    case 0: return WDesc{p.odd_w_qkv, 1536, 1024, 1280, (u16*)(ws + O_WQKV1), p.odd_mix_norm, 3, 0};
    case 1: return WDesc{p.odd_w_qkv, 1536, 1024, 256, (u16*)(ws + O_WV1), p.odd_mix_norm, 0, 1280};
    case 2: return WDesc{p.odd_w_out, 1024, 1024, 1024, (u16*)(ws + O_WOUT1), nullptr, 0, 0};
    case 3: return WDesc{p.ffn_w13 + (size_t)1024 * 5632, 5632, 1024, 5632, (u16*)(ws + O_W13_1), p.ffn_norm + 1024, 1, 0};
    default: return WDesc{p.ffn_w2 + (size_t)2816 * 1024, 1024, 2816, 1024, (u16*)(ws + O_W2_1), nullptr, 0, 0};
  }
}
__device__ void wt_run(const Params& p, char* ws, int set, int gw, int nw, int lane) {
  const int c0 = set ? 320 : 1088, c1 = c0 + (set ? 64 : 128), c2 = c1 + (set ? 256 : 384), c3 = c2 + 1408, total = c3 + 704;
  for (int it = gw; it < total; it += nw) {
    const int i = it < c0 ? 0 : it < c1 ? 1 : it < c2 ? 2 : it < c3 ? 3 : 4;
    const int base = i == 0 ? 0 : i == 1 ? c0 : i == 2 ? c1 : i == 3 ? c2 : c3;
    const WDesc d = wt_desc(p, ws, set, i);
    wt_item(d, it - base, lane);
  }
}

__device__ void phase_prep(const Params& p) {
  size_t wz = 0;
  asm volatile("" : "+s"(wz));
  char* ws = p.ws + wz;
  const int tid = otid(), lane = tid & 63;
  const int gw = blockIdx.x * 8 + (tid >> 6), nw = gridDim.x * 8;
  PSUB(1) wt_run(p, ws, 0, gw, nw, lane);
  PSUB(2) for (int row0 = gw * 4; row0 < T; row0 += nw * 4) {
    float4 v[4][4];
#pragma unroll
    for (int rr = 0; rr < 4; ++rr)
#pragma unroll
      for (int i = 0; i < 4; ++i) v[rr][i] = *(const float4*)(p.x + (size_t)(row0 + rr) * 1024 + i * 256 + lane * 4);
#pragma unroll
    for (int rr = 0; rr < 4; ++rr) {
      u16* xb = (u16*)(ws + O_XB) + (size_t)(row0 + rr) * 1024;
      float ss = 0.f;
#pragma unroll
      for (int i = 0; i < 4; ++i) { const float4 a = v[rr][i]; ss += a.x * a.x + a.y * a.y + a.z * a.z + a.w * a.w; }
#pragma unroll
      for (int o = 32; o >= 1; o >>= 1) ss += __shfl_xor(ss, o);
      const float rs = rsqrtf(ss * (1.f / 1024.f) + EPS);
#pragma unroll
      for (int i = 0; i < 4; ++i) {
        const float4 a = v[rr][i];
        *(uint2*)(xb + i * 256 + lane * 4) = make_uint2(pack2(a.x * rs, a.y * rs), pack2(a.z * rs, a.w * rs));
      }
      if (lane == 0) {
        float* ssq = (float*)(ws + O_SSQ);
        const int row = row0 + rr;
        ssq[row] = ss; ssq[T + row] = 0.f; ssq[2 * T + row] = 0.f; ssq[3 * T + row] = 0.f;
      }
    }
  }
  PSUB(3) for (int idx = blockIdx.x * 512 + tid; idx < 65536; idx += gridDim.x * 512) {
    int s = idx >> 5, pp = idx & 31;
    float pos = (pp < 16) ? (float)(s >> 6) : (float)(s & 63);
    float freq = __builtin_amdgcn_exp2f(-(float)(pp & 15) * (13.287712379549449f / 16.f));
    float sn, cs;
    sincosf(pos * freq, &sn, &cs);
    ((float2*)(ws + O_ROPE))[idx] = make_float2(cs, sn);
  }
}
__device__ void phase_prep_l1(const Params& p, char* ws, int gw, int nw, int lane) { wt_run(p, ws, 1, gw, nw, lane); }
namespace pg8 {
#define PG8_LAS __attribute__((address_space(3)))
typedef unsigned short bf16_t;
constexpr int BM = 256, BK = 64, HALF = 128, HTB = HALF * BK * 2, STAGE_BYTES = 8 * HTB, NXCD = 8, WGM = 8;
DI int lds_byte(int r, int c) { const int st = (r >> 4) * 2 + (c >> 5), rr = r & 15, cc = c & 31, ob = rr * 64 + cc * 2; return st * 1024 + (ob ^ (((ob >> 9) & 1) << 5)); }
DI void stage_rc(int b, int& R, int& C) { const int st = b / 1024, sb = b % 1024, swz = sb ^ (((sb >> 9) & 1) << 5); R = (st >> 1) * 16 + swz / 64; C = (st & 1) * 32 + (swz % 64) / 2; }
DI int perm32(int rho) { const int n = rho >> 4, i = rho & 15; return 8 * (i >> 2) + 4 * n + (i & 3); }
struct Unit { int pm, pn; };
struct Gemm { const bf16_t* A; const bf16_t* Bt; int M, N, K; };
struct StaticOrder {
  int nM, nN, nwg, G, c;
  DI void init(int M, int N, int G_, int c_) { nM = M / BM; nN = N / BM; nwg = nM * nN; G = G_; c = c_; }
  DI bool next(int i, Unit& u) const {
    const long L = (long)i * G + c; if (L >= nwg) return false;
    int wgid = (int)L; { const int q = nwg / NXCD, r = nwg % NXCD, xcd = wgid % NXCD, off = wgid / NXCD; wgid = (xcd < r ? xcd * (q + 1) : r * (q + 1) + (xcd - r) * q) + off; }
    const int nig = WGM * nN, gid = wgid / nig, fm = gid * WGM, gsz = (nM - fm) < WGM ? (nM - fm) : WGM;
    u.pm = fm + ((wgid % nig) % gsz); u.pn = (wgid % nig) / gsz; return true;
  }
};
template <class Epi>
DI void gemm_phase(PG8_LAS unsigned char* lds, const Gemm g, const StaticOrder& S, const Epi& E) {
  const int tid = otid(), wid = __builtin_amdgcn_readfirstlane(tid >> 6), lane = tid & 63, wr = wid >> 2, wc = wid & 3, fr = lane & 15, fq = lane >> 4;
  const int K = g.K, nt = K / BK;
  unsigned voffA[2], voffB[2];
#pragma unroll
  for (int i = 0; i < 2; ++i) { int R, C; stage_rc(tid * 16 + i * 8192, R, C); const int Rb = E.perm ? ((R & ~31) + perm32(R & 31)) : R;
    voffA[i] = (unsigned)(R * K + C) * 2u; voffB[i] = (unsigned)(Rb * K + C) * 2u; }
  const size_t kstep = (size_t)(BK * 2);
  const size_t hstep = (size_t)HALF * K * 2;
  const size_t tstep = 2 * hstep;
  const unsigned ldsw = (unsigned)wid * 1024u;
  const int aoff = lds_byte(wr * 64 + fr, fq * 8), boff = lds_byte(wc * 32 + fr, fq * 8);
#define PG8_SA(b, h) (((b) * 2 + (h)) * HTB)
#define PG8_SB(b, h) ((4 + (b) * 2 + (h)) * HTB)
#define PG8_STAGE(bufoff, gbase, voff) do { _Pragma("unroll") for (int _i = 0; _i < 2; ++_i) \
    __builtin_amdgcn_global_load_lds((const unsigned*)((const char*)(gbase) + (voff)[_i]), (PG8_LAS unsigned*)(lds + (bufoff) + ldsw + _i * 8192), 16, 0, 0); } while (0)
#define PG8_LDA(dst, b, h) do { _Pragma("unroll") for (int m = 0; m < 4; ++m) _Pragma("unroll") for (int k = 0; k < 2; ++k) dst[m][k] = *(const PG8_LAS bf16x8*)(lds + PG8_SA(b, h) + aoff + m * 2048 + k * 1024); } while (0)
#define PG8_LDB(dst, b, h) do { _Pragma("unroll") for (int n = 0; n < 2; ++n) _Pragma("unroll") for (int k = 0; k < 2; ++k) dst[n][k] = *(const PG8_LAS bf16x8*)(lds + PG8_SB(b, h) + boff + n * 2048 + k * 1024); } while (0)
#define PG8_MMA(ai, bj, At, Bt) do { __builtin_amdgcn_s_setprio(1); _Pragma("unroll") for (int m = 0; m < 4; ++m) _Pragma("unroll") for (int n = 0; n < 2; ++n) _Pragma("unroll") for (int k = 0; k < 2; ++k) \
    acc[ai][bj][m][n] = __builtin_amdgcn_mfma_f32_16x16x32_bf16(Bt[n][k], At[m][k], acc[ai][bj][m][n], 0, 0, 0); __builtin_amdgcn_s_setprio(0); } while (0)
#define PG8_WAIT_V(n) asm volatile("s_waitcnt vmcnt(" #n ")" ::: "memory")
#define PG8_WAIT_L(n) asm volatile("s_waitcnt lgkmcnt(" #n ")" ::: "memory")
#define PG8_BAR __builtin_amdgcn_s_barrier()
#define PG8_SCHED __builtin_amdgcn_sched_barrier(0)
  Unit cur, nxt; int ui = 0;
  if (!S.next(0, cur)) return;
  if (E.ssq_in) {
    PG8_LAS float* rtab = (PG8_LAS float*)(lds + 131072);
    Unit uu;
    for (int q = 0; q < 8 && S.next(q, uu); ++q)
      if (tid < 256) rtab[q * 256 + tid] = rsqrtf(E.ssq_in[(E.kind == 4 ? uu.pn : uu.pm) * 256 + tid] * (1.f / 1024.f) + EPS);
    __syncthreads();
  }
  f32x4 acc[2][2][4][2];
#pragma unroll
  for (int a = 0; a < 2; ++a)
#pragma unroll
    for (int b = 0; b < 2; ++b)
#pragma unroll
      for (int m = 0; m < 4; ++m)
#pragma unroll
        for (int n = 0; n < 2; ++n) acc[a][b][m][n] = (f32x4){0.f, 0.f, 0.f, 0.f};
  bf16x8 At[4][2], B0[2][2], B1[2][2];
  const char* cA = (const char*)g.A + (size_t)cur.pm * tstep; const char* cB = (const char*)g.Bt + (size_t)cur.pn * tstep;
  PG8_STAGE(PG8_SB(0, 0), cB, voffB); PG8_STAGE(PG8_SA(0, 0), cA, voffA); PG8_STAGE(PG8_SB(0, 1), cB + hstep, voffB); PG8_STAGE(PG8_SA(0, 1), cA + hstep, voffA);
  if (wr == 1) PG8_BAR;
  PG8_WAIT_V(4); PG8_BAR;
  PG8_STAGE(PG8_SB(1, 0), cB + kstep, voffB); PG8_STAGE(PG8_SA(1, 0), cA + kstep, voffA); PG8_STAGE(PG8_SB(1, 1), cB + hstep + kstep, voffB);
  PG8_WAIT_V(6); PG8_BAR;
  for (;;) {
    const bool has_next = S.next(ui + 1, nxt);
    const char* nA = has_next ? (const char*)g.A + (size_t)nxt.pm * tstep : cA; const char* nB = has_next ? (const char*)g.Bt + (size_t)nxt.pn * tstep : cB;
    for (int t = 0; t < nt; t += 2) {
      const bool last = (t == nt - 2);
      const char* a1 = cA + (size_t)(t + 1) * kstep;
      const char* a2 = last ? nA : cA + (size_t)(t + 2) * kstep; const char* b2 = last ? nB : cB + (size_t)(t + 2) * kstep;
      const char* a3 = a2 + kstep; const char* b3 = b2 + kstep;
      PG8_LDB(B0, 0, 0); PG8_SCHED; PG8_LDA(At, 0, 0); PG8_STAGE(PG8_SA(1, 1), a1 + hstep, voffA);
      PG8_WAIT_L(8); PG8_BAR; PG8_WAIT_L(0); PG8_MMA(0, 0, At, B0); PG8_BAR; PG8_SCHED;
      PG8_LDB(B1, 0, 1); PG8_STAGE(PG8_SB(0, 0), b2, voffB);
      PG8_BAR; PG8_WAIT_L(0); PG8_MMA(0, 1, At, B1); PG8_BAR;
      PG8_LDA(At, 0, 1); PG8_STAGE(PG8_SA(0, 0), a2, voffA);
      PG8_BAR; PG8_WAIT_L(0); PG8_MMA(1, 0, At, B0); PG8_BAR; PG8_SCHED;
      PG8_STAGE(PG8_SB(0, 1), b2 + hstep, voffB);
      PG8_WAIT_V(6); PG8_BAR; PG8_MMA(1, 1, At, B1); PG8_BAR;
      PG8_LDB(B0, 1, 0); PG8_SCHED; PG8_LDA(At, 1, 0); PG8_STAGE(PG8_SA(0, 1), a2 + hstep, voffA);
      PG8_WAIT_L(8); PG8_BAR; PG8_WAIT_L(0); PG8_MMA(0, 0, At, B0); PG8_BAR; PG8_SCHED;
      PG8_LDB(B1, 1, 1); PG8_STAGE(PG8_SB(1, 0), b3, voffB);
      PG8_BAR; PG8_WAIT_L(0); PG8_MMA(0, 1, At, B1); PG8_BAR;
      PG8_LDA(At, 1, 1); PG8_STAGE(PG8_SA(1, 0), a3, voffA);
      PG8_BAR; PG8_WAIT_L(0); PG8_MMA(1, 0, At, B0); PG8_BAR; PG8_SCHED;
      PG8_STAGE(PG8_SB(1, 1), b3 + hstep, voffB);
      PG8_WAIT_V(6); PG8_BAR; PG8_MMA(1, 1, At, B1); PG8_BAR;
    }
    E(acc, cur, wr, wc, fr, fq, (const PG8_LAS float*)(lds + 131072) + ui * 256);
    if (!has_next) break;
#pragma unroll
    for (int a = 0; a < 2; ++a)
#pragma unroll
      for (int b = 0; b < 2; ++b)
#pragma unroll
        for (int m = 0; m < 4; ++m)
#pragma unroll
          for (int n = 0; n < 2; ++n) acc[a][b][m][n] = (f32x4){0.f, 0.f, 0.f, 0.f};
    cur = nxt; cA = nA; cB = nB; ++ui;
  }
  PG8_WAIT_V(0);
  if (wr == 0) PG8_BAR;
  PG8_BAR;
#undef PG8_SA
#undef PG8_SB
#undef PG8_STAGE
#undef PG8_LDA
#undef PG8_LDB
#undef PG8_MMA
#undef PG8_WAIT_V
#undef PG8_WAIT_L
#undef PG8_BAR
#undef PG8_SCHED
}
}

typedef f32x4 AccT[2][2][4][2];
DI uint4 pack8(f32x4 a, f32x4 b) { return make_uint4(pack2(a[0], a[1]), pack2(a[2], a[3]), pack2(b[0], b[1]), pack2(b[2], b[3])); }

struct EpiRes {
  static constexpr bool PERM = false;
  const float* res_f32; u16* xb; float* out_f32; float* ssq_out;
  DI void operator()(const AccT& acc, const pg8::Unit& u, int wr, int wc, int fr, int fq, const PG8_LAS float* rtab) const {
    const int row0 = u.pm * 256 + wr * 64 + fr, col0 = u.pn * 256 + wc * 32 + 4 * fq;
#pragma unroll
    for (int ai = 0; ai < 2; ++ai)
#pragma unroll
      for (int m = 0; m < 4; ++m) {
        const size_t r = row0 + ai * 128 + m * 16;
        float part = 0.f;
#pragma unroll
        for (int bj = 0; bj < 2; ++bj)
#pragma unroll
          for (int n = 0; n < 2; ++n) {
            const int c = col0 + bj * 128 + n * 16;
            float4 r4;
            if (res_f32) r4 = *(const float4*)(res_f32 + r * 1024 + c);
            else { uint2 rr = *(const uint2*)(xb + r * 1024 + c); r4 = make_float4(bflo(rr.x), bfhi(rr.x), bflo(rr.y), bfhi(rr.y)); }
            f32x4 a = acc[ai][bj][m][n];
            float4 v = make_float4(r4.x + a[0], r4.y + a[1], r4.z + a[2], r4.w + a[3]);
            if (out_f32) *(float4*)(out_f32 + r * 1024 + c) = v;
            else *(uint2*)(xb + r * 1024 + c) = make_uint2(pack2(v.x, v.y), pack2(v.z, v.w));
            part += v.x * v.x + v.y * v.y + v.z * v.z + v.w * v.w;
          }
        if (ssq_out) {
          part = xor16_32_sum(part);
          if (fq == 0) atomicAdd(ssq_out + r, part);
        }
      }
  }
};

struct EpiSwiglu {
  static constexpr bool PERM = true;
  const float* ssq_in; u16* h_out;
  DI void operator()(const AccT& acc, const pg8::Unit& u, int wr, int wc, int fr, int fq, const PG8_LAS float* rtab) const {
    const int row0 = u.pm * 256 + wr * 64 + fr;
#pragma unroll
    for (int ai = 0; ai < 2; ++ai)
#pragma unroll
      for (int m = 0; m < 4; ++m) {
        const size_t r = row0 + ai * 128 + m * 16;
        const float rs = rtab[ai * 128 + wr * 64 + m * 16 + fr];
        f32x4 h0, h1;
#pragma unroll
        for (int e = 0; e < 4; ++e) {
          h0[e] = silu(acc[ai][0][m][0][e] * rs) * (acc[ai][1][m][0][e] * rs);
          h1[e] = silu(acc[ai][0][m][1][e] * rs) * (acc[ai][1][m][1][e] * rs);
        }
        *(uint4*)(h_out + r * 2816 + u.pn * 128 + wc * 32 + 8 * fq) = pack8(h0, h1);
      }
  }
};

template <int L1>
struct EpiQK {
  static constexpr bool PERM = true;
  char* ws; u16* zout; const float* qn; const float* kn; const float* ssq_in;
  DI void operator()(const AccT& acc, const pg8::Unit& u, int wr, int wc, int fr, int fq, const PG8_LAS float* rtab) const {
    const int pn = u.pn;
    const int row0 = u.pm * 256 + wr * 64 + fr;
    const bool headnorm = L1 ? true : (pn < 4);
    const bool is_q = L1 ? (pn < 4) : (pn < 2);
#pragma unroll
    for (int ai = 0; ai < 2; ++ai)
#pragma unroll
      for (int m = 0; m < 4; ++m) {
        const size_t r = row0 + ai * 128 + m * 16;
        const float rs = L1 ? rtab[ai * 128 + wr * 64 + m * 16 + fr] : 1.f;
        f32x4 v[2][2];
#pragma unroll
        for (int bj = 0; bj < 2; ++bj)
#pragma unroll
          for (int n = 0; n < 2; ++n) v[bj][n] = acc[ai][bj][m][n] * rs;
        if (headnorm) {
          float ss = 0.f;
#pragma unroll
          for (int bj = 0; bj < 2; ++bj)
#pragma unroll
            for (int n = 0; n < 2; ++n)
              ss += v[bj][n][0] * v[bj][n][0] + v[bj][n][1] * v[bj][n][1] + v[bj][n][2] * v[bj][n][2] + v[bj][n][3] * v[bj][n][3];
          ss = xor16_32_sum(ss);
          const float hn = rsqrtf(ss * (1.f / 64.f) + EPS) * (is_q ? 0.125f * LOG2E : 1.f);
          const float* gn = is_q ? qn : kn;
#pragma unroll
          for (int bj = 0; bj < 2; ++bj)
#pragma unroll
            for (int n = 0; n < 2; ++n) {
              float4 g4 = *(const float4*)(gn + bj * 32 + 8 * fq + 4 * n);
              v[bj][n][0] *= hn * g4.x; v[bj][n][1] *= hn * g4.y; v[bj][n][2] *= hn * g4.z; v[bj][n][3] *= hn * g4.w;
            }
          u16* dst;
          if (L1) {
            const int s = (int)(r & 2047);
            const float4* rt = (const float4*)(ws + O_ROPE) + (size_t)s * 16;
#pragma unroll
            for (int bj = 0; bj < 2; ++bj)
#pragma unroll
              for (int n = 0; n < 2; ++n) {
                float4 cs = rt[bj * 8 + 2 * fq + n];
                float a0 = v[bj][n][0], a1 = v[bj][n][1], b0 = v[bj][n][2], b1 = v[bj][n][3];
                v[bj][n][0] = a0 * cs.x - a1 * cs.y; v[bj][n][1] = a0 * cs.y + a1 * cs.x;
                v[bj][n][2] = b0 * cs.z - b1 * cs.w; v[bj][n][3] = b0 * cs.w + b1 * cs.z;
              }
            dst = is_q ? (u16*)(ws + O_Q1) + r * 1024 + (pn * 4 + wc) * 64 : (u16*)(ws + O_K1) + r * 256 + wc * 64;
          } else {
            dst = (is_q ? (u16*)(ws + O_Q0) : (u16*)(ws + O_K0)) + r * 512 + ((pn & 1) * 4 + wc) * 64;
          }
#pragma unroll
          for (int bj = 0; bj < 2; ++bj) *(uint4*)(dst + bj * 32 + 8 * fq) = pack8(v[bj][0], v[bj][1]);
        } else if (pn < 8) {
          u16* dst = zout + r * 1024 + (pn - 4) * 256 + wc * 32 + 8 * fq;
#pragma unroll
          for (int bj = 0; bj < 2; ++bj) *(uint4*)(dst + bj * 128) = pack8(v[bj][0], v[bj][1]);
        } else if (pn < 16) {
          u16* dst = (u16*)(ws + O_XBC) + r * 2048 + (pn - 8) * 256 + wc * 32 + 8 * fq;
#pragma unroll
          for (int bj = 0; bj < 2; ++bj) *(uint4*)(dst + bj * 128) = pack8(v[bj][0], v[bj][1]);
        } else if (wc == 0) {
          float* dst = (float*)(ws + O_DTB) + r * 32 + 8 * fq;
          *(float4*)(dst) = make_float4(v[0][0][0], v[0][0][1], v[0][0][2], v[0][0][3]);
          *(float4*)(dst + 4) = make_float4(v[0][1][0], v[0][1][1], v[0][1][2], v[0][1][3]);
        }
      }
  }
};

struct EpiVT {
  static constexpr bool PERM = true;
  const float* ssq_in; u16* vt; int nh;
  DI void operator()(const AccT& acc, const pg8::Unit& u, int wr, int wc, int fr, int fq, const PG8_LAS float* rtab) const {
#pragma unroll
    for (int bj = 0; bj < 2; ++bj) {
      const int tok0 = u.pn * 256 + bj * 128 + wc * 32 + 8 * fq;
      f32x4 r0 = {1.f, 1.f, 1.f, 1.f}, r1 = r0;
      if (ssq_in) {
        const int lo = bj * 128 + wc * 32 + 8 * fq;
        r0 = *(const PG8_LAS f32x4*)(rtab + lo); r1 = *(const PG8_LAS f32x4*)(rtab + lo + 4);
      }
      const int b = tok0 >> 11, s = tok0 & 2047;
#pragma unroll
      for (int ai = 0; ai < 2; ++ai)
#pragma unroll
        for (int m = 0; m < 4; ++m) {
          const int f = u.pm * 256 + ai * 128 + wr * 64 + m * 16 + fr;
          const int hd = f >> 6, d = f & 63;
          u16* dstp = vt + ((size_t)((b * nh + hd) * 64 + d)) * 2048;
          const uint4 pk = pack8(acc[ai][bj][m][0] * r0, acc[ai][bj][m][1] * r1);
          if (nh == 4) {
            const int c = (s >> 3) & 3, pos0 = (s & ~31) + 16 * (c & 1) + 4 * (c >> 1);
            *(uint2*)(dstp + pos0) = make_uint2(pk.x, pk.y);
            *(uint2*)(dstp + pos0 + 8) = make_uint2(pk.z, pk.w);
          } else {
            *(uint4*)(dstp + s) = pk;
          }
        }
    }
  }
};
enum { EK_RES = 0, EK_SWIGLU = 1, EK_QK0 = 2, EK_QK1 = 3, EK_VT = 4 };
struct EpiAny {
  int kind; bool perm;
  char* ws; u16* zout; const float* qn; const float* kn; const float* ssq_in; float* ssq_out; const float* res_in; float* res_out; u16* xb_out; u16* o16; int nh;
  DI void operator()(const AccT& acc, const pg8::Unit& u, int wr, int wc, int fr, int fq, const PG8_LAS float* rtab) const {
    switch (kind) {
      case EK_RES: { EpiRes e{res_in, xb_out, res_out, ssq_out}; e(acc, u, wr, wc, fr, fq, rtab); } break;
      case EK_SWIGLU: { EpiSwiglu e{ssq_in, o16}; e(acc, u, wr, wc, fr, fq, rtab); } break;
      case EK_QK0: { EpiQK<0> e{ws, zout, qn, kn, ssq_in}; e(acc, u, wr, wc, fr, fq, rtab); } break;
      case EK_QK1: { EpiQK<1> e{ws, zout, qn, kn, ssq_in}; e(acc, u, wr, wc, fr, fq, rtab); } break;
      default: { EpiVT e{ssq_in, o16, nh}; e(acc, u, wr, wc, fr, fq, rtab); } break;
    }
  }
};

__device__ void na_tile(const Params& p, int tile) {
  const int tid = vtid(), lane = tid & 63, wave = tid >> 6, l15 = lane & 15, quad = lane >> 4;
  const int h = tile & 7, r = (tile >> 3) & 31, b = tile >> 8;
  const int c0 = min(max(16 * wave - 8, 0), 32);
  const int rs = min(max(r - 4, 0), 24);
  const u16* Q0 = (const u16*)(p.ws + O_Q0);
  const u16* K0 = (const u16*)(p.ws + O_K0) + (size_t)(b * 2048 + rs * 64 + c0 + 8 * (l15 >> 2) + (l15 & 3)) * 512 + h * 64 + 8 * quad;
  const u16* VT = (const u16*)(p.ws + O_VT0) + (size_t)((b * 8 + h) * 64 + l15) * 2048 + rs * 64 + c0 + 8 * quad;
  u16* mix = (u16*)(p.ws + O_MIX);
  const int tq = b * 2048 + r * 64 + 16 * wave + l15;
  bf16x8 qf[2];
#pragma unroll
  for (int ks = 0; ks < 2; ++ks) qf[ks] = as_bf8(*(const uint4*)(Q0 + (size_t)tq * 512 + h * 64 + 32 * ks + 8 * quad));
  const int cq = 16 * wave + l15;
  const int cs = min(max(cq - 8, 0), 48);
  const float* rpb = p.na_rel_bias + h * 465 + (rs - r + 7) * 31;
  const int d0 = c0 + 8 * quad - cq;
  const int w0 = d0 + cq - cs;
  f32x4 s[16];
  uint4 kb[2][4];
#pragma unroll
  for (int q4 = 0; q4 < 4; ++q4) kb[0][q4] = *(const uint4*)(K0 + (size_t)(4 * (q4 >> 1)) * 512 + 32 * (q4 & 1));
#pragma unroll
  for (int jr = 0; jr < 8; ++jr) {
    if (jr + 1 < 8) {
#pragma unroll
      for (int q4 = 0; q4 < 4; ++q4)
        kb[(jr + 1) & 1][q4] = *(const uint4*)(K0 + (size_t)((jr + 1) * 64 + 4 * (q4 >> 1)) * 512 + 32 * (q4 & 1));
    }
    float bias[8];
#pragma unroll
    for (int e = 0; e < 8; ++e) bias[e] = rpb[jr * 31 + min(max(d0 + 4 * (e >> 2) + (e & 3), -15), 15) + 15];
#pragma unroll
    for (int tt = 0; tt < 2; ++tt) {
      f32x4 a = {0.f, 0.f, 0.f, 0.f};
      a = MFMA(as_bf8(kb[jr & 1][2 * tt]), qf[0], a);
      a = MFMA(as_bf8(kb[jr & 1][2 * tt + 1]), qf[1], a);
#pragma unroll
      for (int rr = 0; rr < 4; ++rr) a[rr] = ((unsigned)(w0 + 4 * tt + rr) < 16u) ? (a[rr] + bias[tt * 4 + rr] * LOG2E) : -INFINITY;
      s[jr * 2 + tt] = a;
    }
  }
  float mx = -INFINITY;
#pragma unroll
  for (int u = 0; u < 16; ++u) mx = fmaxf(mx, fmaxf(fmaxf(s[u][0], s[u][1]), fmaxf(s[u][2], s[u][3])));
  mx = xor16_32_max(mx);
  uint4 vbuf[3][4];
#define NA_VLOAD(jr, dst) do { \
    _Pragma("unroll") for (int i2 = 0; i2 < 4; ++i2) dst[i2] = *(const uint4*)(VT + (size_t)(16 * i2) * 2048 + (jr) * 64); } while (0)
  NA_VLOAD(0, vbuf[0]);
  NA_VLOAD(1, vbuf[1]);
  float sum = 0.f;
#pragma unroll
  for (int u = 0; u < 16; ++u)
#pragma unroll
    for (int rr = 0; rr < 4; ++rr) { float pv = ex2(s[u][rr] - mx); s[u][rr] = pv; sum += pv; }
  sum = xor16_32_sum(sum);
  f32x4 o[4];
#pragma unroll
  for (int i2 = 0; i2 < 4; ++i2) o[i2] = (f32x4){0.f, 0.f, 0.f, 0.f};
#pragma unroll
  for (int jr = 0; jr < 8; ++jr) {
    if (jr + 2 < 8) NA_VLOAD(jr + 2, vbuf[(jr + 2) % 3]);
    bf16x8 pf = cat_bf8(pack4(s[2 * jr]), pack4(s[2 * jr + 1]));
#pragma unroll
    for (int i2 = 0; i2 < 4; ++i2) o[i2] = MFMA(as_bf8(vbuf[jr % 3][i2]), pf, o[i2]);
  }
#undef NA_VLOAD
  const float inv = 1.f / sum;
#pragma unroll
  for (int i2 = 0; i2 < 4; ++i2) *(uint2*)(mix + (size_t)tq * 1536 + h * 64 + 16 * i2 + 4 * quad) = pack4(o[i2] * inv);
}

__device__ void conv_tile(const Params& p, int tile) {
  const int tb = tile >> 2, cb = tile & 3;
  const int ch = cb * 512 + 2 * vtid();
  const int b = tb >> 5, s0 = (tb & 31) * 64;
  float w[4][2], bias[2];
#pragma unroll
  for (int k = 0; k < 4; ++k) { const float2 t = *(const float2*)(p.conv_w + k * 2048 + ch); w[k][0] = t.x; w[k][1] = t.y; }
  { const float2 t = *(const float2*)(p.conv_b + ch); bias[0] = t.x; bias[1] = t.y; }
  const u16* src = (const u16*)(p.ws + O_XBC) + (size_t)(b * 2048) * 2048 + ch;
  unsigned um2 = (s0 >= 2) ? *(const unsigned*)(src + (size_t)(s0 - 2) * 2048) : 0u;
  unsigned um1 = (s0 >= 1) ? *(const unsigned*)(src + (size_t)(s0 - 1) * 2048) : 0u;
  unsigned u0 = *(const unsigned*)(src + (size_t)s0 * 2048);
  u16* XT = (u16*)p.out + 16 * MIB;
  for (int sg = 0; sg < 8; ++sg) {
    unsigned nx[8];
#pragma unroll
    for (int e = 0; e < 8; ++e) { const int s = s0 + sg * 8 + e; nx[e] = (s + 1 < 2048) ? *(const unsigned*)(src + (size_t)(s + 1) * 2048) : 0u; }
    float y[2][8];
#pragma unroll
    for (int e = 0; e < 8; ++e) {
      const unsigned up1 = nx[e];
      y[0][e] = silu(w[0][0] * bflo(um2) + w[1][0] * bflo(um1) + w[2][0] * bflo(u0) + w[3][0] * bflo(up1) + bias[0]);
      y[1][e] = silu(w[0][1] * bfhi(um2) + w[1][1] * bfhi(um1) + w[2][1] * bfhi(u0) + w[3][1] * bfhi(up1) + bias[1]);
      um2 = um1; um1 = u0; u0 = up1;
    }
    const int sb = s0 + sg * 8;
    if (cb < 3) {
      u16* dstT = (cb < 2) ? XT + (size_t)(b * 1024 + ch) * 2048 + sb : (u16*)(p.ws + O_BT) + (size_t)(b * 512 + (ch - 1024)) * 2048 + sb;
#pragma unroll
      for (int c2 = 0; c2 < 2; ++c2)
        *(uint4*)(dstT + (size_t)c2 * 2048) = make_uint4(pack2(y[c2][0], y[c2][1]), pack2(y[c2][2], y[c2][3]), pack2(y[c2][4], y[c2][5]), pack2(y[c2][6], y[c2][7]));
    }
    if (cb >= 2) {
      u16* nat = (cb == 2) ? (u16*)(p.ws + O_BN) + (size_t)(b * 2048 + sb) * 512 + (ch - 1024)
                           : (u16*)(p.ws + O_CN) + (size_t)(b * 2048 + sb) * 512 + (ch - 1536);
#pragma unroll
      for (int e = 0; e < 8; ++e) *(unsigned*)(nat + e * 512) = pack2(y[0][e], y[1][e]);
    }
  }
}

__device__ void scan_item8(const Params& p, char* smem, int item) {
  const int tid = otid(), lane = tid & 63, wave = __builtin_amdgcn_readfirstlane(tid >> 6), l15 = lane & 15, quad = lane >> 4;
  const int dir = item & 1, h = (item >> 1) & 15, b = item >> 5, g = h >> 2;
  const float Ah = -__expf(p.A_log[dir * 16 + h]) * LOG2E;
  PG8_LAS float* wall = (PG8_LAS float*)((PG8_LAS unsigned char*)smem + 65536);
  PG8_LAS float* cdall = wall + 2048;
  const float* dtb = (const float*)(p.ws + O_DTB);
#pragma unroll
  for (int cc = 0; cc < 2; ++cc) {
    const int c = 2 * wave + cc;
    const int tokb = b * 2048 + c * 128;
    const float d0 = dtb[(size_t)(tokb + 2 * lane) * 32 + dir * 16 + h];
    const float d1 = dtb[(size_t)(tokb + 2 * lane + 1) * 32 + dir * 16 + h];
    const float a0 = d0 * Ah, a1 = d1 * Ah, ps = a0 + a1;
    float incl = ps;
#pragma unroll
    for (int o = 1; o < 64; o <<= 1) { float tv = __shfl_up(incl, o); if (lane >= o) incl += tv; }
    const float total = __shfl(incl, 63);
    const float excl = incl - ps;
    float w0, w1;
    if (dir == 0) { w0 = ex2(total - (excl + a0)) * d0; w1 = ex2(total - incl) * d1; }
    else { w0 = ex2(excl) * d0; w1 = ex2(excl + a0) * d1; }
    wall[c * 128 + 2 * lane] = w0; wall[c * 128 + 2 * lane + 1] = w1;
    if (lane == 0) cdall[c] = ex2(total);
  }
  __syncthreads();
  const int drow = 8 * wave + (lane >> 4);
  const u16* XTg = (const u16*)p.out + 16 * MIB + (size_t)(b * 1024 + h * 64) * 2048;
  const char* xsrc0 = (const char*)(XTg + (size_t)drow * 2048) + (((lane & 15) ^ (drow & 15)) << 4);
  const char* xsrc1 = (const char*)(XTg + (size_t)(drow + 4) * 2048) + (((lane & 15) ^ ((drow + 4) & 15)) << 4);
  PG8_LAS unsigned char* lds = (PG8_LAS unsigned char*)smem;
  const u16* BT = (const u16*)(p.ws + O_BT) + (size_t)(b * 512 + g * 128 + 16 * wave + l15) * 2048 + 8 * quad;
  u16* HP = (u16*)(p.ws + O_HPREV);
  f32x4 acc[4];
#pragma unroll
  for (int j = 0; j < 4; ++j) acc[j] = (f32x4){0.f, 0.f, 0.f, 0.f};
  u32x4v bA[4], bB[4], bC[4], bD[4];
#define SC_ISSUE(Bf, st, c) do { \
    __builtin_amdgcn_global_load_lds((const unsigned*)(xsrc0 + (c) * 256), (PG8_LAS unsigned*)(lds + (st) * 16384 + wave * 2048), 16, 0, 0); \
    __builtin_amdgcn_global_load_lds((const unsigned*)(xsrc1 + (c) * 256), (PG8_LAS unsigned*)(lds + (st) * 16384 + wave * 2048 + 1024), 16, 0, 0); \
    { const u16* _bp = BT + (c) * 128; \
      asm volatile("global_load_dwordx4 %0, %4, off\n\tglobal_load_dwordx4 %1, %4, off offset:64\n\tglobal_load_dwordx4 %2, %4, off offset:128\n\tglobal_load_dwordx4 %3, %4, off offset:192" \
                   : "=&v"(Bf[0]), "=&v"(Bf[1]), "=&v"(Bf[2]), "=&v"(Bf[3]) : "v"(_bp) : "memory"); } } while (0)
#define SC_STEP(Bf, st, c) do { \
    u16* hp = HP + ((size_t)(((b * 16 + (c)) * 16 + h) * 2 + dir) << 13); \
    _Pragma("unroll") for (int j = 0; j < 4; ++j) *(uint2*)(hp + (16 * j + l15) * 128 + 16 * wave + 4 * quad) = pack4(acc[j]); \
    const float cd = cdall[(c)]; \
    _Pragma("unroll") for (int j = 0; j < 4; ++j) acc[j] *= cd; \
    _Pragma("unroll") for (int ks = 0; ks < 4; ++ks) { \
      const f32x4 wav = *(const PG8_LAS f32x4*)(wall + (c) * 128 + 32 * ks + 8 * quad); \
      const f32x4 wbv = *(const PG8_LAS f32x4*)(wall + (c) * 128 + 32 * ks + 8 * quad + 4); \
      const float4 wa = make_float4(wav[0], wav[1], wav[2], wav[3]), wb = make_float4(wbv[0], wbv[1], wbv[2], wbv[3]); \
      _Pragma("unroll") for (int j = 0; j < 4; ++j) { \
        const u32x4v rawv = *(const PG8_LAS u32x4v*)(lds + (st) * 16384 + (16 * j + l15) * 256 + (((4 * ks + quad) ^ l15) << 4)); \
        const uint4 raw = make_uint4(rawv[0], rawv[1], rawv[2], rawv[3]); uint4 sc; \
        sc.x = pack2(bflo(raw.x) * wa.x, bfhi(raw.x) * wa.y); sc.y = pack2(bflo(raw.y) * wa.z, bfhi(raw.y) * wa.w); \
        sc.z = pack2(bflo(raw.z) * wb.x, bfhi(raw.z) * wb.y); sc.w = pack2(bflo(raw.w) * wb.z, bfhi(raw.w) * wb.w); \
        acc[j] = MFMA(__builtin_bit_cast(bf16x8, Bf[ks]), as_bf8(sc), acc[j]); } } } while (0)
#define SC_CH(s) (dir ? 15 - (s) : (s))
  SC_ISSUE(bA, 0, SC_CH(0)); SC_ISSUE(bB, 1, SC_CH(1)); SC_ISSUE(bC, 2, SC_CH(2));
#define SC_BAR() do { asm volatile("" ::: "memory"); __builtin_amdgcn_s_barrier(); asm volatile("" ::: "memory"); } while (0)
#define SC_WAIT(nlast, Bf) do { if (s4 == 12) asm volatile("s_waitcnt vmcnt(" #nlast ")" : "+v"(Bf[0]), "+v"(Bf[1]), "+v"(Bf[2]), "+v"(Bf[3]) :: "memory"); \
    else asm volatile("s_waitcnt vmcnt(18)" : "+v"(Bf[0]), "+v"(Bf[1]), "+v"(Bf[2]), "+v"(Bf[3]) :: "memory"); } while (0)
  for (int s4 = 0; s4 < 16; s4 += 4) {
    SC_ISSUE(bD, 3, SC_CH(s4 + 3));
    SC_WAIT(18, bA); SC_BAR();
    SC_STEP(bA, 0, SC_CH(s4));
    SC_BAR();
    if (s4 + 4 < 16) SC_ISSUE(bA, 0, SC_CH(s4 + 4));
    SC_WAIT(12, bB); SC_BAR();
    SC_STEP(bB, 1, SC_CH(s4 + 1));
    SC_BAR();
    if (s4 + 5 < 16) SC_ISSUE(bB, 1, SC_CH(s4 + 5));
    SC_WAIT(6, bC); SC_BAR();
    SC_STEP(bC, 2, SC_CH(s4 + 2));
    SC_BAR();
    if (s4 + 6 < 16) SC_ISSUE(bC, 2, SC_CH(s4 + 6));
    SC_WAIT(0, bD); SC_BAR();
    SC_STEP(bD, 3, SC_CH(s4 + 3));
    SC_BAR();
  }
#undef SC_BAR
#undef SC_WAIT
#undef SC_ISSUE
#undef SC_STEP
#undef SC_CH
  asm volatile("s_waitcnt vmcnt(0)" ::: "memory");
  __syncthreads();
}

__device__ void ssd_out_tile(const Params& p, char* smem, int tile) {
  const int tid = vtid(), lane = tid & 63, wave = tid >> 6, l15 = lane & 15, quad = lane >> 4;
  const int g = tile & 3, c = (tile >> 2) & 15, b = tile >> 6;
  const int hh = g * 4 + wave;
  u16* Gs = (u16*)smem;
  float* wv = (float*)(smem + 34816) + wave * 512;
  float* red = (float*)(smem + 34816 + 8192);
  const int tok0 = b * 2048 + c * 128;
  const u16* Cn = (const u16*)(p.ws + O_CN) + (size_t)tok0 * 512 + g * 128;
  const u16* Bn = (const u16*)(p.ws + O_BN) + (size_t)tok0 * 512 + g * 128;
  const float* dtb = (const float*)(p.ws + O_DTB);
  {
    f32x4 ga[8][2];
#pragma unroll
    for (int i = 0; i < 8; ++i) { ga[i][0] = (f32x4){0.f, 0.f, 0.f, 0.f}; ga[i][1] = ga[i][0]; }
#pragma unroll 2
    for (int ks = 0; ks < 4; ++ks) {
      bf16x8 cf[2];
#pragma unroll
      for (int jj = 0; jj < 2; ++jj)
        cf[jj] = as_bf8(*(const uint4*)(Cn + (size_t)(16 * (2 * wave + jj) + l15) * 512 + 32 * ks + 8 * quad));
#pragma unroll
      for (int i = 0; i < 8; ++i) {
        bf16x8 bf = as_bf8(*(const uint4*)(Bn + (size_t)(16 * i + l15) * 512 + 32 * ks + 8 * quad));
        ga[i][0] = MFMA(bf, cf[0], ga[i][0]);
        ga[i][1] = MFMA(bf, cf[1], ga[i][1]);
      }
    }
#pragma unroll
    for (int i = 0; i < 8; ++i)
#pragma unroll
      for (int jj = 0; jj < 2; ++jj)
        *(uint2*)(Gs + (16 * (2 * wave + jj) + l15) * 136 + 16 * i + 4 * quad) = pack4(ga[i][jj]);
  }
  {
    const float Af = -__expf(p.A_log[hh]) * LOG2E, Ab = -__expf(p.A_log[16 + hh]) * LOG2E;
    const float d0f = dtb[(size_t)(tok0 + 2 * lane) * 32 + hh], d1f = dtb[(size_t)(tok0 + 2 * lane + 1) * 32 + hh];
    const float d0b = dtb[(size_t)(tok0 + 2 * lane) * 32 + 16 + hh], d1b = dtb[(size_t)(tok0 + 2 * lane + 1) * 32 + 16 + hh];
    const float a0 = d0f * Af, a1 = d1f * Af, c0 = d0b * Ab, c1 = d1b * Ab;
    float inf_ = a0 + a1, inb = c0 + c1;
#pragma unroll
    for (int o = 1; o < 64; o <<= 1) {
      float t1 = __shfl_up(inf_, o), t2 = __shfl_up(inb, o);
      if (lane >= o) { inf_ += t1; inb += t2; }
    }
    const float totb = __shfl(inb, 63);
    const float exf = inf_ - (a0 + a1), exb = inb - (c0 + c1);
    *(float2*)(wv + 2 * lane) = make_float2(exf + a0, inf_);
    *(float2*)(wv + 128 + 2 * lane) = make_float2(totb - exb, totb - (exb + c0));
    *(float2*)(wv + 256 + 2 * lane) = make_float2(d0f, d1f);
    *(float2*)(wv + 384 + 2 * lane) = make_float2(d0b, d1b);
  }
  __syncthreads();
  const float Dh = p.Dskip[hh];
  const int prow = 8 * (l15 >> 2) + (l15 & 3);
  const u16* XT = (const u16*)p.out + 16 * MIB + (size_t)(b * 1024 + hh * 64) * 2048 + c * 128;
  const u16* hf = (const u16*)(p.ws + O_HPREV) + ((size_t)(((b * 16 + c) * 16 + hh) * 2) << 13);
  const u16* hb = hf + 8192;
  const u16* Z = (const u16*)p.out;
  u16* mix = (u16*)(p.ws + O_MIX);
  #pragma unroll 1
  for (int jh = 0; jh < 2; ++jh) {
    f32x4 y[4][4];
    {
      float efv[4], ebv[4];
#pragma unroll
      for (int j = 0; j < 4; ++j) {
        const int l = 64 * jh + 16 * j + l15;
        efv[j] = ex2(wv[l]); ebv[j] = ex2(wv[128 + l]);
      }
#pragma unroll
      for (int i = 0; i < 4; ++i)
#pragma unroll
        for (int j = 0; j < 4; ++j) y[i][j] = (f32x4){0.f, 0.f, 0.f, 0.f};
#pragma unroll 2
      for (int ks = 0; ks < 4; ++ks) {
        bf16x8 cF[4], cB[4];
#pragma unroll
        for (int j = 0; j < 4; ++j) {
          const uint4 raw = *(const uint4*)(Cn + (size_t)(64 * jh + 16 * j + l15) * 512 + 32 * ks + 8 * quad);
          float f[8];
          unpack8(raw, f);
          cF[j] = as_bf8(make_uint4(pack2(f[0] * efv[j], f[1] * efv[j]), pack2(f[2] * efv[j], f[3] * efv[j]), pack2(f[4] * efv[j], f[5] * efv[j]), pack2(f[6] * efv[j], f[7] * efv[j])));
          cB[j] = as_bf8(make_uint4(pack2(f[0] * ebv[j], f[1] * ebv[j]), pack2(f[2] * ebv[j], f[3] * ebv[j]), pack2(f[4] * ebv[j], f[5] * ebv[j]), pack2(f[6] * ebv[j], f[7] * ebv[j])));
        }
#pragma unroll
        for (int i = 0; i < 4; ++i) {
          bf16x8 f1 = as_bf8(*(const uint4*)(hf + (32 * (i >> 1) + 4 * (i & 1) + prow) * 128 + 32 * ks + 8 * quad));
          bf16x8 f2 = as_bf8(*(const uint4*)(hb + (32 * (i >> 1) + 4 * (i & 1) + prow) * 128 + 32 * ks + 8 * quad));
#pragma unroll
          for (int j = 0; j < 4; ++j) { y[i][j] = MFMA(f1, cF[j], y[i][j]); y[i][j] = MFMA(f2, cB[j], y[i][j]); }
        }
      }
    }
#pragma unroll 2
    for (int ks = 0; ks < 4; ++ks) {
      const int sb = 32 * ks + 8 * quad;
      float afs[8], rbs[8], d0s[8], d1s[8];
      *(float4*)(afs) = *(const float4*)(wv + sb); *(float4*)(afs + 4) = *(const float4*)(wv + sb + 4);
      *(float4*)(rbs) = *(const float4*)(wv + 128 + sb); *(float4*)(rbs + 4) = *(const float4*)(wv + 128 + sb + 4);
      *(float4*)(d0s) = *(const float4*)(wv + 256 + sb); *(float4*)(d0s + 4) = *(const float4*)(wv + 256 + sb + 4);
      *(float4*)(d1s) = *(const float4*)(wv + 384 + sb); *(float4*)(d1s + 4) = *(const float4*)(wv + 384 + sb + 4);
      bf16x8 xf[4];
#pragma unroll
      for (int i = 0; i < 4; ++i) xf[i] = as_bf8(*(const uint4*)(XT + (size_t)(32 * (i >> 1) + 4 * (i & 1) + prow) * 2048 + sb));
#pragma unroll
      for (int j = 0; j < 4; ++j) {
        const int l = 64 * jh + 16 * j + l15;
        const float afl = wv[l], rbl = wv[128 + l];
        float gv[8], m[8];
        unpack8(*(const uint4*)(Gs + l * 136 + sb), gv);
#pragma unroll
        for (int e = 0; e < 8; ++e) {
          const int s = sb + e;
          float ff = (s <= l) ? ex2(afl - afs[e]) * d0s[e] : 0.f;
          float fb = (s >= l) ? ex2(rbl - rbs[e]) * d1s[e] : 0.f;
          m[e] = gv[e] * (ff + fb) + ((s == l) ? Dh : 0.f);
        }
        bf16x8 mf = as_bf8(make_uint4(pack2(m[0], m[1]), pack2(m[2], m[3]), pack2(m[4], m[5]), pack2(m[6], m[7])));
#pragma unroll
        for (int i = 0; i < 4; ++i) y[i][j] = MFMA(xf[i], mf, y[i][j]);
      }
    }
#pragma unroll
    for (int j = 0; j < 4; ++j) {
      const int tok = tok0 + 64 * jh + 16 * j + l15;
      float part = 0.f;
#pragma unroll
      for (int k = 0; k < 2; ++k) {
        const uint4 zr = *(const uint4*)(Z + (size_t)tok * 1024 + hh * 64 + 32 * k + 8 * quad);
        y[2 * k][j][0] *= silu(bflo(zr.x)); y[2 * k][j][1] *= silu(bfhi(zr.x)); y[2 * k][j][2] *= silu(bflo(zr.y)); y[2 * k][j][3] *= silu(bfhi(zr.y));
        part += y[2 * k][j][0] * y[2 * k][j][0] + y[2 * k][j][1] * y[2 * k][j][1] + y[2 * k][j][2] * y[2 * k][j][2] + y[2 * k][j][3] * y[2 * k][j][3];
        y[2 * k + 1][j][0] *= silu(bflo(zr.z)); y[2 * k + 1][j][1] *= silu(bfhi(zr.z)); y[2 * k + 1][j][2] *= silu(bflo(zr.w)); y[2 * k + 1][j][3] *= silu(bfhi(zr.w));
        part += y[2 * k + 1][j][0] * y[2 * k + 1][j][0] + y[2 * k + 1][j][1] * y[2 * k + 1][j][1] + y[2 * k + 1][j][2] * y[2 * k + 1][j][2] + y[2 * k + 1][j][3] * y[2 * k + 1][j][3];
      }
      part = xor16_32_sum(part);
      if (quad == 0) red[wave * 64 + 16 * j + l15] = part;
    }
    __syncthreads();
#pragma unroll
    for (int j = 0; j < 4; ++j) {
      const int tok = tok0 + 64 * jh + 16 * j + l15;
      const int q = 16 * j + l15;
      const float tot = red[q] + red[64 + q] + red[128 + q] + red[192 + q];
      const float rs = rsqrtf(tot * (1.f / 256.f) + EPS);
#pragma unroll
      for (int k = 0; k < 2; ++k) {
        const float4 ga = *(const float4*)(p.out_norm + hh * 64 + 32 * k + 8 * quad);
        const float4 gb = *(const float4*)(p.out_norm + hh * 64 + 32 * k + 8 * quad + 4);
        f32x4 oa, ob;
        oa[0] = y[2 * k][j][0] * rs * ga.x; oa[1] = y[2 * k][j][1] * rs * ga.y; oa[2] = y[2 * k][j][2] * rs * ga.z; oa[3] = y[2 * k][j][3] * rs * ga.w;
        ob[0] = y[2 * k + 1][j][0] * rs * gb.x; ob[1] = y[2 * k + 1][j][1] * rs * gb.y; ob[2] = y[2 * k + 1][j][2] * rs * gb.z; ob[3] = y[2 * k + 1][j][3] * rs * gb.w;
        *(uint4*)(mix + (size_t)tok * 1536 + 512 + hh * 64 + 32 * k + 8 * quad) = pack8(oa, ob);
      }
    }
    __syncthreads();
  }
}

__device__ void gqa_tile8(const Params& p, char* smem, int tile) {
  const int tid = otid(), lane = tid & 63, wave = __builtin_amdgcn_readfirstlane(tid >> 6), l15 = lane & 15, quad = lane >> 4;
  const int rep = tile & 3, qb = (tile >> 2) & 3, kvh = (tile >> 4) & 3, b = tile >> 6;
  const int h = kvh * 4 + rep;
  const u16* Q1 = (const u16*)(p.ws + O_Q1);
  const u16* K1 = (const u16*)(p.ws + O_K1) + (size_t)(b * 2048) * 256 + kvh * 64;
  const u16* VT = (const u16*)(p.ws + O_VT1) + (size_t)((b * 4 + kvh) * 64) * 2048;
  u16* AO = (u16*)(p.ws + O_AO);
  const int tq0 = b * 2048 + qb * 512 + 64 * wave;
  bf16x8 qf[4][2];
#pragma unroll
  for (int j = 0; j < 4; ++j)
#pragma unroll
    for (int ks = 0; ks < 2; ++ks)
      qf[j][ks] = as_bf8(*(const uint4*)(Q1 + (size_t)(tq0 + 16 * j + l15) * 1024 + h * 64 + 32 * ks + 8 * quad));
  PG8_LAS unsigned char* lds = (PG8_LAS unsigned char*)smem;
  const int kr0 = 16 * wave + (lane >> 3), kr1 = kr0 + 8;
  const char* ksrc0 = (const char*)(K1 + (size_t)kr0 * 256) + ((((lane & 7) ^ ((kr0 >> 1) & 7))) << 4);
  const char* ksrc1 = (const char*)(K1 + (size_t)kr1 * 256) + ((((lane & 7) ^ ((kr1 >> 1) & 7))) << 4);
  const int vr0 = 8 * wave + (lane >> 4), vr1 = vr0 + 4;
  const char* vsrc0 = (const char*)(VT + (size_t)vr0 * 2048) + ((((lane & 15) ^ (vr0 & 15))) << 4);
  const char* vsrc1 = (const char*)(VT + (size_t)vr1 * 2048) + ((((lane & 15) ^ (vr1 & 15))) << 4);
  float shift;
  {
    float gq = fabsf(p.gqa_q_norm[lane]), gk = fabsf(p.gqa_k_norm[lane]);
#pragma unroll
    for (int o_ = 32; o_ >= 1; o_ >>= 1) { gq = fmaxf(gq, __shfl_xor(gq, o_)); gk = fmaxf(gk, __shfl_xor(gk, o_)); }
    shift = 8.f * gq * gk * LOG2E;
  }
  f32x4 o[4][4];
#pragma unroll
  for (int i = 0; i < 4; ++i)
#pragma unroll
    for (int j = 0; j < 4; ++j) o[i][j] = (f32x4){0.f, 0.f, 0.f, 0.f};
  f32x4 osum[4];
#pragma unroll
  for (int j = 0; j < 4; ++j) osum[j] = (f32x4){0.f, 0.f, 0.f, 0.f};
  const bf16x8 ones = {0x3F80, 0x3F80, 0x3F80, 0x3F80, 0x3F80, 0x3F80, 0x3F80, 0x3F80};
  const f32x4 sinit = {-shift, -shift, -shift, -shift};
#define GQ_ISSUE(t) do { const int _st = (t) & 3; \
    __builtin_amdgcn_global_load_lds((const unsigned*)(ksrc0 + (size_t)(t) * (128 * 512)), (PG8_LAS unsigned*)(lds + _st * 32768 + wave * 2048), 16, 0, 0); \
    __builtin_amdgcn_global_load_lds((const unsigned*)(ksrc1 + (size_t)(t) * (128 * 512)), (PG8_LAS unsigned*)(lds + _st * 32768 + wave * 2048 + 1024), 16, 0, 0); \
    __builtin_amdgcn_global_load_lds((const unsigned*)(vsrc0 + (t) * 256), (PG8_LAS unsigned*)(lds + _st * 32768 + 16384 + wave * 2048), 16, 0, 0); \
    __builtin_amdgcn_global_load_lds((const unsigned*)(vsrc1 + (t) * 256), (PG8_LAS unsigned*)(lds + _st * 32768 + 16384 + wave * 2048 + 1024), 16, 0, 0); } while (0)
#define GQ_BODY(st, hk, jb) do { \
    PG8_LAS const unsigned char* sK = lds + (st) * 32768; PG8_LAS const unsigned char* sV = sK + 16384; \
    f32x4 s[4][2]; \
    _Pragma("unroll") for (int i = 0; i < 4; ++i) { s[i][0] = sinit; s[i][1] = sinit; } \
    _Pragma("unroll") for (int ks = 0; ks < 2; ++ks) \
      _Pragma("unroll") for (int i = 0; i < 4; ++i) { \
        const int kr = 64 * (hk) + 16 * i + l15; \
        bf16x8 kf = *(PG8_LAS const bf16x8*)(sK + kr * 128 + (((4 * ks + quad) ^ ((kr >> 1) & 7)) << 4)); \
        s[i][0] = MFMA(kf, qf[(jb)][ks], s[i][0]); s[i][1] = MFMA(kf, qf[(jb) + 1][ks], s[i][1]); } \
    bf16x8 pf[2][2]; \
    _Pragma("unroll") for (int j = 0; j < 2; ++j) { \
      _Pragma("unroll") for (int i = 0; i < 4; ++i) \
        _Pragma("unroll") for (int r = 0; r < 4; ++r) s[i][j][r] = ex2(s[i][j][r]); \
      pf[j][0] = cat_bf8(pack4(s[0][j]), pack4(s[1][j])); pf[j][1] = cat_bf8(pack4(s[2][j]), pack4(s[3][j])); } \
    _Pragma("unroll") for (int ks2 = 0; ks2 < 2; ++ks2) \
      _Pragma("unroll") for (int i2 = 0; i2 < 4; ++i2) { \
        const int vd = 16 * i2 + l15; \
        bf16x8 vf = *(PG8_LAS const bf16x8*)(sV + vd * 256 + (((8 * (hk) + 4 * ks2 + quad) ^ (vd & 15)) << 4)); \
        o[i2][(jb)] = MFMA(vf, pf[0][ks2], o[i2][(jb)]); o[i2][(jb) + 1] = MFMA(vf, pf[1][ks2], o[i2][(jb) + 1]); } \
    _Pragma("unroll") for (int ks2 = 0; ks2 < 2; ++ks2) { osum[(jb)] = MFMA(ones, pf[0][ks2], osum[(jb)]); osum[(jb) + 1] = MFMA(ones, pf[1][ks2], osum[(jb) + 1]); } \
    __builtin_amdgcn_sched_barrier(0); \
  } while (0)
  __syncthreads();
  GQ_ISSUE(0); GQ_ISSUE(1);
  for (int kt = 0; kt < 16; ++kt) {
    if (kt + 2 < 16) GQ_ISSUE(kt + 2);
    if (kt < 14) asm volatile("s_waitcnt vmcnt(8)" ::: "memory");
    else if (kt == 14) asm volatile("s_waitcnt vmcnt(4)" ::: "memory");
    else asm volatile("s_waitcnt vmcnt(0)" ::: "memory");
    asm volatile("" ::: "memory"); __builtin_amdgcn_s_barrier(); asm volatile("" ::: "memory");
    const int st = kt & 3;
    GQ_BODY(st, 0, 0); GQ_BODY(st, 0, 2); GQ_BODY(st, 1, 0); GQ_BODY(st, 1, 2);
  }
#undef GQ_ISSUE
#undef GQ_BODY
#pragma unroll
  for (int j = 0; j < 4; ++j) {
    const float inv = 1.f / osum[j][0];
    const int tq = tq0 + 16 * j + l15;
#pragma unroll
    for (int i2 = 0; i2 < 4; ++i2) *(uint2*)(AO + (size_t)tq * 1024 + h * 64 + 16 * i2 + 4 * quad) = pack4(o[i2][j] * inv);
  }
}

#ifndef ONLY_PHASE
#define ONLY_PHASE -1
#endif
__device__ void run_phase(const Params& p, char* smem, int ph) {
  if (ONLY_PHASE >= 0 && ph != ONLY_PHASE) return;
  size_t wz = 0;
  asm volatile("" : "+s"(wz));
  char* ws = p.ws + wz;
  float* ssq = (float*)(ws + O_SSQ);
  u16* xb = (u16*)(ws + O_XB);
  const int half = __builtin_amdgcn_readfirstlane(threadIdx_x_raw() >> 8);
  char* sh = smem + half * 65536;
  const int G = gridDim.x, bid = blockIdx.x;
  const int vb = bid * 2 + half, nvb = G * 2;
  const bool is_gemm = (ph == 1) || (ph >= 5 && ph != 9);
  if (is_gemm) {
    const int nsub = (ph == 1 || ph == 8) ? 2 : 1;
    for (int sub = 0; sub < nsub; ++sub) {
      pg8::Gemm g{}; EpiAny E{}; E.ws = ws; E.zout = (u16*)p.out; E.perm = true; int c = bid;
      E.qn = (ph >= 8) ? p.gqa_q_norm : p.na_q_norm; E.kn = (ph >= 8) ? p.gqa_k_norm : p.na_k_norm;
      const bool l1 = ph >= 8;
      const u16* W13 = (const u16*)(ws + (l1 ? O_W13_1 : O_W13_0));
      const u16* W2 = (const u16*)(ws + (l1 ? O_W2_1 : O_W2_0));
      if (ph == 1 || ph == 8) {
        const float* sq = l1 ? ssq + 2 * T : nullptr;
        if (sub == 0) { g = pg8::Gemm{xb, (const u16*)(ws + (l1 ? O_WQKV1 : O_WIN0)), T, l1 ? 1280 : 4352, 1024}; E.kind = l1 ? EK_QK1 : EK_QK0; E.ssq_in = sq; }
        else { g = pg8::Gemm{(const u16*)(ws + (l1 ? O_WV1 : O_WV0)), xb, l1 ? 256 : 512, T, 1024}; E.kind = EK_VT; E.ssq_in = sq;
               E.o16 = (u16*)(ws + (l1 ? O_VT1 : O_VT0)); E.nh = l1 ? 4 : 8; c = (bid + G - 64) % G; }
      } else if (ph == 5 || ph == 10) {
        g = pg8::Gemm{(const u16*)(ws + (l1 ? O_AO : O_MIX)), (const u16*)(ws + (l1 ? O_WOUT1 : O_WOUT0)), T, 1024, l1 ? 1024 : 1536};
        E.kind = EK_RES; E.perm = false; E.res_in = l1 ? nullptr : p.x; E.res_out = nullptr; E.xb_out = xb; E.ssq_out = ssq + (l1 ? 3 * T : T);
      } else if (ph == 6 || ph == 11) {
        g = pg8::Gemm{xb, W13, T, 5632, 1024}; E.kind = EK_SWIGLU; E.ssq_in = ssq + (l1 ? 3 * T : T); E.o16 = (u16*)(ws + O_H);
      } else {
        g = pg8::Gemm{(const u16*)(ws + O_H), W2, T, 1024, 2816};
        E.kind = EK_RES; E.perm = false; E.res_in = nullptr; E.res_out = l1 ? p.out : nullptr; E.xb_out = xb; E.ssq_out = l1 ? nullptr : ssq + 2 * T;
      }
      pg8::StaticOrder S; S.init(g.M, g.N, G, c);
      pg8::gemm_phase(( PG8_LAS unsigned char*)smem, g, S, E);
      if (ph == 6 && G == 256 && bid >= 128) {
        const int tid = otid();
        phase_prep_l1(p, ws, (bid - 128) * 8 + (tid >> 6), 128 * 8, tid & 63);
      }
    }
    return;
  }
  switch (ph) {
    case 0: phase_prep(p); break;
    case 2: {
      PSUB(4) for (int t = vb; t < 2048; t += nvb) na_tile(p, t);
      PSUB(5) for (int t = vb; t < 1024; t += nvb) conv_tile(p, t);
      float* dtb = (float*)(ws + O_DTB);
      for (int idx = bid * 512 + otid(); idx < T * 32; idx += G * 512) {
        float v = dtb[idx] + p.dt_bias[idx & 31];
        const float ev = __builtin_amdgcn_exp2f(v * LOG2E);
        const float sp = (ev < 1e-3f) ? ev * (1.f - 0.5f * ev + 0.33333333f * ev * ev) : __builtin_amdgcn_logf(1.f + ev) * 0.6931471805599453f;
        dtb[idx] = (v > 20.f) ? v : sp;
      }
    } break;
    case 3: {
      for (int t0 = 0; t0 < 256; t0 += G) {
        int item = min(t0 + bid, 255);
        if (G == 256) {
          const int xcd = bid & 7, j = bid >> 3, grp = xcd * 4 + (j >> 3), idx8 = j & 7;
          item = (idx8 & 1) + 2 * ((grp & 3) * 4 + (idx8 >> 1)) + 32 * (grp >> 2);
        }
        scan_item8(p, smem, item);
      }
      if (G != 256) { const int tid = otid(); phase_prep_l1(p, ws, bid * 8 + (tid >> 6), G * 8, tid & 63); }
    } break;
    case 4:
      for (int t0 = 0; t0 < 512; t0 += nvb) ssd_out_tile(p, sh, min(t0 + vb, 511));
      break;
    case 9:
      if (G == 256) {
        const int xcd = bid & 7, j = bid >> 3;
        for (int r = 0; r < 2; ++r) gqa_tile8(p, smem, (r * 16 + xcd * 2 + (j >> 4)) * 16 + (j & 15));
      } else {
        for (int t0 = 0; t0 < 512; t0 += G) gqa_tile8(p, smem, min(t0 + bid, 511));
      }
      break;
    default: break;
  }
}

#define XB_TMO      128
#define XB_XCNT(j)  (256  + 64 * (j))
#define XB_XSUB(j)  (1280 + 64 * (j))
#define XB_XGEN(j)  (2304 + 64 * (j))
#define XB_TOP      3328
#define XB_TOPGEN   3392
#define XCD_BAR_WORDS 3456
#define XB_SPIN_CAP (1u << 18)
#define LAS __attribute__((address_space(3)))
DI unsigned xb_ld(unsigned* p) { return __hip_atomic_load(p, __ATOMIC_RELAXED, __HIP_MEMORY_SCOPE_AGENT); }
DI unsigned xb_add(unsigned* p, unsigned v) { return __hip_atomic_fetch_add(p, v, __ATOMIC_RELAXED, __HIP_MEMORY_SCOPE_AGENT); }
DI unsigned xb_xcc_id() { return (unsigned)__builtin_amdgcn_s_getreg((3 << 11) | 20) & 0xFu; }
#define XB_SPIN(cond, bar) do { unsigned _sp = 0; while (cond) { __builtin_amdgcn_s_sleep(1); \
    if ((++_sp & 255u) == 0u) { if (xb_ld(&(bar)[XB_TMO])) break; if (_sp > XB_SPIN_CAP) { atomicAdd(&(bar)[XB_TMO], 1u); break; } } } } while (0)
struct XcdBarrier { unsigned* bar; unsigned x; volatile LAS unsigned* st; };
DI XcdBarrier xcd_barrier_post(unsigned* bar, volatile LAS unsigned* st) {
  XcdBarrier b; b.bar = bar; b.x = xb_xcc_id(); b.st = st;
  if (threadIdx_x_raw() == 0) (void)xb_add(&bar[XB_XCNT(b.x)], 1u);
  return b;
}
DI void xcd_barrier_complete(unsigned* bar, unsigned x, unsigned& nloc, unsigned& nx) {
  const unsigned G = gridDim.x * gridDim.y * gridDim.z;
  unsigned sum, cnt, mine, sp = 0u;
  for (;;) {
    sum = 0u; cnt = 0u; mine = 0u;
#pragma unroll
    for (unsigned j = 0; j < 16; ++j) { const unsigned c = xb_ld(&bar[XB_XCNT(j)]); sum += c; cnt += (c > 0u) ? 1u : 0u; mine = (j == x) ? c : mine; }
    if (sum == G) break;
    __builtin_amdgcn_s_sleep(1);
    if ((++sp & 255u) == 0u) { if (xb_ld(&bar[XB_TMO])) break; if (sp > XB_SPIN_CAP) { atomicAdd(&bar[XB_TMO], 1u); break; } }
  }
  nloc = mine > 0u ? mine : 1u; nx = cnt > 0u ? cnt : 1u;
}
DI void xcd_barrier(const XcdBarrier& b) {
  asm volatile("s_waitcnt vmcnt(0)" ::: "memory");
  __syncthreads();
  if (threadIdx_x_raw() == 0) {
    unsigned* bar = b.bar;
    asm volatile("" : "+s"(bar));
    __builtin_amdgcn_s_waitcnt(0);
    unsigned nloc = b.st[0], nx = b.st[1];
    if (nloc == 0u) { xcd_barrier_complete(bar, b.x, nloc, nx); b.st[0] = nloc; b.st[1] = nx; }
    const unsigned old = xb_add(&bar[XB_XSUB(b.x)], 1u);
    const unsigned gen = old / nloc;
    if (old + 1u == (gen + 1u) * nloc) {
      __builtin_amdgcn_fence(__ATOMIC_RELEASE, "agent");
      asm volatile("s_waitcnt vmcnt(0)" ::: "memory");
      const unsigned og = xb_add(&bar[XB_TOP], 1u);
      const unsigned tg = og / nx;
      if (og + 1u == (tg + 1u) * nx) xb_add(&bar[XB_TOPGEN], 1u);
      else XB_SPIN(xb_ld(&bar[XB_TOPGEN]) == tg, bar);
      __builtin_amdgcn_fence(__ATOMIC_ACQUIRE, "agent");
      xb_add(&bar[XB_XGEN(b.x)], 1u);
      asm volatile("s_waitcnt vmcnt(0)" ::: "memory");
    } else {
      XB_SPIN(xb_ld(&bar[XB_XGEN(b.x)]) == gen, bar);
      __builtin_amdgcn_fence(__ATOMIC_ACQUIRE, "agent");
      asm volatile("s_waitcnt vmcnt(0)" ::: "memory");
    }
  }
  __syncthreads();
}

__global__ void __launch_bounds__(512, 2) mega(Params p) {
  extern __shared__ __attribute__((aligned(16))) char smem[];
  __shared__ uint4 xb_words;
  cg::grid_group grid = cg::this_grid();
  if (threadIdx_x_raw() == 0) xb_words = make_uint4(0u, 0u, 0u, 0u);
  __syncthreads();
  XcdBarrier xb = xcd_barrier_post((unsigned*)(p.ws + O_BAR), (volatile LAS unsigned*)&xb_words);
  if (p.ph0 < 0) grid.sync();
  for (int ph = p.ph0; ph < p.ph1; ++ph) {
    int nrep = 1;
#if PROBE_REP_MASK
    if ((PROBE_REP_MASK >> ph) & 1) nrep = 2;
#endif
    for (int r = 0; r < nrep; ++r) {
      run_phase(p, smem, ph);
      if (r + 1 < nrep || ph + 1 < p.ph1) xcd_barrier(xb);
    }
  }
#if PROBE_EXTRA_SYNCS
  for (int i = 0; i < PROBE_EXTRA_SYNCS; ++i) xcd_barrier(xb);
#endif
}

extern "C" void kernel_launch(void* const* d_in, const int* in_sizes, int n_in, void* d_out, int out_size, void* d_ws,
                              size_t ws_size, hipStream_t stream) {
  static int grid_blocks = 0;
  if (!grid_blocks) {
    (void)hipFuncSetAttribute((const void*)mega, hipFuncAttributeMaxDynamicSharedMemorySize, SMEM_BYTES);
    int dev = 0, cus = 0, per_cu = 0;
    (void)hipGetDevice(&dev);
    (void)hipDeviceGetAttribute(&cus, hipDeviceAttributeMultiprocessorCount, dev);
    (void)hipOccupancyMaxActiveBlocksPerMultiprocessor(&per_cu, mega, 512, SMEM_BYTES);
    if (per_cu < 1) per_cu = 1;
    grid_blocks = cus;
  }
  Params p{};
  const float** pp = (const float**)&p;
  for (int i = 0; i < 21; ++i) pp[i] = (const float*)d_in[i];
  p.out = (float*)d_out;
  p.ws = (char*)d_ws;
  (void)hipMemsetAsync((char*)d_ws + O_BAR, 0, XCD_BAR_WORDS * 4, stream);
#if MULTI_LAUNCH
  for (int ph = 0; ph < NPHASE; ++ph) {
    p.ph0 = ph; p.ph1 = ph + 1;
    hipLaunchKernelGGL(mega, dim3(grid_blocks), dim3(512), SMEM_BYTES, stream, p);
  }
#else
  p.ph0 = 0; p.ph1 = NPHASE;
  void* args[] = {&p};
  hipError_t e = hipLaunchCooperativeKernel((const void*)mega, dim3(grid_blocks), dim3(512), args, SMEM_BYTES, stream);
  if (e != hipSuccess) fprintf(stderr, "cooperative launch failed: %s (grid %d)\n", hipGetErrorString(e), grid_blocks);
#endif
}
```
